# Optimizing an MI355X kernel written in HIP

```python
import math
import jax
import jax.numpy as jnp
from jax import lax
import numpy as np

D_MODEL = 1024
BATCH = 2
SEQ = 8192
DEPTH = 1

GRID_W = 64
CTX_LEN = 256
NORM_EPS = 1e-6
DN_HEADS = 8
DN_DK = 128
DN_DV = 128
DN_WIDTH = DN_HEADS * DN_DV
CONV_K = 5
CHUNK = 64
S5_WIDTH = 512
S5_GROUP = 16
S5_GROUPS = S5_WIDTH // S5_GROUP
S5_STATE = 64
QK_W = DN_HEADS * DN_DK
QKV_W = 2 * QK_W + DN_WIDTH
O_BETA = QKV_W
O_DECAY = O_BETA + 2 * DN_HEADS
O_U = O_DECAY + 2 * DN_HEADS
STATE_COLS = O_U + S5_WIDTH
O_ZDN = STATE_COLS
O_ZS5 = O_ZDN + DN_WIDTH
O_GDN = O_ZS5 + S5_WIDTH
O_GS5 = O_GDN + D_MODEL
IN_WIDTH = O_GS5 + D_MODEL

kernel_name = 'hybrid_deltanet_s5_prefix_ctx_block'


def rms_norm(x, w):
    xf = x.astype(jnp.float32)
    y = xf * lax.rsqrt(jnp.mean(xf * xf, axis=-1, keepdims=True) + NORM_EPS)
    return (y * w.astype(jnp.float32)).astype(x.dtype)


def l2_normalise(t):
    return t * lax.rsqrt(jnp.sum(t * t, axis=-1, keepdims=True) + NORM_EPS)


def short_conv(u, w, rows):
    bsz, length, ch = u.shape
    if rows is not None:
        u = u.reshape(bsz * rows, GRID_W, ch)
    y = lax.conv_general_dilated(u, w[:, None, :].astype(u.dtype), window_strides=(1,),
                                 padding=[(CONV_K // 2, CONV_K // 2)],
                                 dimension_numbers=('NWC', 'WIO', 'NWC'),
                                 feature_group_count=ch)
    return jax.nn.silu(y.reshape(bsz, length, ch))


def gated_delta_chunked(q, k, v, g, beta, s0, need_out):
    bsz, nh, length, dk = q.shape
    dv = v.shape[-1]
    n = length // CHUNK

    def blocks(t):
        return t.reshape(bsz, nh, n, CHUNK, *t.shape[3:])

    q, k, v, g, beta = blocks(q), blocks(k), blocks(v), blocks(g), blocks(beta)
    G = jnp.cumsum(g, axis=-1)
    pos = jnp.arange(CHUNK)
    lower_incl = pos[:, None] >= pos[None, :]
    lower_strict = pos[:, None] > pos[None, :]
    decay = jnp.exp(jnp.where(lower_incl, G[..., :, None] - G[..., None, :], -jnp.inf))
    kb = k * beta[..., None]
    t_mat = jnp.where(lower_strict, jnp.einsum('bhncd,bhnsd->bhncs', kb, k) * decay, 0.0) \
        + jnp.eye(CHUNK, dtype=jnp.float32)
    u = lax.linalg.triangular_solve(t_mat, v * beta[..., None], left_side=True, lower=True, unit_diagonal=True)
    w = lax.linalg.triangular_solve(t_mat, kb * jnp.exp(G)[..., None], left_side=True, lower=True,
                                    unit_diagonal=True)
    k_end = k * jnp.exp(G[..., -1:] - G)[..., None]
    a_end = jnp.exp(G[..., -1])
    if s0 is None:
        s0 = jnp.zeros((bsz, nh, dk, dv), jnp.float32)
    front = lambda t: jnp.moveaxis(t, 2, 0)
    if need_out:
        attn = jnp.einsum('bhncd,bhnsd->bhncs', q, k) * decay
        q_dec = q * jnp.exp(G)[..., None]
        xs = tuple(map(front, (u, w, k_end, a_end, q_dec, attn)))
    else:
        xs = tuple(map(front, (u, w, k_end, a_end)))

    def step(S, xs_c):
        u_c, w_c, k_c, a_c = xs_c[:4]
        v_new = u_c - jnp.einsum('bhcd,bhdv->bhcv', w_c, S)
        S_next = S * a_c[..., None, None] + jnp.einsum('bhcd,bhcv->bhdv', k_c, v_new)
        if need_out:
            qd_c, at_c = xs_c[4], xs_c[5]
            o = jnp.einsum('bhcd,bhdv->bhcv', qd_c, S) + jnp.einsum('bhcs,bhsv->bhcv', at_c, v_new)
            return S_next, o
        return S_next, None

    S, o = lax.scan(step, s0, xs)
    if need_out:
        o = jnp.moveaxis(o, 0, 2).reshape(bsz, nh, length, dv)
    return o, S


def s5_discretise(lam_re, lam_im, log_step, b_re, b_im):
    lam_re = lam_re.astype(jnp.float32)
    lam_im = lam_im.astype(jnp.float32)
    dt = jnp.exp(log_step.astype(jnp.float32))[:, None]
    mag = jnp.exp(lam_re * dt)
    abar_re = mag * jnp.cos(lam_im * dt)
    abar_im = mag * jnp.sin(lam_im * dt)
    num_re = abar_re - 1.0
    num_im = abar_im
    den = lam_re * lam_re + lam_im * lam_im
    f_re = (num_re * lam_re + num_im * lam_im) / den
    f_im = (num_im * lam_re - num_re * lam_im) / den
    b_re = b_re.astype(jnp.float32)
    b_im = b_im.astype(jnp.float32)
    bbar_re = f_re[..., None] * b_re - f_im[..., None] * b_im
    bbar_im = f_re[..., None] * b_im + f_im[..., None] * b_re
    return abar_re, abar_im, bbar_re, bbar_im


def s5_scan(u, abar_re, abar_im, bbar_re, bbar_im, h0, reverse):
    bu_re = jnp.einsum('blgc,gpc->blgp', u, bbar_re)
    bu_im = jnp.einsum('blgc,gpc->blgp', u, bbar_im)
    a_re = jnp.broadcast_to(abar_re, bu_re.shape)
    a_im = jnp.broadcast_to(abar_im, bu_re.shape)

    def combine(e1, e2):
        a1r, a1i, b1r, b1i = e1
        a2r, a2i, b2r, b2i = e2
        return (a1r * a2r - a1i * a2i, a1r * a2i + a1i * a2r,
                a2r * b1r - a2i * b1i + b2r, a2r * b1i + a2i * b1r + b2i)

    ar, ai, hr, hi = lax.associative_scan(combine, (a_re, a_im, bu_re, bu_im), reverse=reverse, axis=1)
    if h0 is not None:
        h0r, h0i = h0[0][:, None], h0[1][:, None]
        hr = hr + ar * h0r - ai * h0i
        hi = hi + ar * h0i + ai * h0r
    return hr, hi


def mixer(h, lp, init, rows, need_out):
    bsz, length, _ = h.shape
    f32 = jnp.float32
    w_in = lp['w_in'] if need_out else lp['w_in'][:, :STATE_COLS]
    p = jnp.einsum('bld,de->ble', h, w_in)

    qkv = short_conv(p[..., :QKV_W], lp['conv_w'], rows)

    def heads(t, dh):
        return t.reshape(bsz, length, DN_HEADS, dh).transpose(0, 2, 1, 3).astype(f32)

    q = l2_normalise(heads(qkv[..., :QK_W], DN_DK)) * (DN_DK ** -0.5)
    k = l2_normalise(heads(qkv[..., QK_W:2 * QK_W], DN_DK))
    v = heads(qkv[..., 2 * QK_W:], DN_DV)
    beta = jax.nn.sigmoid(p[..., O_BETA:O_DECAY].astype(f32)).reshape(bsz, length, 2, DN_HEADS)
    beta = beta.transpose(2, 0, 3, 1)
    dec = p[..., O_DECAY:O_U].astype(f32).reshape(bsz, length, 2, DN_HEADS)
    g = -jnp.exp(lp['dn_A_log'].astype(f32)) * jax.nn.softplus(dec + lp['dn_dt_bias'].astype(f32))
    g = g.transpose(2, 0, 3, 1)
    flip = lambda t: jnp.flip(t, axis=2)
    o_f, s_f = gated_delta_chunked(q, k, v, g[0], beta[0], None if init is None else init[0], need_out)
    o_b, s_b = gated_delta_chunked(flip(q), flip(k), flip(v), flip(g[1]), flip(beta[1]),
                                   None if init is None else init[1], need_out)

    u = p[..., O_U:STATE_COLS].astype(f32).reshape(bsz, length, S5_GROUPS, S5_GROUP)
    ssm = []
    finals = []
    for d in range(2):
        reverse = d == 1
        abr, abi, bbr, bbi = s5_discretise(lp['s5_lam_re'][d], lp['s5_lam_im'][d], lp['s5_log_step'][d],
                                           lp['s5_B_re'][d], lp['s5_B_im'][d])
        hr, hi = s5_scan(u, abr, abi, bbr, bbi, None if init is None else init[2 + d], reverse)
        end = 0 if reverse else -1
        finals.append((hr[:, end], hi[:, end]))
        ssm.append((hr, hi))
    states = (s_f, s_b, finals[0], finals[1])
    if not need_out:
        return None, states

    o = (o_f + flip(o_b)).transpose(0, 2, 1, 3)
    o = rms_norm(o, lp['dn_norm_w'])
    z_dn = p[..., O_ZDN:O_ZS5].astype(f32).reshape(bsz, length, DN_HEADS, DN_DV)
    y_dn = (o * jax.nn.silu(z_dn)).reshape(bsz, length, DN_WIDTH).astype(h.dtype)

    y = lp['s5_D'].astype(f32).reshape(S5_GROUPS, S5_GROUP) * u
    for d in range(2):
        hr, hi = ssm[d]
        y = y + jnp.einsum('blgp,gcp->blgc', hr, lp['s5_C_re'][d].astype(f32)) \
            - jnp.einsum('blgp,gcp->blgc', hi, lp['s5_C_im'][d].astype(f32))
    y = jax.nn.gelu(y.reshape(bsz, length, S5_WIDTH))
    y = y * jax.nn.sigmoid(y @ lp['glu_w'].astype(f32) + lp['glu_b'].astype(f32))
    z_s5 = p[..., O_ZS5:O_GDN].astype(f32)
    y_s5 = (y * jax.nn.silu(z_s5)).astype(h.dtype)

    merged = jax.nn.sigmoid(p[..., O_GDN:O_GS5]) * (y_dn @ lp['w_proj_dn']) \
        + jax.nn.sigmoid(p[..., O_GS5:IN_WIDTH]) * (y_s5 @ lp['w_proj_s5'])
    return merged @ lp['w_out'], states


def setup_inputs(seed: int = 0) -> dict:
    key = jax.random.key(seed)
    ks = jax.random.split(key, 28)
    f32 = jnp.float32
    nrm = lambda k_, shape, s: jax.random.normal(k_, shape, f32) * s
    dt = jnp.exp(jax.random.uniform(ks[9], (DEPTH, 2, DN_HEADS), f32, math.log(1e-3), math.log(1e-1)))
    lam_im = jnp.pi * jnp.arange(S5_STATE, dtype=f32)
    return {
        'x': nrm(ks[0], (BATCH, SEQ, D_MODEL), 1.0),
        'c': nrm(ks[1], (BATCH, D_MODEL), 1.0),
        'ctx': nrm(ks[2], (BATCH, CTX_LEN, D_MODEL), 1.0),
        'c_ctx': nrm(ks[3], (D_MODEL,), 1.0),
        'w_ada': nrm(ks[4], (DEPTH, D_MODEL, 3 * D_MODEL), 0.5 * D_MODEL ** -0.5),
        'b_ada': nrm(ks[5], (DEPTH, 3 * D_MODEL), 0.01),
        'norm_w': 1.0 + nrm(ks[6], (DEPTH, D_MODEL), 0.02),
        'w_in': nrm(ks[7], (DEPTH, D_MODEL, IN_WIDTH), D_MODEL ** -0.5),
        'conv_w': nrm(ks[8], (DEPTH, CONV_K, QKV_W), CONV_K ** -0.5),
        'dn_A_log': jnp.log(jax.random.uniform(ks[10], (DEPTH, 2, DN_HEADS), f32, 1.0, 16.0)),
        'dn_dt_bias': dt + jnp.log(-jnp.expm1(-dt)),
        'dn_norm_w': 1.0 + nrm(ks[11], (DEPTH, DN_DV), 0.02),
        's5_lam_re': -0.5 + nrm(ks[12], (DEPTH, 2, S5_GROUPS, S5_STATE), 0.01),
        's5_lam_im': lam_im + nrm(ks[13], (DEPTH, 2, S5_GROUPS, S5_STATE), 0.01),
        's5_log_step': jax.random.uniform(ks[14], (DEPTH, 2, S5_GROUPS), f32, math.log(1e-3), math.log(1e-1)),
        's5_B_re': nrm(ks[15], (DEPTH, 2, S5_GROUPS, S5_STATE, S5_GROUP), (2 * S5_GROUP) ** -0.5),
        's5_B_im': nrm(ks[16], (DEPTH, 2, S5_GROUPS, S5_STATE, S5_GROUP), (2 * S5_GROUP) ** -0.5),
        's5_C_re': nrm(ks[17], (DEPTH, 2, S5_GROUPS, S5_GROUP, S5_STATE), (2 * S5_STATE) ** -0.5),
        's5_C_im': nrm(ks[18], (DEPTH, 2, S5_GROUPS, S5_GROUP, S5_STATE), (2 * S5_STATE) ** -0.5),
        's5_D': nrm(ks[19], (DEPTH, S5_WIDTH), 1.0),
        'glu_w': nrm(ks[20], (DEPTH, S5_WIDTH, S5_WIDTH), S5_WIDTH ** -0.5),
        'glu_b': nrm(ks[21], (DEPTH, S5_WIDTH), 0.01),
        'w_proj_dn': nrm(ks[22], (DEPTH, DN_WIDTH, D_MODEL), DN_WIDTH ** -0.5),
        'w_proj_s5': nrm(ks[23], (DEPTH, S5_WIDTH, D_MODEL), S5_WIDTH ** -0.5),
        'w_out': nrm(ks[24], (DEPTH, D_MODEL, D_MODEL), D_MODEL ** -0.5),
        'final_norm_w': 1.0 + nrm(ks[25], (D_MODEL,), 0.02),
    }


def reference(x, c, ctx, c_ctx, w_ada, b_ada, norm_w, w_in, conv_w, dn_A_log, dn_dt_bias, dn_norm_w,
              s5_lam_re, s5_lam_im, s5_log_step, s5_B_re, s5_B_im, s5_C_re, s5_C_im, s5_D, glu_w, glu_b,
              w_proj_dn, w_proj_s5, w_out, final_norm_w):
    n_rows = x.shape[1] // GRID_W
    cx = ctx
    for i in range(DEPTH):
        lp = {'w_in': w_in[i], 'conv_w': conv_w[i], 'dn_A_log': dn_A_log[i], 'dn_dt_bias': dn_dt_bias[i],
              'dn_norm_w': dn_norm_w[i], 's5_lam_re': s5_lam_re[i], 's5_lam_im': s5_lam_im[i],
              's5_log_step': s5_log_step[i], 's5_B_re': s5_B_re[i], 's5_B_im': s5_B_im[i],
              's5_C_re': s5_C_re[i], 's5_C_im': s5_C_im[i], 's5_D': s5_D[i], 'glu_w': glu_w[i],
              'glu_b': glu_b[i], 'w_proj_dn': w_proj_dn[i], 'w_proj_s5': w_proj_s5[i], 'w_out': w_out[i]}
        last = i == DEPTH - 1
        mod_k = jax.nn.silu(c_ctx) @ w_ada[i] + b_ada[i]
        shift_k, scale_k, gate_k = jnp.split(mod_k, 3, axis=-1)
        hc = rms_norm(cx, norm_w[i]) * (1.0 + scale_k) + shift_k
        ctx_out, ctx_states = mixer(hc, lp, None, None, not last)
        if not last:
            cx = cx + gate_k * ctx_out
        mod_x = jax.nn.silu(c) @ w_ada[i] + b_ada[i]
        shift, scale, gate = jnp.split(mod_x[:, None, :], 3, axis=-1)
        h = rms_norm(x, norm_w[i]) * (1.0 + scale) + shift
        out, _ = mixer(h, lp, ctx_states, n_rows, True)
        x = x + gate * out
    return rms_norm(x, final_norm_w)
```

```cpp
#include <hip/hip_runtime.h>
#include <cstdio>
#include <cstdint>
#define MK_PER_PHASE 1
namespace pg8 {
#define PG8_LAS __attribute__((address_space(3)))
typedef unsigned short bf16_t;
typedef short bf16x8 __attribute__((ext_vector_type(8)));
typedef float f32x4 __attribute__((ext_vector_type(4)));
typedef unsigned u32x4 __attribute__((ext_vector_type(4)));
constexpr int BM = 256, BK = 64, HALF = 128, HTB = HALF * BK * 2  , STAGE_BYTES = 8 * HTB, NXCD = 8, WGM = 8;

__host__ __device__ __forceinline__ int lds_byte(int r, int c) { const int st = (r >> 4) * 2 + (c >> 5), rr = r & 15, cc = c & 31, ob = rr * 64 + cc * 2; return st * 1024 + (ob ^ (((ob >> 9) & 1) << 5)); }
__host__ __device__ __forceinline__ void stage_rc(int b, int& R, int& C) { const int st = b / 1024, sb = b % 1024, swz = sb ^ (((sb >> 9) & 1) << 5); R = (st >> 1) * 16 + swz / 64; C = (st & 1) * 32 + (swz % 64) / 2; }
__host__ __device__ __forceinline__ int perm32(int rho) { const int n = rho >> 4, i = rho & 15; return 8 * (i >> 2) + 4 * n + (i & 3); }

struct Unit { int pm, pn; };
struct Gemm { const bf16_t* A; const bf16_t* Bt; int M, N, K; };

struct StaticOrder {
    int nM, nN, nwg, G, c;
    __host__ __device__ void init(int M, int N, int G_, int c_) { nM = M / BM; nN = N / BM; nwg = nM * nN; G = G_; c = c_; }
    __host__ __device__ bool next(int i, Unit& u) const {
        const long L = (long)i * G + c; if (L >= nwg) return false;
        int wgid = (int)L; { const int q = nwg / NXCD, r = nwg % NXCD, xcd = wgid % NXCD, off = wgid / NXCD; wgid = (xcd < r ? xcd * (q + 1) : r * (q + 1) + (xcd - r) * q) + off; }
        const int nig = WGM * nN, gid = wgid / nig, fm = gid * WGM, gsz = (nM - fm) < WGM ? (nM - fm) : WGM;
        u.pm = fm + ((wgid % nig) % gsz); u.pn = (wgid % nig) / gsz; return true;
    }
    __device__ __forceinline__ void a_ready(const Unit&) const {}
    __device__ __forceinline__ void done(const Unit&) const {}
};

__device__ __forceinline__ unsigned cvt_pk_bf16(float lo, float hi) { unsigned r; asm volatile("v_cvt_pk_bf16_f32 %0, %1, %2" : "=v"(r) : "v"(lo), "v"(hi)); return r; }
template <class Epi, class Sched, bool ALIGN_EPI = false, bool SP2 = false>
__device__ __forceinline__ void gemm_phase(PG8_LAS unsigned char* lds, const Gemm g, const Sched& S, const Epi& E) {
    const int tid = threadIdx.x, wid = __builtin_amdgcn_readfirstlane(tid >> 6), lane = tid & 63, wr = wid >> 2, wc = wid & 3, fr = lane & 15, fq = lane >> 4;
    const int K = g.K, nt = K / BK;
    unsigned voffA[2], voffB[2];
#pragma unroll
    for (int i = 0; i < 2; ++i) { int R, C; stage_rc(tid * 16 + i * 8192, R, C); const int Rb = Epi::PERM ? ((R & ~31) + perm32(R & 31)) : R;
        voffA[i] = (unsigned)(R * K + C) * 2u; voffB[i] = (unsigned)(Rb * K + C) * 2u; }
    const size_t kstep = (size_t)(BK * 2);
    const size_t hstep = (size_t)HALF * K * 2;
    const size_t tstep = 2 * hstep;
    const unsigned ldsw = (unsigned)wid * 1024u;
    const int aoff = lds_byte(wr * 64 + fr, fq * 8), boff = lds_byte(wc * 32 + fr, fq * 8);
#define PG8_SA(b, h) (((b) * 2 + (h)) * HTB)
#define PG8_SB(b, h) ((4 + (b) * 2 + (h)) * HTB)
#define PG8_STAGE(bufoff, gbase, voff) do { _Pragma("unroll") for (int _i = 0; _i < 2; ++_i) \
        __builtin_amdgcn_global_load_lds((const unsigned*)((const char*)(gbase) + (voff)[_i]), (PG8_LAS unsigned*)(lds + (bufoff) + ldsw + _i * 8192), 16, 0, 0); } while (0)
#define PG8_LDA(dst, b, h) do { _Pragma("unroll") for (int m = 0; m < 4; ++m) _Pragma("unroll") for (int k = 0; k < 2; ++k) dst[m][k] = *(const PG8_LAS bf16x8*)(lds + PG8_SA(b, h) + aoff + m * 2048 + k * 1024); } while (0)
#define PG8_LDB(dst, b, h) do { _Pragma("unroll") for (int n = 0; n < 2; ++n) _Pragma("unroll") for (int k = 0; k < 2; ++k) dst[n][k] = *(const PG8_LAS bf16x8*)(lds + PG8_SB(b, h) + boff + n * 2048 + k * 1024); } while (0)
#define PG8_MMA(ai, bj, At, Bt) do { __builtin_amdgcn_s_setprio(1); _Pragma("unroll") for (int m = 0; m < 4; ++m) _Pragma("unroll") for (int n = 0; n < 2; ++n) _Pragma("unroll") for (int k = 0; k < 2; ++k) \
        acc[ai][bj][m][n] = __builtin_amdgcn_mfma_f32_16x16x32_bf16(Bt[n][k], At[m][k], acc[ai][bj][m][n], 0, 0, 0); __builtin_amdgcn_s_setprio(0); } while (0)
#define PG8_WAIT_V(n) asm volatile("s_waitcnt vmcnt(" #n ")" ::: "memory")
#define PG8_WAIT_L(n) asm volatile("s_waitcnt lgkmcnt(" #n ")" ::: "memory")
#define PG8_BAR __builtin_amdgcn_s_barrier()
#define PG8_SCHED __builtin_amdgcn_sched_barrier(0)
    Unit cur, nxt; int ui = 0;
    if (!S.next(0, cur)) return;
    f32x4 acc[2][2][4][2];
#pragma unroll
    for (int a = 0; a < 2; ++a)
#pragma unroll
        for (int b = 0; b < 2; ++b)
#pragma unroll
            for (int m = 0; m < 4; ++m)
#pragma unroll
                for (int n = 0; n < 2; ++n) acc[a][b][m][n] = (f32x4){0.f, 0.f, 0.f, 0.f};
    bf16x8 At[4][2], B0[2][2], B1[2][2];
    const char* cA = (const char*)g.A + (size_t)cur.pm * tstep; const char* cB = (const char*)g.Bt + (size_t)cur.pn * tstep;
    S.a_ready(cur);
    if constexpr (SP2) {
        PG8_STAGE(PG8_SB(0, 0), cB, voffB); PG8_STAGE(PG8_SB(0, 1), cB + hstep, voffB); PG8_STAGE(PG8_SA(0, 0), cA, voffA); PG8_STAGE(PG8_SA(0, 1), cA + hstep, voffA);
        if (wr == 1) PG8_BAR;
        PG8_WAIT_V(2); PG8_BAR;
        PG8_STAGE(PG8_SB(1, 0), cB + kstep, voffB); PG8_STAGE(PG8_SA(1, 0), cA + kstep, voffA); PG8_STAGE(PG8_SB(1, 1), cB + hstep + kstep, voffB);
        PG8_WAIT_V(6); PG8_BAR;
    } else {
        PG8_STAGE(PG8_SB(0, 0), cB, voffB); PG8_STAGE(PG8_SA(0, 0), cA, voffA); PG8_STAGE(PG8_SB(0, 1), cB + hstep, voffB); PG8_STAGE(PG8_SA(0, 1), cA + hstep, voffA);
        if (wr == 1) PG8_BAR;
        PG8_WAIT_V(4); PG8_BAR;
        PG8_STAGE(PG8_SB(1, 0), cB + kstep, voffB); PG8_STAGE(PG8_SA(1, 0), cA + kstep, voffA); PG8_STAGE(PG8_SB(1, 1), cB + hstep + kstep, voffB);
        PG8_WAIT_V(6); PG8_BAR;
    }
    for (;;) {
        const bool has_next = S.next(ui + 1, nxt);
        const char* nA = has_next ? (const char*)g.A + (size_t)nxt.pm * tstep : cA; const char* nB = has_next ? (const char*)g.Bt + (size_t)nxt.pn * tstep : cB;
        for (int t = 0; t < nt; t += 2) {
            const bool last = (t == nt - 2);
            const char* a1 = cA + (size_t)(t + 1) * kstep;
            const char* a2 = last ? nA : cA + (size_t)(t + 2) * kstep; const char* b2 = last ? nB : cB + (size_t)(t + 2) * kstep;
            const char* a3 = a2 + kstep; const char* b3 = b2 + kstep;
            if (last && has_next) S.a_ready(nxt);
            if constexpr (SP2) {
            PG8_LDB(B0, 0, 0); PG8_LDB(B1, 0, 1); PG8_SCHED; PG8_LDA(At, 0, 0); PG8_STAGE(PG8_SA(1, 1), a1 + hstep, voffA);
            PG8_WAIT_V(8); PG8_WAIT_L(0); PG8_BAR; PG8_MMA(0, 0, At, B0); PG8_MMA(0, 1, At, B1); PG8_BAR; PG8_SCHED;
            PG8_LDA(At, 0, 1); PG8_STAGE(PG8_SB(0, 0), b2, voffB); PG8_STAGE(PG8_SB(0, 1), b2 + hstep, voffB); PG8_STAGE(PG8_SA(0, 0), a2, voffA);
            PG8_WAIT_V(8); PG8_WAIT_L(0); PG8_BAR; PG8_MMA(1, 0, At, B0); PG8_MMA(1, 1, At, B1); PG8_BAR; PG8_SCHED;
            PG8_LDB(B0, 1, 0); PG8_LDB(B1, 1, 1); PG8_SCHED; PG8_LDA(At, 1, 0); PG8_STAGE(PG8_SA(0, 1), a2 + hstep, voffA);
            PG8_WAIT_V(8); PG8_WAIT_L(0); PG8_BAR; PG8_MMA(0, 0, At, B0); PG8_MMA(0, 1, At, B1); PG8_BAR; PG8_SCHED;
            PG8_LDA(At, 1, 1); PG8_STAGE(PG8_SB(1, 0), b3, voffB); PG8_STAGE(PG8_SB(1, 1), b3 + hstep, voffB); PG8_STAGE(PG8_SA(1, 0), a3, voffA);
            PG8_WAIT_V(8); PG8_WAIT_L(0); PG8_BAR; PG8_MMA(1, 0, At, B0); PG8_MMA(1, 1, At, B1); PG8_BAR; PG8_SCHED;
            } else {
            PG8_LDB(B0, 0, 0); PG8_SCHED; PG8_LDA(At, 0, 0); PG8_STAGE(PG8_SA(1, 1), a1 + hstep, voffA);
            PG8_WAIT_L(8); PG8_BAR; PG8_WAIT_L(0); PG8_MMA(0, 0, At, B0); PG8_BAR; PG8_SCHED;
            PG8_LDB(B1, 0, 1); PG8_STAGE(PG8_SB(0, 0), b2, voffB);
            PG8_BAR; PG8_WAIT_L(0); PG8_MMA(0, 1, At, B1); PG8_BAR;
            PG8_LDA(At, 0, 1); PG8_STAGE(PG8_SA(0, 0), a2, voffA);
            PG8_BAR; PG8_WAIT_L(0); PG8_MMA(1, 0, At, B0); PG8_BAR; PG8_SCHED;
            PG8_STAGE(PG8_SB(0, 1), b2 + hstep, voffB);
            PG8_WAIT_V(6); PG8_BAR; PG8_MMA(1, 1, At, B1); PG8_BAR;
            PG8_LDB(B0, 1, 0); PG8_SCHED; PG8_LDA(At, 1, 0); PG8_STAGE(PG8_SA(0, 1), a2 + hstep, voffA);
            PG8_WAIT_L(8); PG8_BAR; PG8_WAIT_L(0); PG8_MMA(0, 0, At, B0); PG8_BAR; PG8_SCHED;
            PG8_LDB(B1, 1, 1); PG8_STAGE(PG8_SB(1, 0), b3, voffB);
            PG8_BAR; PG8_WAIT_L(0); PG8_MMA(0, 1, At, B1); PG8_BAR;
            PG8_LDA(At, 1, 1); PG8_STAGE(PG8_SA(1, 0), a3, voffA);
            PG8_BAR; PG8_WAIT_L(0); PG8_MMA(1, 0, At, B0); PG8_BAR; PG8_SCHED;
            PG8_STAGE(PG8_SB(1, 1), b3 + hstep, voffB);
            PG8_WAIT_V(6); PG8_BAR; PG8_MMA(1, 1, At, B1); PG8_BAR;
            }
        }
        if constexpr (ALIGN_EPI) { if (wr == 0) PG8_BAR; }
        if constexpr (!Epi::AFTER_DRAIN) { E(acc, cur, wr, wc, fr, fq); S.done(cur); }
        if (!has_next) break;
#pragma unroll
        for (int a = 0; a < 2; ++a)
#pragma unroll
            for (int b = 0; b < 2; ++b)
#pragma unroll
                for (int m = 0; m < 4; ++m)
#pragma unroll
                    for (int n = 0; n < 2; ++n) acc[a][b][m][n] = (f32x4){0.f, 0.f, 0.f, 0.f};
        cur = nxt; cA = nA; cB = nB; ++ui;
        if constexpr (ALIGN_EPI) { if (wr == 1) PG8_BAR; }
    }
    PG8_WAIT_V(0);
    if constexpr (!ALIGN_EPI) { if (wr == 0) PG8_BAR; }
    PG8_BAR;
    if constexpr (Epi::AFTER_DRAIN) { E.fused(acc, cur, wr, wc, fr, fq, lds, wid, lane); S.done(cur); }
#undef PG8_SA
#undef PG8_SB
#undef PG8_STAGE
#undef PG8_LDA
#undef PG8_LDB
#undef PG8_MMA
#undef PG8_WAIT_V
#undef PG8_WAIT_L
#undef PG8_BAR
#undef PG8_SCHED
}
}
#define GAS __attribute__((address_space(1)))
#define LAS __attribute__((address_space(3)))
typedef unsigned short bf16;
typedef unsigned v4u __attribute__((ext_vector_type(4)));
typedef float f32x4 __attribute__((ext_vector_type(4)));
typedef short bf16x8 __attribute__((ext_vector_type(8)));
typedef GAS unsigned gu32;
typedef GAS unsigned long long gu64;
#define RLX_AGENT __ATOMIC_RELAXED, __HIP_MEMORY_SCOPE_AGENT
#define LDS_WAIT() asm volatile("s_waitcnt lgkmcnt(0)" ::: "memory")
#define VM_WAIT() asm volatile("s_waitcnt vmcnt(0)" ::: "memory")
__device__ __forceinline__ unsigned long long rt() { return __builtin_amdgcn_s_memrealtime(); }
__device__ __forceinline__ unsigned f2bf(float f) { unsigned u = __builtin_bit_cast(unsigned, f); return (u + 0x7fffu + ((u >> 16) & 1u)) >> 16; }
__device__ __forceinline__ unsigned pk2(float lo, float hi) { return f2bf(lo) | (f2bf(hi) << 16); }

#define XB_TMO      128
#define XB_XCNT(j)  (256  + 64 * (j))
#define XB_XSUB(j)  (1280 + 64 * (j))
#define XB_XGEN(j)  (2304 + 64 * (j))
#define XB_TOP      3328
#define XB_TOPGEN   3392
#define XCD_BAR_WORDS 3456
#define XB_SPIN_CAP (1u << 18)

__device__ __forceinline__ unsigned xb_ld(unsigned* p)              { return __hip_atomic_load(p, __ATOMIC_RELAXED, __HIP_MEMORY_SCOPE_AGENT); }
__device__ __forceinline__ unsigned xb_add(unsigned* p, unsigned v) { return __hip_atomic_fetch_add(p, v, __ATOMIC_RELAXED, __HIP_MEMORY_SCOPE_AGENT); }
__device__ __forceinline__ unsigned xb_xcc_id() { return (unsigned)__builtin_amdgcn_s_getreg((3 << 11) | 20) & 0xFu; }
#define XB_SPIN(cond, bar) do { unsigned _sp = 0; while (cond) { __builtin_amdgcn_s_sleep(1); \
    if ((++_sp & 255u) == 0u) { if (xb_ld(&(bar)[XB_TMO])) break; if (_sp > XB_SPIN_CAP) { atomicAdd(&(bar)[XB_TMO], 1u); break; } } } } while (0)

struct XcdBarrier {
    unsigned* bar; unsigned x;
    volatile LAS unsigned* st;
};

__device__ __forceinline__ XcdBarrier xcd_barrier_post(unsigned* bar, volatile LAS unsigned* st) {
    XcdBarrier b; b.bar = bar; b.x = xb_xcc_id(); b.st = st;
    if (threadIdx.x == 0) (void)xb_add(&bar[XB_XCNT(b.x)], 1u);
    return b;
}
__device__ __forceinline__ void xcd_barrier_complete(unsigned* bar, unsigned x, unsigned& nloc, unsigned& nx) {
    const unsigned G = gridDim.x * gridDim.y * gridDim.z;
    unsigned sum, cnt, mine, sp = 0u;
    for (;;) {
        sum = 0u; cnt = 0u; mine = 0u;
#pragma unroll
        for (unsigned j = 0; j < 16; ++j) { const unsigned c = xb_ld(&bar[XB_XCNT(j)]); sum += c; cnt += (c > 0u) ? 1u : 0u; mine = (j == x) ? c : mine; }
        if (sum == G) break;
        __builtin_amdgcn_s_sleep(1);
        if ((++sp & 255u) == 0u) { if (xb_ld(&bar[XB_TMO])) break; if (sp > XB_SPIN_CAP) { atomicAdd(&bar[XB_TMO], 1u); break; } }
    }
    nloc = mine > 0u ? mine : 1u; nx = cnt > 0u ? cnt : 1u;
}

__device__ __forceinline__ void xcd_barrier(const XcdBarrier& b) {
    asm volatile("s_waitcnt vmcnt(0)" ::: "memory");
    __syncthreads();
    if (threadIdx.x == 0) {
        unsigned* bar = b.bar;
        __builtin_amdgcn_s_waitcnt(0);
        unsigned nloc = b.st[0], nx = b.st[1];
        if (nloc == 0u) { xcd_barrier_complete(bar, b.x, nloc, nx); b.st[0] = nloc; b.st[1] = nx; }
        const unsigned old = xb_add(&bar[XB_XSUB(b.x)], 1u);
        const unsigned gen = old / nloc;
        if (old + 1u == (gen + 1u) * nloc) {
            __builtin_amdgcn_fence(__ATOMIC_RELEASE, "agent");
            asm volatile("s_waitcnt vmcnt(0)" ::: "memory");
            const unsigned og = xb_add(&bar[XB_TOP], 1u);
            const unsigned tg = og / nx;
            if (og + 1u == (tg + 1u) * nx) xb_add(&bar[XB_TOPGEN], 1u);
            else XB_SPIN(xb_ld(&bar[XB_TOPGEN]) == tg, bar);
            __builtin_amdgcn_fence(__ATOMIC_ACQUIRE, "agent");
            xb_add(&bar[XB_XGEN(b.x)], 1u);
            asm volatile("s_waitcnt vmcnt(0)" ::: "memory");
        } else {
            XB_SPIN(xb_ld(&bar[XB_XGEN(b.x)]) == gen, bar);
            __builtin_amdgcn_fence(__ATOMIC_ACQUIRE, "agent");
            asm volatile("s_waitcnt vmcnt(0)" ::: "memory");
        }
    }
    __syncthreads();
}
constexpr int NWAVES = 8, NTHR = 512;
#ifndef MK_PER_PHASE
#define MK_PER_PHASE 0
#endif
constexpr int NPHASE = 13;
constexpr int BATCH = 2, SEQ = 8192, D = 1024, T = BATCH * SEQ, LCTX = 256, TCX = BATCH * LCTX, MROWS = T + TCX;
constexpr int NH = 8, CHK = 64, NCHL = SEQ / CHK, NCHC = LCTX / CHK, NCH = NCHL + NCHC;
constexpr int INW = 7200, NPAD = 7424;
constexpr float EPS = 1e-6f;
constexpr size_t MiB = 1u << 20;
constexpr size_t WS_CTL = 0, CTL_ZERO_BYTES = 1 * MiB;
constexpr size_t WS_TAB = 1 * MiB;
constexpr size_t TAB_MODP = 0, TAB_GATE = 589824, TAB_ABAR = 598016, TAB_A64 = 630784, TAB_BBAR = 663552;
constexpr size_t WS_WIN = 3 * MiB, WS_WPD = WS_WIN + (size_t)NPAD * D * 2, WS_WPS = WS_WPD + 2 * MiB, WS_WOUT = WS_WPS + 1 * MiB, WS_GLU = WS_WOUT + 2 * MiB;
constexpr size_t WS_QKV = 23 * MiB, WS_QKVC = 119 * MiB, WS_U = 122 * MiB, WS_BD = WS_U + (size_t)MROWS * 512 * 2, WS_RG = 141 * MiB, WS_CTXTA = 253 * MiB, WS_END = 254 * MiB;
static_assert(WS_GLU + 512 * 512 * 2 <= WS_QKV && WS_BD + (size_t)MROWS * 32 * 4 <= WS_RG, "ws map");
constexpr size_t WS_TA = WS_RG, WS_ODIR = WS_RG + 32 * MiB, WS_YDN = WS_RG, WS_M1 = WS_RG + 32 * MiB, WS_MERGED = WS_RG + 64 * MiB, WS_ZS5 = WS_RG + 96 * MiB;
constexpr size_t WS_ZDN = WS_QKV, WS_GDN = WS_QKV + 32 * MiB, WS_GS5 = WS_QKV + 64 * MiB, WS_YS5 = WS_U;
constexpr size_t DO_H = 0, DO_SC = 33 * MiB, DO_EH = 37 * MiB, DO_Y = 46 * MiB;
constexpr int SCN = 2 * 2 * 8 * (NCH * 64);
constexpr int CW_BAR = 4096;
constexpr int RING_BYTES = 143360, LDSCTL_OFF = RING_BYTES, MISC_OFF = LDSCTL_OFF + 320, LDS_BYTES = 147456;
typedef float f32x2 __attribute__((ext_vector_type(2)));
__device__ __forceinline__ float bf2f(unsigned v) { return __builtin_bit_cast(float, v << 16); }
__device__ __forceinline__ float sigmoidf_(float x) { return 1.f / (1.f + __expf(-x)); }
__device__ __forceinline__ float siluf_(float x) { return x / (1.f + __expf(-x)); }
__device__ __forceinline__ float softplusf_(float x) { return x > 20.f ? x : log1pf(__expf(x)); }
__device__ __forceinline__ float gelu_tanh(float x) { const float u = 0.7978845608028654f * (x + 0.044715f * x * x * x); const float e = __expf(2.f * u); const float th = 1.f - 2.f / (e + 1.f); return 0.5f * x * (1.f + th); }
__device__ __forceinline__ void unpack8(const v4u r, float* f) { f[0] = bf2f(r.x & 0xffffu); f[1] = bf2f(r.x >> 16); f[2] = bf2f(r.y & 0xffffu); f[3] = bf2f(r.y >> 16); f[4] = bf2f(r.z & 0xffffu); f[5] = bf2f(r.z >> 16); f[6] = bf2f(r.w & 0xffffu); f[7] = bf2f(r.w >> 16); }
__device__ __forceinline__ v4u pack8(const float* f) { v4u o; o.x = pk2(f[0], f[1]); o.y = pk2(f[2], f[3]); o.z = pk2(f[4], f[5]); o.w = pk2(f[6], f[7]); return o; }
__device__ __forceinline__ float wave_sum(float v) {
#pragma unroll
    for (int o = 1; o < 64; o <<= 1) v += __shfl_xor(v, o);
    return v;
}

struct Frame {
    LAS unsigned char* lds;
    int tid, lane, wave, vcu, G;
    const float* in[26]; float* out; unsigned char* ws;
};
#define WSP(T_, off) ((T_*)(F.ws + (off)))
#define DOP(T_, off) ((T_*)((unsigned char*)F.out + (off)))
#define TABP(T_, off) ((T_*)(F.ws + WS_TAB + (off)))
enum { I_X = 0, I_C, I_CTX, I_CCTX, I_WADA, I_BADA, I_NORMW, I_WIN, I_CONVW, I_ALOG, I_DTB, I_DNNW, I_LRE, I_LIM, I_LSTEP, I_BRE, I_BIM, I_CRE, I_CIM, I_S5D, I_GLUW, I_GLUB, I_WPD, I_WPS, I_WOUT, I_FNW };

__device__ __forceinline__ void tr_item(const float* W, int K, int N, bf16* WT, LAS float* scr, int k0, int sn0, int dn0, int lane) {
#pragma unroll 8
    for (int i = 0; i < 32; ++i) { const int kk = 2 * i + (lane >> 5); scr[kk * 33 + (lane & 31)] = W[(size_t)(k0 + kk) * N + sn0 + (lane & 31)]; }
    LDS_WAIT(); asm volatile("" ::: "memory");
    const int c = lane & 7;
#pragma unroll
    for (int j = 0; j < 4; ++j) { const int n = (lane >> 3) + 8 * j; const LAS float* s = scr + (8 * c) * 33 + n;
        v4u o; o.x = pk2(s[0 * 33], s[1 * 33]); o.y = pk2(s[2 * 33], s[3 * 33]); o.z = pk2(s[4 * 33], s[5 * 33]); o.w = pk2(s[6 * 33], s[7 * 33]);
        *(v4u*)(WT + (size_t)(dn0 + n) * K + k0 + 8 * c) = o; }
    LDS_WAIT(); asm volatile("" ::: "memory");
}
__device__ __forceinline__ void phase0(Frame& F) {
    LAS float* scr = (LAS float*)(F.lds + F.wave * 16384);
    const int gw = F.vcu * NWAVES + F.wave, NGW = F.G * NWAVES, lane = F.lane;
    constexpr int N_WIN = 16 * 225, N_PD = 512, N_PS = 256, N_OUT = 512, N_GLU = 128, N_Z = 28, N_MOD = 768, N_S5 = 64;
    constexpr int N_ALL = N_WIN + N_PD + N_PS + N_OUT + N_GLU + N_Z + N_MOD + N_S5;
    for (int it = gw; it < N_ALL; it += NGW) {
        int r = it;
        if (r < N_WIN) { const int kb = r / 225, sb = r % 225, db = sb < 96 ? sb : (sb == 96 ? 224 : sb - 1); tr_item(F.in[I_WIN], 1024, INW, WSP(bf16, WS_WIN), scr, kb * 64, sb * 32, db * 32, lane); continue; } r -= N_WIN;
        if (r < N_PD) { tr_item(F.in[I_WPD], 1024, 1024, WSP(bf16, WS_WPD), scr, (r / 32) * 64, (r % 32) * 32, (r % 32) * 32, lane); continue; } r -= N_PD;
        if (r < N_PS) { tr_item(F.in[I_WPS], 512, 1024, WSP(bf16, WS_WPS), scr, (r / 32) * 64, (r % 32) * 32, (r % 32) * 32, lane); continue; } r -= N_PS;
        if (r < N_OUT) { tr_item(F.in[I_WOUT], 1024, 1024, WSP(bf16, WS_WOUT), scr, (r / 32) * 64, (r % 32) * 32, (r % 32) * 32, lane); continue; } r -= N_OUT;
        if (r < N_GLU) { tr_item(F.in[I_GLUW], 512, 512, WSP(bf16, WS_GLU), scr, (r / 16) * 64, (r % 16) * 32, (r % 16) * 32, lane); continue; } r -= N_GLU;
        if (r < N_Z) { v4u* zb = (v4u*)(WSP(bf16, WS_WIN) + (size_t)INW * 1024 + (size_t)r * 8192); const v4u z = {0u, 0u, 0u, 0u};
#pragma unroll
            for (int j = 0; j < 16; ++j) zb[j * 64 + lane] = z; continue; } r -= N_Z;
        if (r < N_MOD) { const int ks = r / 48, j = (r % 48) * 64 + lane; float s0 = 0.f, s1 = 0.f, s2 = 0.f;
            const float* wa = F.in[I_WADA]; const float* cv = F.in[I_C]; const float* cc = F.in[I_CCTX];
#pragma unroll 8
            for (int k = ks * 64; k < ks * 64 + 64; ++k) { const float w = wa[(size_t)k * 3072 + j]; s0 += siluf_(cv[k]) * w; s1 += siluf_(cv[1024 + k]) * w; s2 += siluf_(cc[k]) * w; }
            float* mp = TABP(float, TAB_MODP); mp[(ks * 3 + 0) * 3072 + j] = s0; mp[(ks * 3 + 1) * 3072 + j] = s1; mp[(ks * 3 + 2) * 3072 + j] = s2; continue; } r -= N_MOD;
        { const int idx = r * 64 + lane;
          const int dg = idx >> 6;
          const float lre = F.in[I_LRE][idx], lim = F.in[I_LIM][idx], dt = __expf(F.in[I_LSTEP][dg]);
          const float th = lim * dt, mag = __expf(lre * dt), ct = cosf(th), st = sinf(th), sh = sinf(0.5f * th);
          const float ar = mag * ct, ai = mag * st;
          const float nr = expm1f(lre * dt) * ct - 2.f * sh * sh, ni = ai, den = lre * lre + lim * lim;
          const float fr = (nr * lre + ni * lim) / den, fi = (ni * lre - nr * lim) / den;
          TABP(f32x2, TAB_ABAR)[idx] = (f32x2){ar, ai};
          const double th64 = (double)lim * (double)dt * 64.0; const double tw = th64 - 6.283185307179586 * rint(th64 / 6.283185307179586);
          const float m64 = __expf(64.f * lre * dt);
          TABP(f32x2, TAB_A64)[idx] = (f32x2){m64 * cosf((float)tw), m64 * sinf((float)tw)};
          const float* bre = F.in[I_BRE] + (size_t)idx * 16; const float* bim = F.in[I_BIM] + (size_t)idx * 16; f32x2* bb = TABP(f32x2, TAB_BBAR) + (size_t)idx * 16;
#pragma unroll
          for (int c = 0; c < 16; ++c) bb[c] = (f32x2){fr * bre[c] - fi * bim[c], fr * bim[c] + fi * bre[c]}; }
    }
}
__device__ __forceinline__ void phase1(Frame& F) {
    LAS float* mult = (LAS float*)F.lds; LAS float* shf = mult + 3072;
    const float* mp = TABP(float, TAB_MODP); const float* bada = F.in[I_BADA]; const float* nw = F.in[I_NORMW];
    for (int e = F.tid; e < 3072; e += NTHR) { const int v = e >> 10, d = e & 1023; float sh = bada[d], sc = bada[1024 + d];
        for (int ks = 0; ks < 16; ++ks) { sh += mp[(ks * 3 + v) * 3072 + d]; sc += mp[(ks * 3 + v) * 3072 + 1024 + d]; }
        mult[e] = nw[d] * (1.f + sc); shf[e] = sh; }
    if (blockIdx.x == 0) for (int e = F.tid; e < 2048; e += NTHR) { const int v = e >> 10, d = e & 1023; float gt = bada[2048 + d];
        for (int ks = 0; ks < 16; ++ks) gt += mp[(ks * 3 + v) * 3072 + 2048 + d];
        TABP(float, TAB_GATE)[e] = gt; }
    __syncthreads();
    const int gw = F.vcu * NWAVES + F.wave, NGW = F.G * NWAVES;
    bf16* Hb = DOP(bf16, DO_H);
    for (int r = gw; r < MROWS; r += NGW) {
        const int v = r < SEQ ? 0 : (r < T ? 1 : 2);
        const float* src = r < T ? F.in[I_X] + (size_t)r * D : F.in[I_CTX] + (size_t)(r - T) * D;
        const f32x4* xr = (const f32x4*)src + F.lane;
        f32x4 xv[4]; float s = 0.f;
#pragma unroll
        for (int j = 0; j < 4; ++j) { xv[j] = xr[64 * j]; s += (xv[j].x * xv[j].x + xv[j].y * xv[j].y) + (xv[j].z * xv[j].z + xv[j].w * xv[j].w); }
        const float rinv = 1.f / sqrtf(wave_sum(s) * (1.f / D) + EPS);
        unsigned long long* o8 = (unsigned long long*)(Hb + (size_t)r * D) + F.lane;
#pragma unroll
        for (int j = 0; j < 4; ++j) { const int e0 = v * 1024 + 4 * F.lane + 256 * j;
            const f32x4 m = *(const LAS f32x4*)(mult + e0), sh = *(const LAS f32x4*)(shf + e0);
            const f32x4 y = xv[j] * rinv * m + sh;
            o8[64 * j] = (unsigned long long)pk2(y.x, y.y) | ((unsigned long long)pk2(y.z, y.w) << 32); }
    }
}
struct OrderIn {
    pg8::StaticOrder so; bool first;
    __device__ void init(bool first_, int G, int c) { first = first_; if (first_) so.init(MROWS, 15 * 256, G, c); else so.init(T, 14 * 256, G, c); }
    __device__ bool next(int i, pg8::Unit& u) const {
        if (!so.next(i, u)) return false;
        u.pn = first ? (u.pn < 14 ? u.pn : 28) : u.pn + 14; return true;
    }
    __device__ __forceinline__ void a_ready(const pg8::Unit&) const {}
    __device__ __forceinline__ void done(const pg8::Unit&) const {}
};
struct EpiIn {
    static constexpr bool PERM = true, AFTER_DRAIN = false;
    bf16 *QKV, *QKVC, *U, *ZDN, *ZS5, *GDN, *GS5; float* BD;
    __device__ __forceinline__ void operator()(const f32x4 (&acc)[2][2][4][2], const pg8::Unit& u, int wr, int wc, int fr, int fq) const {
        const int pn = u.pn; const bool ctx = u.pm >= 64;
#pragma unroll
        for (int ai = 0; ai < 2; ++ai)
#pragma unroll
            for (int m = 0; m < 4; ++m) {
                const int row = u.pm * 256 + ai * 128 + wr * 64 + m * 16 + fr;
#pragma unroll
                for (int bj = 0; bj < 2; ++bj) {
                    const f32x4 v0 = acc[ai][bj][m][0], v1 = acc[ai][bj][m][1];
                    float f[8] = {v0[0], v0[1], v0[2], v0[3], v1[0], v1[1], v1[2], v1[3]};
                    const int colin = bj * 128 + wc * 32 + 8 * fq;
                    if (pn < 12) {
                        const int which = pn >> 2, head = 2 * (pn & 3) + bj, d0 = wc * 32 + 8 * fq;
                        bf16* dst;
                        if (!ctx) { const int b = row >> 13, t = row & 8191; dst = QKV + ((size_t)(((which * 2 + b) * 8 + head) * SEQ + t)) * 128 + d0; }
                        else { const int rr = row - T, b = rr >> 8, t = rr & 255; dst = QKVC + ((size_t)(((which * 2 + b) * 8 + head) * LCTX + t)) * 128 + d0; }
                        *(v4u*)dst = pack8(f);
                    } else if (pn < 14) {
                        *(v4u*)(U + (size_t)row * 512 + (pn - 12) * 256 + colin) = pack8(f);
                    } else if (pn < 28) {
                        if (!ctx) {
                            if (pn < 20) {
#pragma unroll
                                for (int e = 0; e < 8; ++e) f[e] = siluf_(f[e]);
                                if (pn < 18) *(v4u*)(ZDN + (size_t)row * 1024 + (pn - 14) * 256 + colin) = pack8(f);
                                else *(v4u*)(ZS5 + (size_t)row * 512 + (pn - 18) * 256 + colin) = pack8(f);
                            } else {
#pragma unroll
                                for (int e = 0; e < 8; ++e) f[e] = sigmoidf_(f[e]);
                                if (pn < 24) *(v4u*)(GDN + (size_t)row * 1024 + (pn - 20) * 256 + colin) = pack8(f);
                                else *(v4u*)(GS5 + (size_t)row * 1024 + (pn - 24) * 256 + colin) = pack8(f);
                            }
                        }
                    } else {
                        if (bj == 0 && wc == 0) { float* dst = BD + (size_t)row * 32 + 8 * fq; *(f32x4*)dst = v0; *(f32x4*)(dst + 4) = v1; }
                    }
                }
            }
    }
};
__device__ __forceinline__ void phase3(Frame& F) {
    LAS float* xs = (LAS float*)F.lds;
    const float* cw = F.in[I_CONVW];
    constexpr int NU = 48 + 3 * 16 * NCHL;
    for (int uid = F.vcu; uid < NU; uid += F.G) {
        int which, bh, Lu; bf16* base;
        if (uid < 48) { which = uid / 16; bh = uid % 16; Lu = LCTX; base = WSP(bf16, WS_QKVC) + (size_t)((which * 16 + bh) * LCTX) * 128; }
        else { const int v = uid - 48; which = v / (16 * NCHL); const int rem = v % (16 * NCHL); bh = rem / NCHL; const int lc = rem % NCHL; Lu = CHK; base = WSP(bf16, WS_QKV) + ((size_t)(which * 16 + bh) * SEQ + lc * CHK) * 128; }
        const int h = bh & 7;
        for (int idx = F.tid; idx < Lu * 16; idx += NTHR) { const int row = idx >> 4, c8 = idx & 15; const v4u raw = *(const v4u*)(base + row * 128 + c8 * 8); float f[8]; unpack8(raw, f);
            *(LAS f32x4*)(xs + row * 128 + c8 * 8) = (f32x4){f[0], f[1], f[2], f[3]}; *(LAS f32x4*)(xs + row * 128 + c8 * 8 + 4) = (f32x4){f[4], f[5], f[6], f[7]}; }
        __syncthreads();
        const int c = F.tid & 127, tq = F.tid >> 7, n = Lu >> 2, t0 = tq * n, ch = which * 1024 + h * 128 + c;
        const float w0 = cw[ch], w1 = cw[3072 + ch], w2 = cw[2 * 3072 + ch], w3 = cw[3 * 3072 + ch], w4 = cw[4 * 3072 + ch];
        const float hm2 = t0 >= 2 ? xs[(t0 - 2) * 128 + c] : 0.f, hm1 = t0 >= 1 ? xs[(t0 - 1) * 128 + c] : 0.f;
        const float hp1 = t0 + n < Lu ? xs[(t0 + n) * 128 + c] : 0.f, hp2 = t0 + n + 1 < Lu ? xs[(t0 + n + 1) * 128 + c] : 0.f;
        __syncthreads();
        float xm2 = hm2, xm1 = hm1, x0 = xs[t0 * 128 + c], xp1 = xs[(t0 + 1) * 128 + c];
        for (int i = 0; i < n; ++i) {
            const float xp2 = (i + 2 < n) ? xs[(t0 + i + 2) * 128 + c] : (i + 2 == n ? hp1 : hp2);
            const float y = w0 * xm2 + w1 * xm1 + w2 * x0 + w3 * xp1 + w4 * xp2;
            xs[(t0 + i) * 128 + c] = siluf_(y);
            xm2 = xm1; xm1 = x0; x0 = xp1; xp1 = xp2;
        }
        __syncthreads();
        for (int t = F.wave; t < Lu; t += NWAVES) {
            const f32x2 ab = *(const LAS f32x2*)(xs + t * 128 + 2 * F.lane); float a = ab.x, b = ab.y;
            if (which < 2) { const float ss = wave_sum(a * a + b * b); const float sc = (1.f / sqrtf(ss + EPS)) * (which == 0 ? 0.08838834764831845f : 1.f); a *= sc; b *= sc; }
            ((unsigned*)(base + t * 128))[F.lane] = pk2(a, b);
        }
        __syncthreads();
    }
}
__device__ __forceinline__ void dn_prep_unit(Frame& F, int uid) {
    const bool ctx = uid < 64; const int v = ctx ? uid : uid - 64;
    const int bh = ctx ? (v >> 2) : (v >> 7), cc = ctx ? (v & 3) : (v & 127), b = bh >> 3, h = bh & 7;
    const bf16* kbase = ctx ? WSP(bf16, WS_QKVC) + ((size_t)(16 + bh) * LCTX + cc * CHK) * 128 : WSP(bf16, WS_QKV) + ((size_t)(16 + bh) * SEQ + cc * CHK) * 128;
    const bf16* qbase = ctx ? WSP(bf16, WS_QKVC) + ((size_t)(bh) * LCTX + cc * CHK) * 128 : WSP(bf16, WS_QKV) + ((size_t)(bh) * SEQ + cc * CHK) * 128;
    const int rowbase = ctx ? T + b * LCTX + cc * CHK : b * SEQ + cc * CHK, ch132 = ctx ? cc : 4 + cc;
    bf16* ta = ctx ? WSP(bf16, WS_CTXTA) + (size_t)v * 8192 : WSP(bf16, WS_TA) + (size_t)v * 8192;
    LAS float* kf = (LAS float*)F.lds; LAS float* qf = kf + 64 * 129; LAS float* KK = (LAS float*)(F.lds + 66560); LAS float* QK = KK + 64 * 65;
    LAS float* Gs = QK + 64 * 65; LAS float* Bs = Gs + 128;
    LAS float* Tm = (LAS float*)F.lds; LAS float* X = Tm + 2 * 64 * 65;
    for (int idx = F.tid; idx < 1024; idx += NTHR) { const int row = idx >> 4, c8 = idx & 15; float f[8];
        unpack8(*(const v4u*)(kbase + row * 128 + c8 * 8), f);
#pragma unroll
        for (int e = 0; e < 8; ++e) kf[row * 129 + c8 * 8 + e] = f[e];
        unpack8(*(const v4u*)(qbase + row * 128 + c8 * 8), f);
#pragma unroll
        for (int e = 0; e < 8; ++e) qf[row * 129 + c8 * 8 + e] = f[e]; }
    __syncthreads();
    { const int i = F.tid >> 3, jg = F.tid & 7; float aK[8], aQ[8];
#pragma unroll
      for (int jj = 0; jj < 8; ++jj) { aK[jj] = 0.f; aQ[jj] = 0.f; }
      for (int d = 0; d < 128; ++d) { const float ki = kf[i * 129 + d], qi = qf[i * 129 + d];
#pragma unroll
          for (int jj = 0; jj < 8; ++jj) { const float kj = kf[(jg + 8 * jj) * 129 + d]; aK[jj] += ki * kj; aQ[jj] += qi * kj; } }
#pragma unroll
      for (int jj = 0; jj < 8; ++jj) { KK[i * 65 + jg + 8 * jj] = aK[jj]; QK[i * 65 + jg + 8 * jj] = aQ[jj]; } }
    if (F.tid < 128) { const int d = F.tid >> 6, i = F.tid & 63, oi = d ? 63 - i : i; const float* bd = WSP(float, WS_BD) + (size_t)(rowbase + oi) * 32;
        const float beta = sigmoidf_(bd[d * 8 + h]);
        const float g = -__expf(F.in[I_ALOG][d * 8 + h]) * softplusf_(bd[16 + d * 8 + h] + F.in[I_DTB][d * 8 + h]);
        float Gc = g;
#pragma unroll
        for (int o = 1; o < 64; o <<= 1) { const float nb = __shfl_up(Gc, o); if (i >= o) Gc += nb; }
        const float Gt = __shfl(Gc, 63);
        Gs[d * 64 + i] = Gc; Bs[d * 64 + i] = beta;
        float* sc = DOP(float, DO_SC) + (size_t)((d * 2 + b) * 8 + h) * (NCH * 64) + ch132 * 64 + i;
        sc[0] = __expf(Gc); sc[SCN] = __expf(Gt - Gc); sc[2 * SCN] = beta; }
    __syncthreads();
    for (int idx = F.tid; idx < 8192; idx += NTHR) { const int d = idx >> 12, i = (idx >> 6) & 63, j = idx & 63;
        if (i > j) { const int oi = d ? 63 - i : i, oj = d ? 63 - j : j; Tm[d * 4160 + i * 65 + j] = Bs[d * 64 + i] * KK[oi * 65 + oj] * __expf(Gs[d * 64 + i] - Gs[d * 64 + j]); } }
    __syncthreads();
    if (F.wave < 2) { const int d = F.wave, c = F.lane; const LAS float* Tmd = Tm + d * 4160; LAS float* Xd = X + d * 4160;
        for (int i = 0; i < 64; ++i) { float a = (i == c) ? 1.f : 0.f;
            for (int j = 0; j < i; ++j) a -= Tmd[i * 65 + j] * Xd[j * 65 + c];
            Xd[i * 65 + c] = a; } }
    __syncthreads();
    { const int oi = F.tid >> 3, oj0 = (F.tid & 7) * 8; float tv[8], av[8];
#pragma unroll
      for (int e = 0; e < 8; ++e) { const int oj = oj0 + e;
          if (oi > oj) { tv[e] = X[oi * 65 + oj]; av[e] = QK[oi * 65 + oj] * __expf(Gs[oi] - Gs[oj]); }
          else if (oi < oj) { const int i = 63 - oi, j = 63 - oj; tv[e] = X[4160 + i * 65 + j]; av[e] = QK[oi * 65 + oj] * __expf(Gs[64 + i] - Gs[64 + j]); }
          else { tv[e] = 1.f; av[e] = QK[oi * 65 + oi]; } }
      *(v4u*)(ta + oi * 64 + oj0) = pack8(tv); *(v4u*)(ta + 4096 + oi * 64 + oj0) = pack8(av); }
    __syncthreads();
}
__device__ __forceinline__ void s5a_unit(Frame& F, int wu) {
    const int b = wu / (32 * NCH), rem = wu % (32 * NCH), g = rem / NCH, ch = rem % NCH;
    const int r0 = ch < 4 ? T + b * LCTX + ch * CHK : b * SEQ + (ch - 4) * CHK;
    LAS float* ub = (LAS float*)(F.lds + F.wave * 4096);
    { const bf16* src = WSP(bf16, WS_U) + (size_t)(r0 + F.lane) * 512 + g * 16; float f[8];
      unpack8(*(const v4u*)src, f); *(LAS f32x4*)(ub + F.lane * 16) = (f32x4){f[0], f[1], f[2], f[3]}; *(LAS f32x4*)(ub + F.lane * 16 + 4) = (f32x4){f[4], f[5], f[6], f[7]};
      unpack8(*(const v4u*)(src + 8), f); *(LAS f32x4*)(ub + F.lane * 16 + 8) = (f32x4){f[0], f[1], f[2], f[3]}; *(LAS f32x4*)(ub + F.lane * 16 + 12) = (f32x4){f[4], f[5], f[6], f[7]}; }
    LDS_WAIT(); asm volatile("" ::: "memory");
    for (int d = 0; d < 2; ++d) {
        const int idx = (d * 32 + g) * 64 + F.lane; const f32x2 a = TABP(f32x2, TAB_ABAR)[idx]; const f32x2* bbp = TABP(f32x2, TAB_BBAR) + (size_t)idx * 16;
        f32x2 bb[16];
#pragma unroll
        for (int c = 0; c < 16; ++c) bb[c] = bbp[c];
        float hr = 0.f, hi = 0.f;
        for (int i = 0; i < 64; ++i) { const int t = d ? 63 - i : i; float bur = 0.f, bui = 0.f;
#pragma unroll
            for (int c4 = 0; c4 < 4; ++c4) { const f32x4 uv = *(const LAS f32x4*)(ub + t * 16 + c4 * 4);
#pragma unroll
                for (int e = 0; e < 4; ++e) { bur += bb[c4 * 4 + e].x * uv[e]; bui += bb[c4 * 4 + e].y * uv[e]; } }
            const float nr = a.x * hr - a.y * hi + bur, ni = a.x * hi + a.y * hr + bui; hr = nr; hi = ni; }
        DOP(f32x2, DO_EH)[(size_t)(((d * 2 + b) * NCH + ch) * 32 + g) * 64 + F.lane] = (f32x2){hr, hi};
    }
    LDS_WAIT(); asm volatile("" ::: "memory");
}
__device__ __forceinline__ void phase4(Frame& F) {
    constexpr int N_DN = 64 + 16 * NCHL, N_S5 = (2 * NCH * 32) / 8;
    for (int it = F.vcu; it < N_DN + N_S5; it += F.G) {
        if (it < N_DN) dn_prep_unit(F, it);
        else s5a_unit(F, (it - N_DN) * 8 + F.wave);
    }
}
__device__ __forceinline__ void phase5(Frame& F) {
    if (F.vcu < 16) {
        const int idx = F.vcu * NTHR + F.tid, d = idx >> 12, b = (idx >> 11) & 1, g = (idx >> 6) & 31, p = idx & 63;
        const f32x2 a64 = TABP(f32x2, TAB_A64)[(d * 32 + g) * 64 + p];
        f32x2* base = DOP(f32x2, DO_EH) + (size_t)((d * 2 + b) * NCH) * 2048 + g * 64 + p;
        float hr = 0.f, hi = 0.f;
        for (int kb = 0; kb < NCH; kb += 12) { f32x2 e[12];
#pragma unroll
            for (int j = 0; j < 12; ++j) { const int k = kb + j, ch = d == 0 ? k : (k < 4 ? 3 - k : 135 - k); e[j] = base[(size_t)ch * 2048]; }
#pragma unroll
            for (int j = 0; j < 12; ++j) { const int k = kb + j, ch = d == 0 ? k : (k < 4 ? 3 - k : 135 - k); base[(size_t)ch * 2048] = (f32x2){hr, hi};
                const float nr = a64.x * hr - a64.y * hi + e[j].x, ni = a64.x * hi + a64.y * hr + e[j].y; hr = nr; hi = ni; } }
    }
    if (F.G != 256) return;
    const int seqid = F.vcu >> 3, s = F.vcu & 7, d = seqid >> 4, bh = seqid & 15, b = bh >> 3, h = bh & 7;
    LAS float* kf = (LAS float*)F.lds; LAS float* qf = kf + 64 * 129; LAS float* Tf = qf + 64 * 129; LAS float* Af = Tf + 64 * 65;
    LAS float* S = Af + 64 * 65; LAS float* vf = S + 2048; LAS float* rhs = vf + 1024; LAS float* vnew = rhs + 1024; LAS float* vs = vnew + 1024;
    LAS float* eG = vs + 1024; LAS float* eend = eG + 64; LAS float* betas = eend + 64;
    for (int e = F.tid; e < 2048; e += NTHR) S[e] = 0.f;
    __syncthreads();
    const float* scb = DOP(float, DO_SC) + (size_t)((d * 2 + b) * 8 + h) * (NCH * 64);
    for (int step = 0; step < NCH; ++step) {
        const bool ctx = step < 4; const int cc = ctx ? (d ? 3 - step : step) : (d ? 131 - step : step - 4), ch132 = ctx ? cc : 4 + cc;
        const bf16* qb = ctx ? WSP(bf16, WS_QKVC) + ((size_t)(bh) * LCTX + cc * CHK) * 128 : WSP(bf16, WS_QKV) + ((size_t)(bh) * SEQ + cc * CHK) * 128;
        const bf16* kb = ctx ? WSP(bf16, WS_QKVC) + ((size_t)(16 + bh) * LCTX + cc * CHK) * 128 : WSP(bf16, WS_QKV) + ((size_t)(16 + bh) * SEQ + cc * CHK) * 128;
        const bf16* vb = ctx ? WSP(bf16, WS_QKVC) + ((size_t)(32 + bh) * LCTX + cc * CHK) * 128 : WSP(bf16, WS_QKV) + ((size_t)(32 + bh) * SEQ + cc * CHK) * 128;
        const bf16* ta = ctx ? WSP(bf16, WS_CTXTA) + (size_t)(bh * 4 + cc) * 8192 : WSP(bf16, WS_TA) + (size_t)(bh * NCHL + cc) * 8192;
        for (int idx = F.tid; idx < 1024; idx += NTHR) { const int i = idx >> 4, c8 = idx & 15, oi = d ? 63 - i : i; float f[8];
            unpack8(*(const v4u*)(kb + oi * 128 + c8 * 8), f);
#pragma unroll
            for (int e = 0; e < 8; ++e) kf[i * 129 + c8 * 8 + e] = f[e];
            if (!ctx) { unpack8(*(const v4u*)(qb + oi * 128 + c8 * 8), f);
#pragma unroll
                for (int e = 0; e < 8; ++e) qf[i * 129 + c8 * 8 + e] = f[e]; } }
        { const int i = F.tid >> 3, j8 = (F.tid & 7) * 8, oi = d ? 63 - i : i, oj0 = d ? 56 - j8 : j8; float ft[8], fa[8];
          unpack8(*(const v4u*)(ta + oi * 64 + oj0), ft); unpack8(*(const v4u*)(ta + 4096 + oi * 64 + oj0), fa);
#pragma unroll
          for (int e = 0; e < 8; ++e) { const int j = j8 + e; const float tv = d ? ft[7 - e] : ft[e], av = d ? fa[7 - e] : fa[e];
              Tf[i * 65 + j] = i > j ? tv : (i == j ? 1.f : 0.f); Af[i * 65 + j] = i >= j ? av : 0.f; } }
        if (F.tid < 64) { eG[F.tid] = scb[ch132 * 64 + F.tid]; eend[F.tid] = scb[SCN + ch132 * 64 + F.tid]; betas[F.tid] = scb[2 * SCN + ch132 * 64 + F.tid]; }
        if (F.tid < 128) { const int i = F.tid >> 1, hf = F.tid & 1, oi = d ? 63 - i : i; float f[8]; unpack8(*(const v4u*)(vb + oi * 128 + s * 16 + hf * 8), f);
#pragma unroll
            for (int e = 0; e < 8; ++e) vf[i * 16 + hf * 8 + e] = f[e]; }
        __syncthreads();
        const int i = F.tid >> 3, c2 = (F.tid & 7) * 2;
        float r0 = 0.f, r1 = 0.f, o0 = 0.f, o1 = 0.f;
        for (int dd = 0; dd < 128; ++dd) { const f32x2 s2 = *(const LAS f32x2*)(S + dd * 16 + c2); const float kv = kf[i * 129 + dd]; r0 += kv * s2.x; r1 += kv * s2.y;
            if (!ctx) { const float qv = qf[i * 129 + dd]; o0 += qv * s2.x; o1 += qv * s2.y; } }
        rhs[i * 16 + c2] = betas[i] * (vf[i * 16 + c2] - eG[i] * r0); rhs[i * 16 + c2 + 1] = betas[i] * (vf[i * 16 + c2 + 1] - eG[i] * r1);
        __syncthreads();
        float vn0 = 0.f, vn1 = 0.f;
        for (int j = 0; j < 64; ++j) { const float tv = Tf[i * 65 + j]; const f32x2 rr = *(const LAS f32x2*)(rhs + j * 16 + c2); vn0 += tv * rr.x; vn1 += tv * rr.y; }
        vnew[i * 16 + c2] = vn0; vnew[i * 16 + c2 + 1] = vn1; vs[i * 16 + c2] = eend[i] * vn0; vs[i * 16 + c2 + 1] = eend[i] * vn1;
        __syncthreads();
        if (!ctx) { o0 *= eG[i]; o1 *= eG[i];
            for (int j = 0; j < 64; ++j) { const float av = Af[i * 65 + j]; const f32x2 vv = *(const LAS f32x2*)(vnew + j * 16 + c2); o0 += av * vv.x; o1 += av * vv.y; }
            const int oi = d ? 63 - i : i;
            *(unsigned*)(WSP(bf16, WS_ODIR) + ((size_t)d * T + b * SEQ + cc * CHK + oi) * 1024 + h * 128 + s * 16 + c2) = pk2(o0, o1); }
        { const int dd = F.tid >> 2, c4 = (F.tid & 3) * 4; const float ae = eG[63]; f32x4 a4 = *(const LAS f32x4*)(S + dd * 16 + c4) * ae;
          for (int i2 = 0; i2 < 64; ++i2) { const float kv = kf[i2 * 129 + dd]; a4 += *(const LAS f32x4*)(vs + i2 * 16 + c4) * kv; }
          *(LAS f32x4*)(S + dd * 16 + c4) = a4; }
        __syncthreads();
    }
}
__device__ __forceinline__ void phase6(Frame& F) {
    LAS f32x2* Ct = (LAS f32x2*)F.lds;
    LAS f32x2* hb = (LAS f32x2*)(F.lds + 16384 + F.wave * 8320);
    LAS unsigned* ubw = (LAS unsigned*)(F.lds + 82944 + F.wave * 2048);
    LAS float* yb = (LAS float*)(F.lds + 99328 + F.wave * 4096);
    const int lane = F.lane;
    for (int it = F.vcu; it < 1024; it += F.G) {
        const int b = it >> 9, g = (it >> 4) & 31, lc = (it & 15) * 8 + F.wave;
        __syncthreads();
        for (int e = F.tid; e < 2048; e += NTHR) { const int d = e >> 10, p = (e >> 4) & 63, c = e & 15; const size_t si = (size_t)((d * 32 + g) * 16 + c) * 64 + p;
            Ct[e] = (f32x2){F.in[I_CRE][si], F.in[I_CIM][si]}; }
        const int r0 = b * SEQ + lc * CHK;
        { const bf16* src = WSP(bf16, WS_U) + (size_t)(r0 + lane) * 512 + g * 16; const v4u a = *(const v4u*)src, c2 = *(const v4u*)(src + 8);
          *(LAS v4u*)(ubw + lane * 8) = a; *(LAS v4u*)(ubw + lane * 8 + 4) = c2;
          float f[8]; const float* Dp = F.in[I_S5D] + g * 16;
          unpack8(a, f); *(LAS f32x4*)(yb + lane * 16) = (f32x4){f[0] * Dp[0], f[1] * Dp[1], f[2] * Dp[2], f[3] * Dp[3]}; *(LAS f32x4*)(yb + lane * 16 + 4) = (f32x4){f[4] * Dp[4], f[5] * Dp[5], f[6] * Dp[6], f[7] * Dp[7]};
          unpack8(c2, f); *(LAS f32x4*)(yb + lane * 16 + 8) = (f32x4){f[0] * Dp[8], f[1] * Dp[9], f[2] * Dp[10], f[3] * Dp[11]}; *(LAS f32x4*)(yb + lane * 16 + 12) = (f32x4){f[4] * Dp[12], f[5] * Dp[13], f[6] * Dp[14], f[7] * Dp[15]}; }
        __syncthreads();
        for (int d = 0; d < 2; ++d) {
            const int idx = (d * 32 + g) * 64 + lane; const f32x2 a = TABP(f32x2, TAB_ABAR)[idx]; const f32x2* bbp = TABP(f32x2, TAB_BBAR) + (size_t)idx * 16;
            f32x2 bb[16];
#pragma unroll
            for (int c = 0; c < 16; ++c) bb[c] = bbp[c];
            const f32x2 h0 = DOP(f32x2, DO_EH)[(size_t)(((d * 2 + b) * NCH + 4 + lc) * 32 + g) * 64 + lane];
            float hr = h0.x, hi = h0.y;
            for (int ib = 0; ib < 4; ++ib) {
                for (int il = 0; il < 16; ++il) { const int i = ib * 16 + il, t = d ? 63 - i : i; float bur = 0.f, bui = 0.f;
                    const v4u ua = *(const LAS v4u*)(ubw + t * 8), uc = *(const LAS v4u*)(ubw + t * 8 + 4); float f[8];
                    unpack8(ua, f);
#pragma unroll
                    for (int e = 0; e < 8; ++e) { bur += bb[e].x * f[e]; bui += bb[e].y * f[e]; }
                    unpack8(uc, f);
#pragma unroll
                    for (int e = 0; e < 8; ++e) { bur += bb[8 + e].x * f[e]; bui += bb[8 + e].y * f[e]; }
                    const float nr = a.x * hr - a.y * hi + bur, ni = a.x * hi + a.y * hr + bui; hr = nr; hi = ni;
                    hb[il * 65 + lane] = (f32x2){hr, hi}; }
                LDS_WAIT(); asm volatile("" ::: "memory");
                { const int tl = lane >> 2, cq = lane & 3; float ac[4] = {0.f, 0.f, 0.f, 0.f};
                  const LAS f32x2* cp = Ct + d * 1024 + cq * 4;
                  for (int p = 0; p < 64; ++p) { const f32x2 hv = hb[tl * 65 + p]; const f32x4 c01 = *(const LAS f32x4*)(cp + p * 16), c23 = *(const LAS f32x4*)(cp + p * 16 + 2);
                      ac[0] += c01[0] * hv.x - c01[1] * hv.y; ac[1] += c01[2] * hv.x - c01[3] * hv.y; ac[2] += c23[0] * hv.x - c23[1] * hv.y; ac[3] += c23[2] * hv.x - c23[3] * hv.y; }
                  const int i = ib * 16 + tl, t = d ? 63 - i : i; LAS f32x4* yp = (LAS f32x4*)(yb + t * 16 + cq * 4); f32x4 yv = *yp; yv[0] += ac[0]; yv[1] += ac[1]; yv[2] += ac[2]; yv[3] += ac[3]; *yp = yv; }
                LDS_WAIT(); asm volatile("" ::: "memory");
            }
        }
#pragma unroll
        for (int rep = 0; rep < 4; ++rep) { const int t = rep * 16 + (lane >> 2), cq = lane & 3; const f32x4 yv = *(const LAS f32x4*)(yb + t * 16 + cq * 4);
            const unsigned lo = pk2(gelu_tanh(yv[0]), gelu_tanh(yv[1])), hi2 = pk2(gelu_tanh(yv[2]), gelu_tanh(yv[3]));
            *(unsigned long long*)(DOP(bf16, DO_Y) + (size_t)(r0 + t) * 512 + g * 16 + cq * 4) = (unsigned long long)lo | ((unsigned long long)hi2 << 32); }
        LDS_WAIT(); asm volatile("" ::: "memory");
    }
    const int gw = F.vcu * NWAVES + F.wave, NGW = F.G * NWAVES;
    const float* nw = F.in[I_DNNW] + (lane & 7) * 16;
    for (int r = gw; r < T; r += NGW) {
        const bf16* of = WSP(bf16, WS_ODIR) + (size_t)r * 1024 + lane * 16; const bf16* ob = of + (size_t)T * 1024; const bf16* zp = WSP(bf16, WS_ZDN) + (size_t)r * 1024 + lane * 16;
        float o[16], f[8], z[16];
        unpack8(*(const v4u*)of, o); unpack8(*(const v4u*)(of + 8), o + 8);
        unpack8(*(const v4u*)ob, f);
#pragma unroll
        for (int e = 0; e < 8; ++e) o[e] += f[e];
        unpack8(*(const v4u*)(ob + 8), f);
#pragma unroll
        for (int e = 0; e < 8; ++e) o[8 + e] += f[e];
        unpack8(*(const v4u*)zp, z); unpack8(*(const v4u*)(zp + 8), z + 8);
        float ss = 0.f;
#pragma unroll
        for (int e = 0; e < 16; ++e) ss += o[e] * o[e];
        ss += __shfl_xor(ss, 1); ss += __shfl_xor(ss, 2); ss += __shfl_xor(ss, 4);
        const float rinv = 1.f / sqrtf(ss * (1.f / 128.f) + EPS);
#pragma unroll
        for (int e = 0; e < 16; ++e) o[e] = o[e] * rinv * nw[e] * z[e];
        bf16* yo = WSP(bf16, WS_YDN) + (size_t)r * 1024 + lane * 16;
        *(v4u*)yo = pack8(o); *(v4u*)(yo + 8) = pack8(o + 8);
    }
}
struct EpiGlu {
    static constexpr bool PERM = true, AFTER_DRAIN = false;
    const bf16* Y; const bf16* ZS5; const float* gb; bf16* O;
    __device__ __forceinline__ void operator()(const f32x4 (&acc)[2][2][4][2], const pg8::Unit& u, int wr, int wc, int fr, int fq) const {
#pragma unroll
        for (int ai = 0; ai < 2; ++ai)
#pragma unroll
            for (int m = 0; m < 4; ++m) { const int row = u.pm * 256 + ai * 128 + wr * 64 + m * 16 + fr;
#pragma unroll
                for (int bj = 0; bj < 2; ++bj) { const int col = u.pn * 256 + bj * 128 + wc * 32 + 8 * fq; const size_t o = (size_t)row * 512 + col;
                    const f32x4 v0 = acc[ai][bj][m][0], v1 = acc[ai][bj][m][1]; float a[8] = {v0[0], v0[1], v0[2], v0[3], v1[0], v1[1], v1[2], v1[3]}, y[8], z[8];
                    unpack8(*(const v4u*)(Y + o), y); unpack8(*(const v4u*)(ZS5 + o), z);
#pragma unroll
                    for (int e = 0; e < 8; ++e) a[e] = y[e] * sigmoidf_(a[e] + gb[col + e]) * z[e];
                    *(v4u*)(O + o) = pack8(a); } }
    }
};
struct EpiGate {
    static constexpr bool PERM = true, AFTER_DRAIN = false;
    const bf16* Gt; const bf16* P; bf16* O; int add;
    __device__ __forceinline__ void operator()(const f32x4 (&acc)[2][2][4][2], const pg8::Unit& u, int wr, int wc, int fr, int fq) const {
#pragma unroll
        for (int ai = 0; ai < 2; ++ai)
#pragma unroll
            for (int m = 0; m < 4; ++m) { const int row = u.pm * 256 + ai * 128 + wr * 64 + m * 16 + fr;
#pragma unroll
                for (int bj = 0; bj < 2; ++bj) { const int col = u.pn * 256 + bj * 128 + wc * 32 + 8 * fq; const size_t o = (size_t)row * 1024 + col;
                    const f32x4 v0 = acc[ai][bj][m][0], v1 = acc[ai][bj][m][1]; float a[8] = {v0[0], v0[1], v0[2], v0[3], v1[0], v1[1], v1[2], v1[3]}, g[8], p[8];
                    unpack8(*(const v4u*)(Gt + o), g);
                    if (add) { unpack8(*(const v4u*)(P + o), p);
#pragma unroll
                        for (int e = 0; e < 8; ++e) a[e] = p[e] + g[e] * a[e]; }
                    else {
#pragma unroll
                        for (int e = 0; e < 8; ++e) a[e] = g[e] * a[e]; }
                    *(v4u*)(O + o) = pack8(a); } }
    }
};
struct EpiOut {
    static constexpr bool PERM = false, AFTER_DRAIN = false;
    const float* X; const float* gate; float* O;
    __device__ __forceinline__ void operator()(const f32x4 (&acc)[2][2][4][2], const pg8::Unit& u, int wr, int wc, int fr, int fq) const {
#pragma unroll
        for (int ai = 0; ai < 2; ++ai)
#pragma unroll
            for (int m = 0; m < 4; ++m) { const int row = u.pm * 256 + ai * 128 + wr * 64 + m * 16 + fr; const float* gt = gate + (row >> 13) * 1024;
#pragma unroll
                for (int bj = 0; bj < 2; ++bj)
#pragma unroll
                    for (int n = 0; n < 2; ++n) { const int col = u.pn * 256 + bj * 128 + wc * 32 + 16 * n + 4 * fq; const size_t o = (size_t)row * 1024 + col;
                        *(f32x4*)(O + o) = *(const f32x4*)(X + o) + *(const f32x4*)(gt + col) * acc[ai][bj][m][n]; } }
    }
};
__device__ __forceinline__ void phase11(Frame& F) {
    const int gw = F.vcu * NWAVES + F.wave, NGW = F.G * NWAVES; const f32x4* wv = (const f32x4*)F.in[I_FNW] + F.lane;
    for (int r = gw; r < T; r += NGW) {
        f32x4* xr = (f32x4*)(F.out + (size_t)r * D) + F.lane; f32x4 xv[4]; float s = 0.f;
#pragma unroll
        for (int j = 0; j < 4; ++j) { xv[j] = xr[64 * j]; s += (xv[j].x * xv[j].x + xv[j].y * xv[j].y) + (xv[j].z * xv[j].z + xv[j].w * xv[j].w); }
        const float rinv = 1.f / sqrtf(wave_sum(s) * (1.f / D) + EPS);
#pragma unroll
        for (int j = 0; j < 4; ++j) xr[64 * j] = xv[j] * rinv * wv[64 * j];
    }
}
struct Args { const float* in[26]; float* out; unsigned char* ws; int ph_lo, ph_hi; };
__global__ void __launch_bounds__(NWAVES * 64, 2) mk_fwd(Args args) {
    extern __shared__ __attribute__((aligned(16))) unsigned char lds[];
    Frame F;
    F.lds = (LAS unsigned char*)lds;
    F.tid = threadIdx.x; F.lane = F.tid & 63; F.wave = __builtin_amdgcn_readfirstlane(F.tid >> 6);
    F.G = gridDim.x; { const int bx = blockIdx.x; F.vcu = (F.G % 8 == 0) ? (bx % 8) * (F.G / 8) + bx / 8 : bx; }
#pragma unroll
    for (int i = 0; i < 26; ++i) F.in[i] = args.in[i];
    F.out = args.out; F.ws = args.ws;
    volatile LAS unsigned* MISC = (volatile LAS unsigned*)(F.lds + MISC_OFF);
    for (int u = F.tid; u < (LDS_BYTES - LDSCTL_OFF) / 4; u += NTHR) ((LAS unsigned*)(F.lds + LDSCTL_OFF))[u] = 0u;
    __syncthreads();
    XcdBarrier bar; bar.bar = (unsigned*)(F.ws + WS_CTL) + CW_BAR; bar.x = 0; bar.st = nullptr;
    if (!MK_PER_PHASE) bar = xcd_barrier_post((unsigned*)(F.ws + WS_CTL) + CW_BAR, MISC + 8);
    const int lo = args.ph_lo, hi = args.ph_hi;
#define IN(k) (lo <= (k) && (k) < hi)
#define SEAM(k) do { if (IN(k) && IN((k) + 1)) xcd_barrier(bar); } while (0)
    if (IN(0)) { phase0(F); } SEAM(0);
    if (IN(1)) { phase1(F); } SEAM(1);
    if (IN(2)) {
        pg8::Gemm g{DOP(bf16, DO_H), WSP(bf16, WS_WIN), MROWS, NPAD, D}; OrderIn S; S.init(true, F.G, (int)blockIdx.x);
        EpiIn E{WSP(bf16, WS_QKV), WSP(bf16, WS_QKVC), WSP(bf16, WS_U), WSP(bf16, WS_ZDN), WSP(bf16, WS_ZS5), WSP(bf16, WS_GDN), WSP(bf16, WS_GS5), WSP(float, WS_BD)};
        pg8::gemm_phase<EpiIn, OrderIn, true, true>(F.lds, g, S, E);
    } SEAM(2);
    if (IN(3)) { phase3(F); } SEAM(3);
    if (IN(4)) { phase4(F); } SEAM(4);
    if (IN(5)) { phase5(F); } SEAM(5);
    if (IN(6)) {
        pg8::Gemm g{DOP(bf16, DO_H), WSP(bf16, WS_WIN), T, NPAD, D}; OrderIn S; S.init(false, F.G, (int)blockIdx.x);
        EpiIn E{WSP(bf16, WS_QKV), WSP(bf16, WS_QKVC), WSP(bf16, WS_U), WSP(bf16, WS_ZDN), WSP(bf16, WS_ZS5), WSP(bf16, WS_GDN), WSP(bf16, WS_GS5), WSP(float, WS_BD)};
        pg8::gemm_phase<EpiIn, OrderIn, true, true>(F.lds, g, S, E);
    } SEAM(6);
    if (IN(7)) { phase6(F); } SEAM(7);
    if (IN(8)) {
        pg8::Gemm g{DOP(bf16, DO_Y), WSP(bf16, WS_GLU), T, 512, 512}; pg8::StaticOrder S; S.init(T, 512, F.G, (int)blockIdx.x);
        EpiGlu E{DOP(bf16, DO_Y), WSP(bf16, WS_ZS5), F.in[I_GLUB], WSP(bf16, WS_YS5)};
        pg8::gemm_phase<EpiGlu, pg8::StaticOrder, false, true>(F.lds, g, S, E);
    } SEAM(8);
    if (IN(9)) {
        pg8::Gemm g{WSP(bf16, WS_YDN), WSP(bf16, WS_WPD), T, 1024, 1024}; pg8::StaticOrder S; S.init(T, 1024, F.G, (int)blockIdx.x);
        EpiGate E{WSP(bf16, WS_GDN), nullptr, WSP(bf16, WS_M1), 0};
        pg8::gemm_phase<EpiGate, pg8::StaticOrder, false, true>(F.lds, g, S, E);
    } SEAM(9);
    if (IN(10)) {
        pg8::Gemm g{WSP(bf16, WS_YS5), WSP(bf16, WS_WPS), T, 1024, 512}; pg8::StaticOrder S; S.init(T, 1024, F.G, (int)blockIdx.x);
        EpiGate E{WSP(bf16, WS_GS5), WSP(bf16, WS_M1), WSP(bf16, WS_MERGED), 1};
        pg8::gemm_phase<EpiGate, pg8::StaticOrder, false, true>(F.lds, g, S, E);
    } SEAM(10);
    if (IN(11)) {
        pg8::Gemm g{WSP(bf16, WS_MERGED), WSP(bf16, WS_WOUT), T, 1024, 1024}; pg8::StaticOrder S; S.init(T, 1024, F.G, (int)blockIdx.x);
        EpiOut E{F.in[I_X], TABP(float, TAB_GATE), F.out};
        pg8::gemm_phase<EpiOut, pg8::StaticOrder, false, true>(F.lds, g, S, E);
    } SEAM(11);
    if (IN(12)) { phase11(F); }
#undef IN
#undef SEAM
}
extern "C" void kernel_launch(void* const* d_in, const int* in_sizes, int n_in, void* d_out, int out_size, void* d_ws, size_t ws_size, hipStream_t stream) {
    static int grid = 0;
    if (grid == 0) {
        if (n_in != 26 || in_sizes[0] != T * D || out_size != T * D || ws_size < WS_END) { fprintf(stderr, "kernel_launch: unexpected shapes (n_in %d, in0 %d, out %d, ws %zu)\n", n_in, n_in > 0 ? in_sizes[0] : -1, out_size, ws_size); grid = -1; return; }
        int dev = 0, cus = 0;
        if (hipGetDevice(&dev) != hipSuccess || hipDeviceGetAttribute(&cus, hipDeviceAttributeMultiprocessorCount, dev) != hipSuccess) { grid = -1; return; }
        if (hipFuncSetAttribute((const void*)mk_fwd, hipFuncAttributeMaxDynamicSharedMemorySize, LDS_BYTES) != hipSuccess) { fprintf(stderr, "kernel_launch: hipFuncSetAttribute failed\n"); grid = -1; return; }
        (void)hipGetLastError();
        grid = cus;
        if (grid != 256) fprintf(stderr, "kernel_launch: %d CUs; this build assumes 256\n", grid);
    }
    if (grid < 0) return;
    if (hipMemsetAsync((char*)d_ws + WS_CTL, 0, CTL_ZERO_BYTES, stream) != hipSuccess) return;
    Args a{};
    for (int i = 0; i < 26; ++i) a.in[i] = (const float*)d_in[i];
    a.out = (float*)d_out; a.ws = (unsigned char*)d_ws;
#if MK_PER_PHASE
    for (int p = 0; p < NPHASE; ++p) { a.ph_lo = p; a.ph_hi = p + 1; hipLaunchKernelGGL(mk_fwd, dim3(grid), dim3(NWAVES * 64), LDS_BYTES, stream, a); }
#else
    a.ph_lo = 0; a.ph_hi = NPHASE; hipLaunchKernelGGL(mk_fwd, dim3(grid), dim3(NWAVES * 64), LDS_BYTES, stream, a);
#endif
}
```

```cpp
#include <hip/hip_runtime.h>
#include <cstdio>
#include <cstdint>
#define MK_PER_PHASE 0
#define MK_REP -1
#define MK_STAMP -1
namespace pg8 {
#define PG8_LAS __attribute__((address_space(3)))
typedef unsigned short bf16_t;
typedef short bf16x8 __attribute__((ext_vector_type(8)));
typedef float f32x4 __attribute__((ext_vector_type(4)));
typedef unsigned u32x4 __attribute__((ext_vector_type(4)));
constexpr int BM = 256, BK = 64, HALF = 128, HTB = HALF * BK * 2  , STAGE_BYTES = 8 * HTB, NXCD = 8, WGM = 8;

__host__ __device__ __forceinline__ int lds_byte(int r, int c) { const int st = (r >> 4) * 2 + (c >> 5), rr = r & 15, cc = c & 31, ob = rr * 64 + cc * 2; return st * 1024 + (ob ^ (((ob >> 9) & 1) << 5)); }
__host__ __device__ __forceinline__ void stage_rc(int b, int& R, int& C) { const int st = b / 1024, sb = b % 1024, swz = sb ^ (((sb >> 9) & 1) << 5); R = (st >> 1) * 16 + swz / 64; C = (st & 1) * 32 + (swz % 64) / 2; }
__host__ __device__ __forceinline__ int perm32(int rho) { const int n = rho >> 4, i = rho & 15; return 8 * (i >> 2) + 4 * n + (i & 3); }

struct Unit { int pm, pn; };
struct Gemm { const bf16_t* A; const bf16_t* Bt; int M, N, K; };

struct StaticOrder {
    int nM, nN, nwg, G, c;
    __host__ __device__ void init(int M, int N, int G_, int c_) { nM = M / BM; nN = N / BM; nwg = nM * nN; G = G_; c = c_; }
    __host__ __device__ bool next(int i, Unit& u) const {
        const long L = (long)i * G + c; if (L >= nwg) return false;
        int wgid = (int)L; { const int q = nwg / NXCD, r = nwg % NXCD, xcd = wgid % NXCD, off = wgid / NXCD; wgid = (xcd < r ? xcd * (q + 1) : r * (q + 1) + (xcd - r) * q) + off; }
        const int nig = WGM * nN, gid = wgid / nig, fm = gid * WGM, gsz = (nM - fm) < WGM ? (nM - fm) : WGM;
        u.pm = fm + ((wgid % nig) % gsz); u.pn = (wgid % nig) / gsz; return true;
    }
    __device__ __forceinline__ void a_ready(const Unit&) const {}
    __device__ __forceinline__ void done(const Unit&) const {}
};

__device__ __forceinline__ unsigned cvt_pk_bf16(float lo, float hi) { unsigned r; asm volatile("v_cvt_pk_bf16_f32 %0, %1, %2" : "=v"(r) : "v"(lo), "v"(hi)); return r; }
template <class Epi, class Sched, bool ALIGN_EPI = false, bool SP2 = false>
__device__ __forceinline__ void gemm_phase(PG8_LAS unsigned char* lds, const Gemm g, const Sched& S, const Epi& E) {
    int tid_ = threadIdx.x; asm volatile("" : "+v"(tid_));
    const int tid = tid_, wid = __builtin_amdgcn_readfirstlane(tid >> 6), lane = tid & 63, wr = wid >> 2, wc = wid & 3, fr = lane & 15, fq = lane >> 4;
    const int K = g.K, nt = K / BK;
    unsigned voffA[2], voffB[2];
#pragma unroll
    for (int i = 0; i < 2; ++i) { int R, C; stage_rc(tid * 16 + i * 8192, R, C); const int Rb = Epi::PERM ? ((R & ~31) + perm32(R & 31)) : R;
        voffA[i] = (unsigned)(R * K + C) * 2u; voffB[i] = (unsigned)(Rb * K + C) * 2u; }
    const size_t kstep = (size_t)(BK * 2);
    const size_t hstep = (size_t)HALF * K * 2;
    const size_t tstep = 2 * hstep;
    const unsigned ldsw = (unsigned)wid * 1024u;
    const int aoff = lds_byte(wr * 64 + fr, fq * 8), boff = lds_byte(wc * 32 + fr, fq * 8);
#define PG8_SA(b, h) (((b) * 2 + (h)) * HTB)
#define PG8_SB(b, h) ((4 + (b) * 2 + (h)) * HTB)
#define PG8_STAGE(bufoff, gbase, voff) do { _Pragma("unroll") for (int _i = 0; _i < 2; ++_i) \
        __builtin_amdgcn_global_load_lds((const unsigned*)((const char*)(gbase) + (voff)[_i]), (PG8_LAS unsigned*)(lds + (bufoff) + ldsw + _i * 8192), 16, 0, 0); } while (0)
#define PG8_LDA(dst, b, h) do { _Pragma("unroll") for (int m = 0; m < 4; ++m) _Pragma("unroll") for (int k = 0; k < 2; ++k) dst[m][k] = *(const PG8_LAS bf16x8*)(lds + PG8_SA(b, h) + aoff + m * 2048 + k * 1024); } while (0)
#define PG8_LDB(dst, b, h) do { _Pragma("unroll") for (int n = 0; n < 2; ++n) _Pragma("unroll") for (int k = 0; k < 2; ++k) dst[n][k] = *(const PG8_LAS bf16x8*)(lds + PG8_SB(b, h) + boff + n * 2048 + k * 1024); } while (0)
#define PG8_MMA(ai, bj, At, Bt) do { __builtin_amdgcn_s_setprio(1); _Pragma("unroll") for (int m = 0; m < 4; ++m) _Pragma("unroll") for (int n = 0; n < 2; ++n) _Pragma("unroll") for (int k = 0; k < 2; ++k) \
        acc[ai][bj][m][n] = __builtin_amdgcn_mfma_f32_16x16x32_bf16(Bt[n][k], At[m][k], acc[ai][bj][m][n], 0, 0, 0); __builtin_amdgcn_s_setprio(0); } while (0)
#define PG8_WAIT_V(n) asm volatile("s_waitcnt vmcnt(" #n ")" ::: "memory")
#define PG8_WAIT_L(n) asm volatile("s_waitcnt lgkmcnt(" #n ")" ::: "memory")
#define PG8_BAR __builtin_amdgcn_s_barrier()
#define PG8_SCHED __builtin_amdgcn_sched_barrier(0)
    Unit cur, nxt; int ui = 0;
    if (!S.next(0, cur)) return;
    f32x4 acc[2][2][4][2];
#pragma unroll
    for (int a = 0; a < 2; ++a)
#pragma unroll
        for (int b = 0; b < 2; ++b)
#pragma unroll
            for (int m = 0; m < 4; ++m)
#pragma unroll
                for (int n = 0; n < 2; ++n) acc[a][b][m][n] = (f32x4){0.f, 0.f, 0.f, 0.f};
    bf16x8 At[4][2], B0[2][2], B1[2][2];
    const char* cA = (const char*)g.A + (size_t)cur.pm * tstep; const char* cB = (const char*)g.Bt + (size_t)cur.pn * tstep;
    S.a_ready(cur);
    if constexpr (SP2) {
        PG8_STAGE(PG8_SB(0, 0), cB, voffB); PG8_STAGE(PG8_SB(0, 1), cB + hstep, voffB); PG8_STAGE(PG8_SA(0, 0), cA, voffA); PG8_STAGE(PG8_SA(0, 1), cA + hstep, voffA);
        if (wr == 1) PG8_BAR;
        PG8_WAIT_V(2); PG8_BAR;
        PG8_STAGE(PG8_SB(1, 0), cB + kstep, voffB); PG8_STAGE(PG8_SA(1, 0), cA + kstep, voffA); PG8_STAGE(PG8_SB(1, 1), cB + hstep + kstep, voffB);
        PG8_WAIT_V(6); PG8_BAR;
    } else {
        PG8_STAGE(PG8_SB(0, 0), cB, voffB); PG8_STAGE(PG8_SA(0, 0), cA, voffA); PG8_STAGE(PG8_SB(0, 1), cB + hstep, voffB); PG8_STAGE(PG8_SA(0, 1), cA + hstep, voffA);
        if (wr == 1) PG8_BAR;
        PG8_WAIT_V(4); PG8_BAR;
        PG8_STAGE(PG8_SB(1, 0), cB + kstep, voffB); PG8_STAGE(PG8_SA(1, 0), cA + kstep, voffA); PG8_STAGE(PG8_SB(1, 1), cB + hstep + kstep, voffB);
        PG8_WAIT_V(6); PG8_BAR;
    }
    for (;;) {
        const bool has_next = S.next(ui + 1, nxt);
        const char* nA = has_next ? (const char*)g.A + (size_t)nxt.pm * tstep : cA; const char* nB = has_next ? (const char*)g.Bt + (size_t)nxt.pn * tstep : cB;
        for (int t = 0; t < nt; t += 2) {
            const bool last = (t == nt - 2);
            const char* a1 = cA + (size_t)(t + 1) * kstep;
            const char* a2 = last ? nA : cA + (size_t)(t + 2) * kstep; const char* b2 = last ? nB : cB + (size_t)(t + 2) * kstep;
            const char* a3 = a2 + kstep; const char* b3 = b2 + kstep;
            if (last && has_next) S.a_ready(nxt);
            if constexpr (SP2) {
            PG8_LDB(B0, 0, 0); PG8_LDB(B1, 0, 1); PG8_SCHED; PG8_LDA(At, 0, 0); PG8_STAGE(PG8_SA(1, 1), a1 + hstep, voffA);
            PG8_WAIT_V(8); PG8_WAIT_L(0); PG8_BAR; PG8_MMA(0, 0, At, B0); PG8_MMA(0, 1, At, B1); PG8_BAR; PG8_SCHED;
            PG8_LDA(At, 0, 1); PG8_STAGE(PG8_SB(0, 0), b2, voffB); PG8_STAGE(PG8_SB(0, 1), b2 + hstep, voffB); PG8_STAGE(PG8_SA(0, 0), a2, voffA);
            PG8_WAIT_V(8); PG8_WAIT_L(0); PG8_BAR; PG8_MMA(1, 0, At, B0); PG8_MMA(1, 1, At, B1); PG8_BAR; PG8_SCHED;
            PG8_LDB(B0, 1, 0); PG8_LDB(B1, 1, 1); PG8_SCHED; PG8_LDA(At, 1, 0); PG8_STAGE(PG8_SA(0, 1), a2 + hstep, voffA);
            PG8_WAIT_V(8); PG8_WAIT_L(0); PG8_BAR; PG8_MMA(0, 0, At, B0); PG8_MMA(0, 1, At, B1); PG8_BAR; PG8_SCHED;
            PG8_LDA(At, 1, 1); PG8_STAGE(PG8_SB(1, 0), b3, voffB); PG8_STAGE(PG8_SB(1, 1), b3 + hstep, voffB); PG8_STAGE(PG8_SA(1, 0), a3, voffA);
            PG8_WAIT_V(8); PG8_WAIT_L(0); PG8_BAR; PG8_MMA(1, 0, At, B0); PG8_MMA(1, 1, At, B1); PG8_BAR; PG8_SCHED;
            } else {
            PG8_LDB(B0, 0, 0); PG8_SCHED; PG8_LDA(At, 0, 0); PG8_STAGE(PG8_SA(1, 1), a1 + hstep, voffA);
            PG8_WAIT_L(8); PG8_BAR; PG8_WAIT_L(0); PG8_MMA(0, 0, At, B0); PG8_BAR; PG8_SCHED;
            PG8_LDB(B1, 0, 1); PG8_STAGE(PG8_SB(0, 0), b2, voffB);
            PG8_BAR; PG8_WAIT_L(0); PG8_MMA(0, 1, At, B1); PG8_BAR;
            PG8_LDA(At, 0, 1); PG8_STAGE(PG8_SA(0, 0), a2, voffA);
            PG8_BAR; PG8_WAIT_L(0); PG8_MMA(1, 0, At, B0); PG8_BAR; PG8_SCHED;
            PG8_STAGE(PG8_SB(0, 1), b2 + hstep, voffB);
            PG8_WAIT_V(6); PG8_BAR; PG8_MMA(1, 1, At, B1); PG8_BAR;
            PG8_LDB(B0, 1, 0); PG8_SCHED; PG8_LDA(At, 1, 0); PG8_STAGE(PG8_SA(0, 1), a2 + hstep, voffA);
            PG8_WAIT_L(8); PG8_BAR; PG8_WAIT_L(0); PG8_MMA(0, 0, At, B0); PG8_BAR; PG8_SCHED;
            PG8_LDB(B1, 1, 1); PG8_STAGE(PG8_SB(1, 0), b3, voffB);
            PG8_BAR; PG8_WAIT_L(0); PG8_MMA(0, 1, At, B1); PG8_BAR;
            PG8_LDA(At, 1, 1); PG8_STAGE(PG8_SA(1, 0), a3, voffA);
            PG8_BAR; PG8_WAIT_L(0); PG8_MMA(1, 0, At, B0); PG8_BAR; PG8_SCHED;
            PG8_STAGE(PG8_SB(1, 1), b3 + hstep, voffB);
            PG8_WAIT_V(6); PG8_BAR; PG8_MMA(1, 1, At, B1); PG8_BAR;
            }
        }
        if constexpr (ALIGN_EPI) { if (wr == 0) PG8_BAR; }
        if constexpr (!Epi::AFTER_DRAIN) { E(acc, cur, wr, wc, fr, fq); S.done(cur); }
        if (!has_next) break;
#pragma unroll
        for (int a = 0; a < 2; ++a)
#pragma unroll
            for (int b = 0; b < 2; ++b)
#pragma unroll
                for (int m = 0; m < 4; ++m)
#pragma unroll
                    for (int n = 0; n < 2; ++n) acc[a][b][m][n] = (f32x4){0.f, 0.f, 0.f, 0.f};
        cur = nxt; cA = nA; cB = nB; ++ui;
        if constexpr (ALIGN_EPI) { if (wr == 1) PG8_BAR; }
    }
    PG8_WAIT_V(0);
    if constexpr (!ALIGN_EPI) { if (wr == 0) PG8_BAR; }
    PG8_BAR;
    if constexpr (Epi::AFTER_DRAIN) { E.fused(acc, cur, wr, wc, fr, fq, lds, wid, lane); S.done(cur); }
#undef PG8_SA
#undef PG8_SB
#undef PG8_STAGE
#undef PG8_LDA
#undef PG8_LDB
#undef PG8_MMA
#undef PG8_WAIT_V
#undef PG8_WAIT_L
#undef PG8_BAR
#undef PG8_SCHED
}

template <class Epi, class Sched, int K1, int K2>
__device__ __forceinline__ void gemm_dual(PG8_LAS unsigned char* lds, const Gemm g1, const Gemm g2, const Sched& S, const Epi& E) {
    const int tid = threadIdx.x, wid = __builtin_amdgcn_readfirstlane(tid >> 6), lane = tid & 63, wr = wid >> 2, wc = wid & 3, fr = lane & 15, fq = lane >> 4;
    static_assert(K1 == 1024 && K2 == 512, "offset trick below"); constexpr int nt1 = K1 / BK, nt = nt1 + K2 / BK;
    unsigned voffA1[2], voffB1[2];
#pragma unroll
    for (int i = 0; i < 2; ++i) { int R, C; stage_rc(tid * 16 + i * 8192, R, C); const int Rb = Epi::PERM ? ((R & ~31) + perm32(R & 31)) : R;
        voffA1[i] = (unsigned)(R * K1 + C) * 2u; voffB1[i] = (unsigned)(Rb * K1 + C) * 2u; }
    constexpr size_t kstep = (size_t)(BK * 2), hstep1 = (size_t)HALF * K1 * 2, hstep2 = (size_t)HALF * K2 * 2;
    const unsigned ldsw = (unsigned)wid * 1024u;
    const int aoff = lds_byte(wr * 64 + fr, fq * 8), boff = lds_byte(wc * 32 + fr, fq * 8);
#define PG8_SA(b, h) (((b) * 2 + (h)) * HTB)
#define PG8_SB(b, h) ((4 + (b) * 2 + (h)) * HTB)
#define PG8_STAGE(bufoff, gbase, voff) do { _Pragma("unroll") for (int _i = 0; _i < 2; ++_i) \
        __builtin_amdgcn_global_load_lds((const unsigned*)((const char*)(gbase) + (voff)[_i]), (PG8_LAS unsigned*)(lds + (bufoff) + ldsw + _i * 8192), 16, 0, 0); } while (0)
#define PG8_STAGE2(bufoff, gbase, voff) do { _Pragma("unroll") for (int _i = 0; _i < 2; ++_i) \
        __builtin_amdgcn_global_load_lds((const unsigned*)((const char*)(gbase) + (((voff)[_i] >> 11) << 10) + ((voff)[_i] & 2047u)), (PG8_LAS unsigned*)(lds + (bufoff) + ldsw + _i * 8192), 16, 0, 0); } while (0)
#define PG8_STAGE_A(bufoff, tau, half) do { if ((tau) < nt1) PG8_STAGE(bufoff, cA1 + (size_t)(tau) * kstep + (half) * hstep1, voffA1); else PG8_STAGE2(bufoff, cA2 + (size_t)((tau) - nt1) * kstep + (half) * hstep2, voffA1); } while (0)
#define PG8_STAGE_B(bufoff, tau, half) do { if ((tau) < nt1) PG8_STAGE(bufoff, cB1 + (size_t)(tau) * kstep + (half) * hstep1, voffB1); else PG8_STAGE2(bufoff, cB2 + (size_t)((tau) - nt1) * kstep + (half) * hstep2, voffB1); } while (0)
#define PG8_LDA(dst, b, h) do { _Pragma("unroll") for (int m = 0; m < 4; ++m) _Pragma("unroll") for (int k = 0; k < 2; ++k) dst[m][k] = *(const PG8_LAS bf16x8*)(lds + PG8_SA(b, h) + aoff + m * 2048 + k * 1024); } while (0)
#define PG8_LDB(dst, b, h) do { _Pragma("unroll") for (int n = 0; n < 2; ++n) _Pragma("unroll") for (int k = 0; k < 2; ++k) dst[n][k] = *(const PG8_LAS bf16x8*)(lds + PG8_SB(b, h) + boff + n * 2048 + k * 1024); } while (0)
#define PG8_MMA(ai, bj, At, Bt) do { __builtin_amdgcn_s_setprio(1); _Pragma("unroll") for (int m = 0; m < 4; ++m) _Pragma("unroll") for (int n = 0; n < 2; ++n) _Pragma("unroll") for (int k = 0; k < 2; ++k) \
        acc[ai][bj][m][n] = __builtin_amdgcn_mfma_f32_16x16x32_bf16(Bt[n][k], At[m][k], acc[ai][bj][m][n], 0, 0, 0); __builtin_amdgcn_s_setprio(0); } while (0)
#define PG8_WAIT_V(n) asm volatile("s_waitcnt vmcnt(" #n ")" ::: "memory")
#define PG8_WAIT_L(n) asm volatile("s_waitcnt lgkmcnt(" #n ")" ::: "memory")
#define PG8_BAR __builtin_amdgcn_s_barrier()
#define PG8_SCHED __builtin_amdgcn_sched_barrier(0)
    Unit cur;
    if (!S.next(0, cur)) return;
    f32x4 acc[2][2][4][2];
#pragma unroll
    for (int a = 0; a < 2; ++a)
#pragma unroll
        for (int b = 0; b < 2; ++b)
#pragma unroll
            for (int m = 0; m < 4; ++m)
#pragma unroll
                for (int n = 0; n < 2; ++n) acc[a][b][m][n] = (f32x4){0.f, 0.f, 0.f, 0.f};
    bf16x8 At[4][2], B0[2][2], B1[2][2];
    const char* cA1 = (const char*)g1.A + (size_t)cur.pm * 2 * hstep1; const char* cB1 = (const char*)g1.Bt + (size_t)cur.pn * 2 * hstep1;
    const char* cA2 = (const char*)g2.A + (size_t)cur.pm * 2 * hstep2; const char* cB2 = (const char*)g2.Bt + (size_t)cur.pn * 2 * hstep2;
    PG8_STAGE_B(PG8_SB(0, 0), 0, 0); PG8_STAGE_B(PG8_SB(0, 1), 0, 1); PG8_STAGE_A(PG8_SA(0, 0), 0, 0); PG8_STAGE_A(PG8_SA(0, 1), 0, 1);
    if (wr == 1) PG8_BAR;
    PG8_WAIT_V(2); PG8_BAR;
    PG8_STAGE_B(PG8_SB(1, 0), 1, 0); PG8_STAGE_A(PG8_SA(1, 0), 1, 0); PG8_STAGE_B(PG8_SB(1, 1), 1, 1);
    PG8_WAIT_V(6); PG8_BAR;
#define PG8_DUAL_TRIP(t) do { \
        const int t2 = (t == nt - 2) ? 0 : t + 2, t3 = t2 + 1; \
        PG8_LDB(B0, 0, 0); PG8_LDB(B1, 0, 1); PG8_SCHED; PG8_LDA(At, 0, 0); PG8_STAGE_A(PG8_SA(1, 1), t + 1, 1); \
        PG8_WAIT_V(8); PG8_WAIT_L(0); PG8_BAR; PG8_MMA(0, 0, At, B0); PG8_MMA(0, 1, At, B1); PG8_BAR; PG8_SCHED; \
        PG8_LDA(At, 0, 1); PG8_STAGE_B(PG8_SB(0, 0), t2, 0); PG8_STAGE_B(PG8_SB(0, 1), t2, 1); PG8_STAGE_A(PG8_SA(0, 0), t2, 0); \
        PG8_WAIT_V(8); PG8_WAIT_L(0); PG8_BAR; PG8_MMA(1, 0, At, B0); PG8_MMA(1, 1, At, B1); PG8_BAR; PG8_SCHED; \
        PG8_LDB(B0, 1, 0); PG8_LDB(B1, 1, 1); PG8_SCHED; PG8_LDA(At, 1, 0); PG8_STAGE_A(PG8_SA(0, 1), t2, 1); \
        PG8_WAIT_V(8); PG8_WAIT_L(0); PG8_BAR; PG8_MMA(0, 0, At, B0); PG8_MMA(0, 1, At, B1); PG8_BAR; PG8_SCHED; \
        PG8_LDA(At, 1, 1); PG8_STAGE_B(PG8_SB(1, 0), t3, 0); PG8_STAGE_B(PG8_SB(1, 1), t3, 1); PG8_STAGE_A(PG8_SA(1, 0), t3, 0); \
        PG8_WAIT_V(8); PG8_WAIT_L(0); PG8_BAR; PG8_MMA(1, 0, At, B0); PG8_MMA(1, 1, At, B1); PG8_BAR; PG8_SCHED; \
    } while (0)
    for (int t = 0; t < nt1; t += 2) PG8_DUAL_TRIP(t);
    E.mid(acc, cur, wr, wc, fr, fq);
    for (int t = nt1; t < nt; t += 2) PG8_DUAL_TRIP(t);
#undef PG8_DUAL_TRIP
    E(acc, cur, wr, wc, fr, fq);
    PG8_WAIT_V(0);
    if (wr == 0) PG8_BAR;
    PG8_BAR;
#undef PG8_SA
#undef PG8_SB
#undef PG8_STAGE
#undef PG8_STAGE2
#undef PG8_STAGE_A
#undef PG8_STAGE_B
#undef PG8_LDA
#undef PG8_LDB
#undef PG8_MMA
#undef PG8_WAIT_V
#undef PG8_WAIT_L
#undef PG8_BAR
#undef PG8_SCHED
}
}
#define GAS __attribute__((address_space(1)))
#define LAS __attribute__((address_space(3)))
typedef unsigned short bf16;
typedef unsigned v4u __attribute__((ext_vector_type(4)));
typedef float f32x4 __attribute__((ext_vector_type(4)));
typedef short bf16x8 __attribute__((ext_vector_type(8)));
typedef GAS unsigned gu32;
typedef GAS unsigned long long gu64;
#define RLX_AGENT __ATOMIC_RELAXED, __HIP_MEMORY_SCOPE_AGENT
#define LDS_WAIT() asm volatile("s_waitcnt lgkmcnt(0)" ::: "memory")
#define VM_WAIT() asm volatile("s_waitcnt vmcnt(0)" ::: "memory")
__device__ __forceinline__ unsigned long long rt() { return __builtin_amdgcn_s_memrealtime(); }
__device__ __forceinline__ unsigned f2bf(float f) { unsigned u = __builtin_bit_cast(unsigned, f); return (u + 0x7fffu + ((u >> 16) & 1u)) >> 16; }
typedef __bf16 bf16x2_t __attribute__((ext_vector_type(2)));
typedef float f32x2p __attribute__((ext_vector_type(2)));
__device__ __forceinline__ unsigned pk2(float lo, float hi) { const f32x2p v = {lo, hi}; const bf16x2_t b = __builtin_convertvector(v, bf16x2_t); return __builtin_bit_cast(unsigned, b); }

#define XB_TMO      128
#define XB_XCNT(j)  (256  + 64 * (j))
#define XB_XSUB(j)  (1280 + 64 * (j))
#define XB_XGEN(j)  (2304 + 64 * (j))
#define XB_TOP      3328
#define XB_TOPGEN   3392
#define XCD_BAR_WORDS 3456
#define XB_SPIN_CAP (1u << 18)

__device__ __forceinline__ unsigned xb_ld(unsigned* p)              { return __hip_atomic_load(p, __ATOMIC_RELAXED, __HIP_MEMORY_SCOPE_AGENT); }
__device__ __forceinline__ unsigned xb_add(unsigned* p, unsigned v) { return __hip_atomic_fetch_add(p, v, __ATOMIC_RELAXED, __HIP_MEMORY_SCOPE_AGENT); }
__device__ __forceinline__ unsigned xb_xcc_id() { return (unsigned)__builtin_amdgcn_s_getreg((3 << 11) | 20) & 0xFu; }
#define XB_SPIN(cond, bar) do { unsigned _sp = 0; while (cond) { __builtin_amdgcn_s_sleep(1); \
    if ((++_sp & 255u) == 0u) { if (xb_ld(&(bar)[XB_TMO])) break; if (_sp > XB_SPIN_CAP) { atomicAdd(&(bar)[XB_TMO], 1u); break; } } } } while (0)

struct XcdBarrier {
    unsigned* bar; unsigned x; unsigned ngrp;
    volatile LAS unsigned* st;
};

__device__ __forceinline__ XcdBarrier xcd_barrier_post(unsigned* bar, volatile LAS unsigned* st) {
    XcdBarrier b; b.bar = bar; b.x = xb_xcc_id(); b.st = st; b.ngrp = 0u;
    if (threadIdx.x == 0) (void)xb_add(&bar[XB_XCNT(b.x)], 1u);
    return b;
}
__device__ __forceinline__ void xcd_barrier_complete(unsigned* bar, unsigned x, unsigned& nloc, unsigned& nx, unsigned ngrp) {
    const unsigned G = ngrp ? ngrp : gridDim.x * gridDim.y * gridDim.z;
    unsigned sum, cnt, mine, sp = 0u;
    for (;;) {
        sum = 0u; cnt = 0u; mine = 0u;
#pragma unroll
        for (unsigned j = 0; j < 16; ++j) { const unsigned c = xb_ld(&bar[XB_XCNT(j)]); sum += c; cnt += (c > 0u) ? 1u : 0u; mine = (j == x) ? c : mine; }
        if (sum == G) break;
        __builtin_amdgcn_s_sleep(1);
        if ((++sp & 255u) == 0u) { if (xb_ld(&bar[XB_TMO])) break; if (sp > XB_SPIN_CAP) { atomicAdd(&bar[XB_TMO], 1u); break; } }
    }
    nloc = mine > 0u ? mine : 1u; nx = cnt > 0u ? cnt : 1u;
}

__device__ __forceinline__ void xcd_barrier(const XcdBarrier& b) {
    asm volatile("s_waitcnt vmcnt(0)" ::: "memory");
    __syncthreads();
    if (threadIdx.x == 0) {
        unsigned* bar = b.bar;
        __builtin_amdgcn_s_waitcnt(0);
        unsigned nloc = b.st[0], nx = b.st[1];
        if (nloc == 0u) { xcd_barrier_complete(bar, b.x, nloc, nx, b.ngrp); b.st[0] = nloc; b.st[1] = nx; }
        const unsigned old = xb_add(&bar[XB_XSUB(b.x)], 1u);
        const unsigned gen = old / nloc;
        if (old + 1u == (gen + 1u) * nloc) {
            __builtin_amdgcn_fence(__ATOMIC_RELEASE, "agent");
            asm volatile("s_waitcnt vmcnt(0)" ::: "memory");
            const unsigned og = xb_add(&bar[XB_TOP], 1u);
            const unsigned tg = og / nx;
            if (og + 1u == (tg + 1u) * nx) xb_add(&bar[XB_TOPGEN], 1u);
            else XB_SPIN(xb_ld(&bar[XB_TOPGEN]) == tg, bar);
            __builtin_amdgcn_fence(__ATOMIC_ACQUIRE, "agent");
            xb_add(&bar[XB_XGEN(b.x)], 1u);
            asm volatile("s_waitcnt vmcnt(0)" ::: "memory");
        } else {
            XB_SPIN(xb_ld(&bar[XB_XGEN(b.x)]) == gen, bar);
            __builtin_amdgcn_fence(__ATOMIC_ACQUIRE, "agent");
            asm volatile("s_waitcnt vmcnt(0)" ::: "memory");
        }
    }
    __syncthreads();
}
constexpr int NWAVES = 8, NTHR = 512;
#ifndef MK_PER_PHASE
#define MK_PER_PHASE 0
#endif
constexpr int NPHASE = 8;
constexpr int BATCH = 2, SEQ = 8192, D = 1024, T = BATCH * SEQ, LCTX = 256, TCX = BATCH * LCTX, MROWS = T + TCX;
constexpr int NH = 8, CHK = 64, NCHL = SEQ / CHK, NCHC = LCTX / CHK, NCH = NCHL + NCHC;
constexpr int INW = 7200, NPAD = 7424;
constexpr float EPS = 1e-6f;
constexpr size_t MiB = 1u << 20;
constexpr size_t WS_CTL = 0, CTL_ZERO_BYTES = 1 * MiB, CTL_GRAN = 256 * 1024;
constexpr size_t WS_TAB = 1 * MiB;
constexpr size_t TAB_MODP = 0, TAB_GATE = 589824, TAB_ABAR = 598016, TAB_A64 = 630784, TAB_BBAR = 663552, TAB_BBT = 1187840, TAB_CBT = 1449984;
constexpr size_t WS_WIN = 3 * MiB, WS_WPD = WS_WIN + (size_t)NPAD * D * 2, WS_WPS = WS_WPD + 2 * MiB, WS_WOUT = WS_WPS + 1 * MiB, WS_GLU = WS_WOUT + 2 * MiB;
constexpr size_t WS_QKV = 23 * MiB, WS_QKVC = 119 * MiB, WS_U = 122 * MiB, WS_BD = WS_U + (size_t)MROWS * 512 * 2, WS_RG = 141 * MiB, WS_CTXTA = 253 * MiB, WS_END = 254 * MiB;
static_assert(WS_GLU + 512 * 512 * 2 <= WS_QKV && WS_BD + (size_t)MROWS * 32 * 4 <= WS_RG, "ws map");
constexpr size_t WS_TA = WS_RG, WS_ODIR = WS_RG + 32 * MiB, WS_YDN = WS_RG, WS_M1 = WS_RG + 32 * MiB, WS_MERGED = WS_RG + 64 * MiB, WS_ZS5 = WS_RG + 96 * MiB;
constexpr size_t WS_QKVC_RAW = WS_RG + 32 * MiB;
constexpr size_t WS_ZDN = WS_QKV, WS_GDN = WS_QKV + 32 * MiB, WS_GS5 = WS_QKV + 64 * MiB, WS_YS5 = WS_U;
constexpr size_t DO_H = 0, DO_SC = 33 * MiB, DO_EH = 38 * MiB, DO_Y = 47 * MiB;
constexpr int SCBLK = 256;
constexpr int CW_BAR = 4096, CW_BAR2 = 8192, CW_PAN = 16384, CW_PAN2 = 20480, CW_PAN3 = 24576;
constexpr int RING_BYTES = 143360, LDSCTL_OFF = RING_BYTES, MISC_OFF = LDSCTL_OFF + 320, LDS_BYTES = 147456;
typedef float f32x2 __attribute__((ext_vector_type(2)));
typedef unsigned v2u __attribute__((ext_vector_type(2)));
#define MFMA16(a, b, c) __builtin_amdgcn_mfma_f32_16x16x32_bf16((a), (b), (c), 0, 0, 0)
__device__ __forceinline__ int off256(int row, int slot) { return row * 256 + ((slot ^ (row & 15)) << 4); }
__device__ __forceinline__ int off128(int row, int slot) { return row * 128 + ((slot ^ ((row >> 1) & 7)) << 4); }
__device__ __forceinline__ int img128_byte(int oi, int oj) { return off128(oi, 4 * (oj >> 5) + ((oj >> 2) & 3)) + 8 * ((oj >> 4) & 1) + 2 * (oj & 3); }
typedef short s16x4 __attribute__((ext_vector_type(4)));
__device__ __forceinline__ s16x4 ds_tr(const LAS unsigned char* p) { return __builtin_bit_cast(s16x4, __builtin_amdgcn_ds_read_tr16_b64_v4i16((LAS s16x4*)p)); }
__device__ __forceinline__ unsigned cvtpk_c(float lo, float hi) { const f32x2 v = {lo, hi}; const bf16x2_t b = __builtin_convertvector(v, bf16x2_t); return __builtin_bit_cast(unsigned, b); }
__device__ __forceinline__ float bf2f(unsigned v) { return __builtin_bit_cast(float, v << 16); }
__device__ __forceinline__ float sigmoidf_(float x) { return __builtin_amdgcn_rcpf(1.f + __expf(-x)); }
__device__ __forceinline__ float siluf_(float x) { return x * __builtin_amdgcn_rcpf(1.f + __expf(-x)); }
__device__ __forceinline__ float softplusf_(float x) { return x > 20.f ? x : log1pf(__expf(x)); }
__device__ __forceinline__ float gelu_tanh(float x) { const float u = 0.7978845608028654f * (x + 0.044715f * x * x * x); const float e = __expf(2.f * u); const float th = 1.f - 2.f * __builtin_amdgcn_rcpf(e + 1.f); return 0.5f * x * (1.f + th); }
__device__ __forceinline__ void unpack8(const v4u r, float* f) { f[0] = bf2f(r.x & 0xffffu); f[1] = bf2f(r.x >> 16); f[2] = bf2f(r.y & 0xffffu); f[3] = bf2f(r.y >> 16); f[4] = bf2f(r.z & 0xffffu); f[5] = bf2f(r.z >> 16); f[6] = bf2f(r.w & 0xffffu); f[7] = bf2f(r.w >> 16); }
__device__ __forceinline__ v4u pack8(const float* f) { v4u o; o.x = pk2(f[0], f[1]); o.y = pk2(f[2], f[3]); o.z = pk2(f[4], f[5]); o.w = pk2(f[6], f[7]); return o; }
__device__ __forceinline__ float wave_sum(float v) {
#pragma unroll
    for (int o = 1; o < 64; o <<= 1) v += __shfl_xor(v, o);
    return v;
}

__device__ __forceinline__ float dpp_add(float x, int ctrl_sel) {
    const int xi = __builtin_bit_cast(int, x); int yi;
    if (ctrl_sel == 0) yi = __builtin_amdgcn_update_dpp(0, xi, 0xB1, 0xF, 0xF, false);
    else if (ctrl_sel == 1) yi = __builtin_amdgcn_update_dpp(0, xi, 0x4E, 0xF, 0xF, false);
    else if (ctrl_sel == 2) yi = __builtin_amdgcn_update_dpp(0, xi, 0x141, 0xF, 0xF, false);
    else yi = __builtin_amdgcn_update_dpp(0, xi, 0x140, 0xF, 0xF, false);
    return x + __builtin_bit_cast(float, yi);
}
__device__ __forceinline__ float sum8(float x) { x = dpp_add(x, 0); x = dpp_add(x, 1); return dpp_add(x, 2); }
__device__ __forceinline__ float sum16(float x) { return dpp_add(sum8(x), 3); }
struct Frame {
    LAS unsigned char* lds;
    int tid, lane, wave, vcu, G;
    const float* in[26]; float* out; unsigned char* ws;
};
#define WSP(T_, off) ((T_*)(F.ws + (off)))
#define DOP(T_, off) ((T_*)((unsigned char*)F.out + (off)))
#define TABP(T_, off) ((T_*)(F.ws + WS_TAB + (off)))
enum { I_X = 0, I_C, I_CTX, I_CCTX, I_WADA, I_BADA, I_NORMW, I_WIN, I_CONVW, I_ALOG, I_DTB, I_DNNW, I_LRE, I_LIM, I_LSTEP, I_BRE, I_BIM, I_CRE, I_CIM, I_S5D, I_GLUW, I_GLUB, I_WPD, I_WPS, I_WOUT, I_FNW };

template <int NB> __device__ __forceinline__ void tr_item(const float* W, int K, int N, bf16* WT, LAS float* scr, int k0, int sn0, int dn0, int lane) {
#pragma unroll
    for (int hh = 0; hh < 32 / NB; ++hh) { float tv[NB];
#pragma unroll
        for (int i = 0; i < NB; ++i) tv[i] = W[(size_t)(k0 + 2 * (NB * hh + i) + (lane >> 5)) * N + sn0 + (lane & 31)];
#pragma unroll
        for (int i = 0; i < NB; ++i) scr[(2 * (NB * hh + i) + (lane >> 5)) * 33 + (lane & 31)] = tv[i]; }
    LDS_WAIT(); asm volatile("" ::: "memory");
    const int c = lane & 7;
#pragma unroll
    for (int j = 0; j < 4; ++j) { const int n = (lane >> 3) + 8 * j; const LAS float* s = scr + (8 * c) * 33 + n;
        v4u o; o.x = pk2(s[0 * 33], s[1 * 33]); o.y = pk2(s[2 * 33], s[3 * 33]); o.z = pk2(s[4 * 33], s[5 * 33]); o.w = pk2(s[6 * 33], s[7 * 33]);
        *(v4u*)(WT + (size_t)(dn0 + n) * K + k0 + 8 * c) = o; }
    LDS_WAIT(); asm volatile("" ::: "memory");
}
__device__ __forceinline__ void phase0(Frame& F) {
    LAS float* scr = (LAS float*)(F.lds + F.wave * 16384);
    const int gw = F.vcu * NWAVES + F.wave, NGW = F.G * NWAVES, lane = F.lane;
    constexpr int N_WIN = 16 * 225, N_PD = 512, N_PS = 256, N_OUT = 512, N_GLU = 128, N_Z = 28, N_MOD = 768, N_S5 = 64;
    constexpr int N_ALL = N_WIN + N_PD + N_PS + N_OUT + N_GLU + N_Z + N_MOD + N_S5;
    for (int it = gw; it < N_ALL; it += NGW) {
        int r = it;
        if (r < N_WIN) { const int kb = r / 225, sb = r % 225, db = sb < 96 ? sb : (sb == 96 ? 224 : sb - 1); tr_item<32>(F.in[I_WIN], 1024, INW, WSP(bf16, WS_WIN), scr, kb * 64, sb * 32, db * 32, lane); continue; } r -= N_WIN;
        if (r < N_PD) { tr_item<32>(F.in[I_WPD], 1024, 1024, WSP(bf16, WS_WPD), scr, (r / 32) * 64, (r % 32) * 32, (r % 32) * 32, lane); continue; } r -= N_PD;
        if (r < N_PS) { tr_item<32>(F.in[I_WPS], 512, 1024, WSP(bf16, WS_WPS), scr, (r / 32) * 64, (r % 32) * 32, (r % 32) * 32, lane); continue; } r -= N_PS;
        if (r < N_OUT) { tr_item<32>(F.in[I_WOUT], 1024, 1024, WSP(bf16, WS_WOUT), scr, (r / 32) * 64, (r % 32) * 32, (r % 32) * 32, lane); continue; } r -= N_OUT;
        if (r < N_GLU) { tr_item<32>(F.in[I_GLUW], 512, 512, WSP(bf16, WS_GLU), scr, (r / 16) * 64, (r % 16) * 32, (r % 16) * 32, lane); continue; } r -= N_GLU;
        if (r < N_Z) { v4u* zb = (v4u*)(WSP(bf16, WS_WIN) + (size_t)INW * 1024 + (size_t)r * 8192); const v4u z = {0u, 0u, 0u, 0u};
#pragma unroll
            for (int j = 0; j < 16; ++j) zb[j * 64 + lane] = z; continue; } r -= N_Z;
        if (r < N_MOD) { const int ks = r / 48, j = (r % 48) * 64 + lane; float s0 = 0.f, s1 = 0.f, s2 = 0.f;
            const float* wa = F.in[I_WADA]; const float* cv = F.in[I_C]; const float* cc = F.in[I_CCTX];
#pragma unroll 16
            for (int k = ks * 64; k < ks * 64 + 64; ++k) { const float w = wa[(size_t)k * 3072 + j]; s0 += siluf_(cv[k]) * w; s1 += siluf_(cv[1024 + k]) * w; s2 += siluf_(cc[k]) * w; }
            float* mp = TABP(float, TAB_MODP); mp[(ks * 3 + 0) * 3072 + j] = s0; mp[(ks * 3 + 1) * 3072 + j] = s1; mp[(ks * 3 + 2) * 3072 + j] = s2; continue; } r -= N_MOD;
        { const int idx = r * 64 + lane;
          const int dg = idx >> 6;
          const float lre = F.in[I_LRE][idx], lim = F.in[I_LIM][idx], dt = __expf(F.in[I_LSTEP][dg]);
          const float th = lim * dt, mag = __expf(lre * dt), ct = cosf(th), st = sinf(th), sh = sinf(0.5f * th);
          const float ar = mag * ct, ai = mag * st;
          const float nr = expm1f(lre * dt) * ct - 2.f * sh * sh, ni = ai, den = lre * lre + lim * lim;
          const float fr = (nr * lre + ni * lim) / den, fi = (ni * lre - nr * lim) / den;
          TABP(f32x2, TAB_ABAR)[idx] = (f32x2){ar, ai};
          const double th64 = (double)lim * (double)dt * 64.0; const double tw = th64 - 6.283185307179586 * rint(th64 / 6.283185307179586);
          const float m64 = __expf(64.f * lre * dt);
          TABP(f32x2, TAB_A64)[idx] = (f32x2){m64 * cosf((float)tw), m64 * sinf((float)tw)};
          const float* bre = F.in[I_BRE] + (size_t)idx * 16; const float* bim = F.in[I_BIM] + (size_t)idx * 16; f32x2* bb = TABP(f32x2, TAB_BBAR) + (size_t)idx * 16;
#pragma unroll
          for (int c = 0; c < 16; ++c) bb[c] = (f32x2){fr * bre[c] - fi * bim[c], fr * bim[c] + fi * bre[c]};
          const int p = idx & 63; bf16* bbt = TABP(bf16, TAB_BBT) + (size_t)dg * 2048; bf16* cbt = TABP(bf16, TAB_CBT) + (size_t)dg * 2048;
          float tr_[16], ti_[16];
#pragma unroll
          for (int c = 0; c < 16; ++c) { tr_[c] = fr * bre[c] - fi * bim[c]; ti_[c] = fr * bim[c] + fi * bre[c]; }
          *(v4u*)(bbt + p * 16) = pack8(tr_); *(v4u*)(bbt + p * 16 + 8) = pack8(tr_ + 8);
          *(v4u*)(bbt + (64 + p) * 16) = pack8(ti_); *(v4u*)(bbt + (64 + p) * 16 + 8) = pack8(ti_ + 8);
          const float* cre = F.in[I_CRE] + (size_t)dg * 1024 + p; const float* cim = F.in[I_CIM] + (size_t)dg * 1024 + p;
#pragma unroll
          for (int c = 0; c < 16; ++c) { cbt[c * 128 + p] = (bf16)f2bf(cre[c * 64]); cbt[c * 128 + 64 + p] = (bf16)f2bf(-cim[c * 64]); } }
    }
}
__device__ __forceinline__ void phase1(Frame& F) {
    LAS float* mult = (LAS float*)F.lds; LAS float* shf = mult + 3072;
    const float* mp = TABP(float, TAB_MODP); const float* bada = F.in[I_BADA]; const float* nw = F.in[I_NORMW];
    for (int e = F.tid; e < 3072; e += NTHR) { const int v = e >> 10, d = e & 1023; float sh = bada[d], sc = bada[1024 + d];
        for (int ks = 0; ks < 16; ++ks) { sh += mp[(ks * 3 + v) * 3072 + d]; sc += mp[(ks * 3 + v) * 3072 + 1024 + d]; }
        mult[e] = nw[d] * (1.f + sc); shf[e] = sh; }
    if (blockIdx.x == 0) for (int e = F.tid; e < 2048; e += NTHR) { const int v = e >> 10, d = e & 1023; float gt = bada[2048 + d];
        for (int ks = 0; ks < 16; ++ks) gt += mp[(ks * 3 + v) * 3072 + 2048 + d];
        TABP(float, TAB_GATE)[e] = gt; }
    __syncthreads();
    const int gw = F.vcu * NWAVES + F.wave, NGW = F.G * NWAVES;
    bf16* Hb = DOP(bf16, DO_H);
    for (int r = gw; r < MROWS; r += NGW) {
        const int v = r < SEQ ? 0 : (r < T ? 1 : 2);
        const float* src = r < T ? F.in[I_X] + (size_t)r * D : F.in[I_CTX] + (size_t)(r - T) * D;
        const f32x4* xr = (const f32x4*)src + F.lane;
        f32x4 xv[4]; float s = 0.f;
#pragma unroll
        for (int j = 0; j < 4; ++j) { xv[j] = xr[64 * j]; s += (xv[j].x * xv[j].x + xv[j].y * xv[j].y) + (xv[j].z * xv[j].z + xv[j].w * xv[j].w); }
        const float rinv = __builtin_amdgcn_rsqf(wave_sum(s) * (1.f / D) + EPS);
        unsigned long long* o8 = (unsigned long long*)(Hb + (size_t)r * D) + F.lane;
#pragma unroll
        for (int j = 0; j < 4; ++j) { const int e0 = v * 1024 + 4 * F.lane + 256 * j;
            const f32x4 m = *(const LAS f32x4*)(mult + e0), sh = *(const LAS f32x4*)(shf + e0);
            const f32x4 y = xv[j] * rinv * m + sh;
            o8[64 * j] = (unsigned long long)pk2(y.x, y.y) | ((unsigned long long)pk2(y.z, y.w) << 32); }
    }
}
struct OrderIn {
    pg8::StaticOrder so; bool first;
    __device__ void init(bool first_, int G, int c) { first = first_; if (first_) so.init(MROWS, 15 * 256, G, c); else so.init(T, 12 * 256, G, c); }
    __device__ bool next(int i, pg8::Unit& u) const {
        if (!so.next(i, u)) return false;
        u.pn = first ? (u.pn < 14 ? u.pn : 28) : (u.pn < 4 ? 14 + u.pn : 16 + u.pn); return true;
    }
    __device__ __forceinline__ void a_ready(const pg8::Unit&) const {}
    __device__ __forceinline__ void done(const pg8::Unit&) const {}
};
struct OrderOne {
    pg8::Unit u0;
    __device__ bool next(int i, pg8::Unit& u) const { if (i != 0) return false; u = u0; return true; }
    __device__ __forceinline__ void a_ready(const pg8::Unit&) const {}
    __device__ __forceinline__ void done(const pg8::Unit&) const {}
};
struct EpiIn {
    static constexpr bool PERM = true, AFTER_DRAIN = false;
    bf16 *QKV, *QKVC, *U, *ZDN, *ZS5, *GDN, *GS5; float* BD;
    __device__ __forceinline__ void operator()(const f32x4 (&acc)[2][2][4][2], const pg8::Unit& u, int wr, int wc, int fr, int fq) const {
        const int pn = u.pn; const bool ctx = u.pm >= 64;
#pragma unroll
        for (int ai = 0; ai < 2; ++ai)
#pragma unroll
            for (int m = 0; m < 4; ++m) {
                const int row = u.pm * 256 + ai * 128 + wr * 64 + m * 16 + fr;
#pragma unroll
                for (int bj = 0; bj < 2; ++bj) {
                    const f32x4 v0 = acc[ai][bj][m][0], v1 = acc[ai][bj][m][1];
                    float f[8] = {v0[0], v0[1], v0[2], v0[3], v1[0], v1[1], v1[2], v1[3]};
                    const int colin = bj * 128 + wc * 32 + 8 * fq;
                    if (pn < 12) {
                        const int which = pn >> 2, head = 2 * (pn & 3) + bj, d0 = wc * 32 + 8 * fq;
                        bf16* dst;
                        if (!ctx) { const int b = row >> 13, t = row & 8191; dst = QKV + ((size_t)(((which * 2 + b) * 8 + head) * SEQ + t)) * 128 + d0; }
                        else { const int rr = row - T, b = rr >> 8, t = rr & 255; dst = QKVC + ((size_t)(((which * 2 + b) * 8 + head) * LCTX + t)) * 128 + d0; }
                        *(v4u*)dst = pack8(f);
                    } else if (pn < 14) {
                        *(v4u*)(U + (size_t)row * 512 + (pn - 12) * 256 + colin) = pack8(f);
                    } else if (pn < 28) {
                        if (!ctx) {
                            if (pn < 20) {
#pragma unroll
                                for (int e = 0; e < 8; ++e) f[e] = siluf_(f[e]);
                                if (pn < 18) *(v4u*)(ZDN + (size_t)row * 1024 + (pn - 14) * 256 + colin) = pack8(f);
                                else *(v4u*)(ZS5 + (size_t)row * 512 + (pn - 18) * 256 + colin) = pack8(f);
                            } else {
#pragma unroll
                                for (int e = 0; e < 8; ++e) f[e] = sigmoidf_(f[e]);
                                if (pn < 24) *(v4u*)(GDN + (size_t)row * 1024 + (pn - 20) * 256 + colin) = pack8(f);
                                else *(v4u*)(GS5 + (size_t)row * 1024 + (pn - 24) * 256 + colin) = pack8(f);
                            }
                        }
                    } else {
                        if (bj == 0 && wc == 0) { float* dst = BD + (size_t)row * 32 + 8 * fq; *(f32x4*)dst = v0; *(f32x4*)(dst + 4) = v1; }
                    }
                }
            }
    }
};
typedef short s16x4k __attribute__((ext_vector_type(4)));
#define MFMA16K16(a, b, c) __builtin_amdgcn_mfma_f32_16x16x16bf16_1k((a), (b), (c), 0, 0, 0)
constexpr int S5_BUF_BYTES = 128 * 20 * 4, S5_HT_BYTES = 128 * 48;
template <bool OUT> __device__ __forceinline__ void s5_block(LAS float* buf, LAS unsigned char* hT, const LAS unsigned* ubw, const s16x4k (&bbf)[8], const bf16x8 (&cbf)[4], const f32x2 a, float& hr, float& hi,
                                                             int d, int ib, int lane, LAS float* yb) {
    const int fr = lane & 15, fq = lane >> 4;
    { const int i = 16 * ib + fr, t = d ? 63 - i : i; const v2u au = *(const LAS v2u*)(ubw + t * 8 + 2 * fq); const s16x4k af = __builtin_bit_cast(s16x4k, au);
#pragma unroll
      for (int nt = 0; nt < 8; ++nt) { const f32x4 Dm = MFMA16K16(af, bbf[nt], ((f32x4){0.f, 0.f, 0.f, 0.f}));
          *(LAS f32x4*)(buf + (16 * nt + fr) * 20 + 4 * fq) = Dm; } }
    asm volatile("" ::: "memory");
    f32x4 br[4], bi[4];
#pragma unroll
    for (int q = 0; q < 4; ++q) { br[q] = *(const LAS f32x4*)(buf + lane * 20 + 4 * q); bi[q] = *(const LAS f32x4*)(buf + (64 + lane) * 20 + 4 * q); }
    float hre[16], him[16];
#pragma unroll
    for (int il = 0; il < 16; ++il) { const float nr = a.x * hr - a.y * hi + br[il >> 2][il & 3], ni = a.x * hi + a.y * hr + bi[il >> 2][il & 3]; hr = nr; hi = ni; hre[il] = hr; him[il] = hi; }
    if (OUT) {
        v4u w0, w1;
        w0.x = cvtpk_c(hre[0], hre[1]); w0.y = cvtpk_c(hre[2], hre[3]); w0.z = cvtpk_c(hre[4], hre[5]); w0.w = cvtpk_c(hre[6], hre[7]);
        w1.x = cvtpk_c(hre[8], hre[9]); w1.y = cvtpk_c(hre[10], hre[11]); w1.z = cvtpk_c(hre[12], hre[13]); w1.w = cvtpk_c(hre[14], hre[15]);
        *(LAS v4u*)(hT + lane * 48) = w0; *(LAS v4u*)(hT + lane * 48 + 16) = w1;
        w0.x = cvtpk_c(him[0], him[1]); w0.y = cvtpk_c(him[2], him[3]); w0.z = cvtpk_c(him[4], him[5]); w0.w = cvtpk_c(him[6], him[7]);
        w1.x = cvtpk_c(him[8], him[9]); w1.y = cvtpk_c(him[10], him[11]); w1.z = cvtpk_c(him[12], him[13]); w1.w = cvtpk_c(him[14], him[15]);
        *(LAS v4u*)(hT + (64 + lane) * 48) = w0; *(LAS v4u*)(hT + (64 + lane) * 48 + 16) = w1;
        asm volatile("" ::: "memory");
        f32x4 acc = {0.f, 0.f, 0.f, 0.f};
#pragma unroll
        for (int ks = 0; ks < 4; ++ks) {
            const s16x4 lo = ds_tr(hT + (32 * ks + 8 * fq + (fr >> 2)) * 48 + 8 * (fr & 3)), hi4 = ds_tr(hT + (32 * ks + 8 * fq + 4 + (fr >> 2)) * 48 + 8 * (fr & 3));
            const bf16x8 bfrag = __builtin_shufflevector(lo, hi4, 0, 1, 2, 3, 4, 5, 6, 7);
            acc = MFMA16(cbf[ks], bfrag, acc); }
        { const int i = 16 * ib + fr, t = d ? 63 - i : i; LAS f32x4* yp = (LAS f32x4*)(yb + t * 16 + 4 * fq); *yp = *yp + acc; }
        asm volatile("" ::: "memory");
    }
}
__device__ __forceinline__ void s5_load_bbf(const Frame& F, int dg, int lane, s16x4k (&bbf)[8]) {
    const bf16* bbt = TABP(bf16, TAB_BBT) + (size_t)dg * 2048;
#pragma unroll
    for (int nt = 0; nt < 8; ++nt) bbf[nt] = *(const s16x4k*)(bbt + (16 * nt + (lane & 15)) * 16 + 4 * (lane >> 4));
}
__device__ __forceinline__ void s5a_group(Frame& F, int g, int q0, int nq) {
    LAS float* buf = (LAS float*)(F.lds + F.wave * 12288); LAS unsigned* ubw = (LAS unsigned*)(F.lds + F.wave * 12288 + S5_BUF_BYTES);
    const bf16x8 cdummy[4] = {};
    s16x4k bbf0[8], bbf1[8]; s5_load_bbf(F, g, F.lane, bbf0); s5_load_bbf(F, 32 + g, F.lane, bbf1);
    const f32x2 a0 = TABP(f32x2, TAB_ABAR)[g * 64 + F.lane], a1 = TABP(f32x2, TAB_ABAR)[(32 + g) * 64 + F.lane];
    auto urow = [&](int un) { const int b = un / NCH, ch = un % NCH, r0 = ch < 4 ? T + b * LCTX + ch * CHK : b * SEQ + (ch - 4) * CHK; return WSP(bf16, WS_U) + (size_t)(r0 + F.lane) * 512 + g * 16; };
    v4u n0 = {0u, 0u, 0u, 0u}, n1 = n0;
    { const int un0 = q0 * 8 + F.wave; if (un0 < 2 * NCH) { const bf16* src = urow(un0); n0 = *(const v4u*)src; n1 = *(const v4u*)(src + 8); } }
    for (int un = q0 * 8 + F.wave; un < 2 * NCH; un += nq * 8) {
        const int b = un / NCH, ch = un % NCH;
        *(LAS v4u*)(ubw + F.lane * 8) = n0; *(LAS v4u*)(ubw + F.lane * 8 + 4) = n1;
        if (un + nq * 8 < 2 * NCH) { const bf16* src = urow(un + nq * 8); n0 = *(const v4u*)src; n1 = *(const v4u*)(src + 8); }
        asm volatile("" ::: "memory");
        { float hr = 0.f, hi = 0.f;
          for (int ib = 0; ib < 4; ++ib) s5_block<false>(buf, nullptr, ubw, bbf0, cdummy, a0, hr, hi, 0, ib, F.lane, nullptr);
          DOP(f32x2, DO_EH)[(size_t)(((0 * 2 + b) * NCH + ch) * 32 + g) * 64 + F.lane] = (f32x2){hr, hi}; }
        { float hr = 0.f, hi = 0.f;
          for (int ib = 0; ib < 4; ++ib) s5_block<false>(buf, nullptr, ubw, bbf1, cdummy, a1, hr, hi, 1, ib, F.lane, nullptr);
          DOP(f32x2, DO_EH)[(size_t)(((1 * 2 + b) * NCH + ch) * 32 + g) * 64 + F.lane] = (f32x2){hr, hi}; }
        LDS_WAIT(); asm volatile("" ::: "memory");
    }
}
__device__ __forceinline__ void s5_state_scan(Frame& F, int sidx) {
    if (sidx < 16) {
        const int idx = sidx * NTHR + F.tid, d = idx >> 12, b = (idx >> 11) & 1, g = (idx >> 6) & 31, p = idx & 63;
        const f32x2 a64 = TABP(f32x2, TAB_A64)[(d * 32 + g) * 64 + p];
        f32x2* base = DOP(f32x2, DO_EH) + (size_t)((d * 2 + b) * NCH) * 2048 + g * 64 + p;
        float hr = 0.f, hi = 0.f;
        for (int kb = 0; kb < NCH; kb += 12) { f32x2 e[12];
#pragma unroll
            for (int j = 0; j < 12; ++j) { const int k = kb + j, ch = d == 0 ? k : (k < 4 ? 3 - k : 135 - k); e[j] = base[(size_t)ch * 2048]; }
#pragma unroll
            for (int j = 0; j < 12; ++j) { const int k = kb + j, ch = d == 0 ? k : (k < 4 ? 3 - k : 135 - k); base[(size_t)ch * 2048] = (f32x2){hr, hi};
                const float nr = a64.x * hr - a64.y * hi + e[j].x, ni = a64.x * hi + a64.y * hr + e[j].y; hr = nr; hi = ni; } }
    }
}
constexpr int SB_KP = 0, SB_QP = 16384, SB_TP = 32768, SB_AP = 40960, SB_V = 49152, SB_SC = 53248, SB_SIZE = 54272;
constexpr int XS_OFF = 2 * SB_SIZE, XB_OFF = XS_OFF + 16384, OST_OFF = XB_OFF + 4096, FLG_OFF = OST_OFF + 8192;
static_assert(FLG_OFF + 16 <= RING_BYTES, "scan LDS");
__device__ __forceinline__ bf16x8 packB(const f32x4 a, const f32x4 b) {
    v4u o; o.x = cvtpk_c(a[0], a[1]); o.y = cvtpk_c(a[2], a[3]); o.z = cvtpk_c(b[0], b[1]); o.w = cvtpk_c(b[2], b[3]);
    return __builtin_bit_cast(bf16x8, o);
}
struct ScanStep { bool ctx; int cc; const unsigned char *qimg, *kimg, *vrow, *ta, *sc; };
__device__ __forceinline__ ScanStep scan_step(const Frame& F, int step, int d, int bh) {
    ScanStep s; s.ctx = step < 4; s.cc = s.ctx ? (d ? 3 - step : step) : (d ? 131 - step : step - 4); const int ch132 = s.ctx ? s.cc : 4 + s.cc;
    const bf16* base = s.ctx ? WSP(bf16, WS_QKVC) : WSP(bf16, WS_QKV); const int Lx = s.ctx ? LCTX : SEQ;
    s.qimg = (const unsigned char*)(base + ((size_t)(bh) * Lx + s.cc * CHK) * 128); s.kimg = (const unsigned char*)(base + ((size_t)(16 + bh) * Lx + s.cc * CHK) * 128);
    s.vrow = (const unsigned char*)(base + ((size_t)(32 + bh) * Lx + s.cc * CHK) * 128);
    s.ta = (const unsigned char*)(s.ctx ? WSP(bf16, WS_CTXTA) + (size_t)(bh * 4 + s.cc) * 8192 : WSP(bf16, WS_TA) + (size_t)(bh * NCHL + s.cc) * 8192);
    s.sc = (const unsigned char*)(DOP(float, DO_SC) + (size_t)(((d * 2 + (bh >> 3)) * 8 + (bh & 7)) * NCH + ch132) * SCBLK);
    return s;
}
#define SCAN_BAR() do { asm volatile("s_waitcnt lgkmcnt(0)" ::: "memory"); __builtin_amdgcn_s_barrier(); asm volatile("" ::: "memory"); } while (0)
#define GLDS16(gp, lp) __builtin_amdgcn_global_load_lds((const unsigned*)(gp), (LAS unsigned*)(lp), 16, 0, 0)
template <int LW> __device__ __forceinline__ void dma_issue(const ScanStep& s, LAS unsigned char* B, int pair, int lane) {
    if (LW == 0) {
#pragma unroll
        for (int u = 0; u < 16; ++u) GLDS16(s.kimg + u * 1024 + lane * 16, B + SB_KP + u * 1024);
    } else if (LW == 1) {
        if (!s.ctx) {
#pragma unroll
            for (int u = 0; u < 16; ++u) GLDS16(s.qimg + u * 1024 + lane * 16, B + SB_QP + u * 1024);
        }
    } else if (LW == 2) {
#pragma unroll
        for (int u = 0; u < 8; ++u) GLDS16(s.ta + u * 1024 + lane * 16, B + SB_TP + u * 1024);
        if (!s.ctx) {
#pragma unroll
            for (int u = 0; u < 8; ++u) GLDS16(s.ta + 8192 + u * 1024 + lane * 16, B + SB_AP + u * 1024);
        }
    } else {
#pragma unroll
        for (int u = 0; u < 4; ++u) GLDS16(s.vrow + (16 * u + (lane >> 2)) * 256 + pair * 64 + (lane & 3) * 16, B + SB_V + u * 1024);
        GLDS16(s.sc + lane * 16, B + SB_SC);
    }
}
__device__ __forceinline__ void ost_store(Frame& F, int d, int bh, int pair, int step, int lane) {
    const int cc = d ? 131 - step : step - 4, b = bh >> 3, h = bh & 7;
    bf16* ob = WSP(bf16, WS_ODIR) + ((size_t)d * T + b * SEQ + cc * CHK) * 1024 + h * 128 + pair * 32;
#pragma unroll
    for (int u = 0; u < 4; ++u) { const v4u v = *(const LAS v4u*)(F.lds + OST_OFF + (step & 1) * 4096 + u * 1024 + lane * 16); *(v4u*)(ob + (size_t)(16 * u + (lane >> 2)) * 1024 + (lane & 3) * 8) = v; }
}
template <int LW> __device__ __forceinline__ void scan_dma(Frame& F, int d, int bh, int pair, int probe) {
    const int lane = F.lane;
    if ((probe & 512) && LW != 0) { for (int i = 0; i <= NCH; ++i) SCAN_BAR(); return; }
    if ((probe & 1024) && (LW == 1 || LW == 3)) { for (int i = 0; i <= NCH; ++i) SCAN_BAR(); return; }
    { const ScanStep s0 = scan_step(F, 0, d, bh); dma_issue<LW>(s0, F.lds, pair, lane); }
    asm volatile("s_waitcnt vmcnt(0)" ::: "memory");
    SCAN_BAR();
    for (int step = 0; step < NCH; ++step) {
        if (LW == 3 && step >= 5 && !(probe & 32)) ost_store(F, d, bh, pair, step - 1, lane);
        if (step + 1 < NCH) { const ScanStep s1 = scan_step(F, step + 1, d, bh); dma_issue<LW>(s1, F.lds + ((step + 1) & 1) * SB_SIZE, pair, lane); }
        asm volatile("s_waitcnt vmcnt(0)" ::: "memory");
        SCAN_BAR();
    }
    if (LW == 3 && !(probe & 32)) ost_store(F, d, bh, pair, NCH - 1, lane);
}
struct FragMask { unsigned keep[2][4], diag[2][4]; };
template <int D, bool STRICT> __device__ __forceinline__ FragMask frag_mask(int fr, int fq) {
    FragMask M;
#pragma unroll
    for (int h = 0; h < 2; ++h)
#pragma unroll
        for (int w = 0; w < 4; ++w) { unsigned k = 0u, dg = 0u;
#pragma unroll
            for (int e = 0; e < 2; ++e) { const int jj = 2 * w + e, irel = 16 * h + fr, jrel = 16 * (jj >> 2) + 4 * fq + (jj & 3);
                const bool kp = STRICT ? (D == 0 ? irel > jrel : irel < jrel) : (D == 0 ? irel >= jrel : irel <= jrel);
                k |= kp ? (0xffffu << (16 * e)) : 0u; dg |= (STRICT && irel == jrel) ? (0x3f80u << (16 * e)) : 0u; }
            M.keep[h][w] = k; M.diag[h][w] = dg; }
    return M;
}
__device__ __forceinline__ bf16x8 apply_mask(const bf16x8 f, const unsigned (&keep)[4], const unsigned (&diag)[4]) {
    v4u v = __builtin_bit_cast(v4u, f); v.x = (v.x & keep[0]) | diag[0]; v.y = (v.y & keep[1]) | diag[1]; v.z = (v.z & keep[2]) | diag[2]; v.w = (v.w & keep[3]) | diag[3];
    return __builtin_bit_cast(bf16x8, v);
}
template <int D> __device__ __forceinline__ constexpr int frag_kind(int mt, int ks) { return ks == (mt >> 1) ? 2 : ((ks > (mt >> 1)) == (D == 1) ? 1 : 0); }
template <int D> __device__ __forceinline__ void scan_chain(Frame& F, int slice) {
    const int lane = F.lane, fr = lane & 15, fq = lane >> 4;
    f32x4 Sacc[8]; bf16x8 Sb[4];
#pragma unroll
    for (int m = 0; m < 8; ++m) Sacc[m] = (f32x4){0.f, 0.f, 0.f, 0.f};
#pragma unroll
    for (int k = 0; k < 4; ++k) Sb[k] = (bf16x8){0, 0, 0, 0, 0, 0, 0, 0};
    LAS unsigned char* xs = F.lds + XS_OFF + slice * 8192; LAS unsigned char* xb = F.lds + XB_OFF + slice * 2048;
    volatile LAS unsigned* flg = (volatile LAS unsigned*)(F.lds + FLG_OFF + slice * 8);
    if (lane == 0) *flg = 0u;
    const FragMask TM = frag_mask<D, true>(fr, fq);
    SCAN_BAR();
    for (int step = 0; step < NCH; ++step) {
        const LAS unsigned char* B = F.lds + (step & 1) * SB_SIZE;
        bf16x8 fk[16], ft[8];
#pragma unroll
        for (int ks = 0; ks < 4; ++ks)
#pragma unroll
            for (int mt = 0; mt < 4; ++mt) fk[ks * 4 + mt] = *(const LAS bf16x8*)(B + SB_KP + off256(16 * mt + fr, 4 * ks + fq));
        f32x4 bg4[4], ee4[4], be4[4]; s16x4 vv[4];
#pragma unroll
        for (int mt = 0; mt < 4; ++mt) { const int i0 = 16 * mt + 4 * fq;
            bg4[mt] = *(const LAS f32x4*)(B + SB_SC + i0 * 4); ee4[mt] = *(const LAS f32x4*)(B + SB_SC + 256 + i0 * 4); be4[mt] = *(const LAS f32x4*)(B + SB_SC + 768 + i0 * 4);
            vv[mt] = ds_tr(B + SB_V + (16 * mt + 4 * fq + (fr >> 2)) * 64 + slice * 32 + 8 * (fr & 3)); }
#pragma unroll
        for (int mt = 0; mt < 4; ++mt)
#pragma unroll
            for (int ks = 0; ks < 2; ++ks) if (frag_kind<D>(mt, ks) != 0) ft[2 * mt + ks] = *(const LAS bf16x8*)(B + SB_TP + off128(16 * mt + fr, 4 * ks + fq));
        const float ae = *(const LAS float*)(B + SB_SC + 512 + (D ? 0 : 63) * 4);
        const f32x4 z4 = {0.f, 0.f, 0.f, 0.f};
        f32x4 R[4] = {z4, z4, z4, z4};
#pragma unroll
        for (int ks = 0; ks < 4; ++ks)
#pragma unroll
            for (int mt = 0; mt < 4; ++mt) R[mt] = MFMA16(fk[ks * 4 + mt], Sb[ks], R[mt]);
        __builtin_amdgcn_sched_barrier(0);
        s16x4 tl[16], th[16];
#pragma unroll
        for (int m = 0; m < 8; ++m)
#pragma unroll
            for (int ks = 0; ks < 2; ++ks) {
                tl[m * 2 + ks] = ds_tr(B + SB_KP + off256(32 * ks + 4 * fq + (fr >> 2), 4 * (m >> 1) + (fr & 3)) + 8 * (m & 1));
                th[m * 2 + ks] = ds_tr(B + SB_KP + off256(32 * ks + 16 + 4 * fq + (fr >> 2), 4 * (m >> 1) + (fr & 3)) + 8 * (m & 1)); }
        f32x4 rhs[4];
#pragma unroll
        for (int mt = 0; mt < 4; ++mt) { const f32x4 vf = {bf2f((unsigned short)vv[mt][0]), bf2f((unsigned short)vv[mt][1]), bf2f((unsigned short)vv[mt][2]), bf2f((unsigned short)vv[mt][3])};
            rhs[mt] = be4[mt] * vf - bg4[mt] * R[mt]; }
        const bf16x8 RB0 = packB(rhs[0], rhs[1]), RB1 = packB(rhs[2], rhs[3]);
        f32x4 VN[4] = {z4, z4, z4, z4};
#pragma unroll
        for (int mt = 0; mt < 4; ++mt)
#pragma unroll
            for (int ks = 0; ks < 2; ++ks) {
                const int kind = frag_kind<D>(mt, ks);
                if (kind == 1) VN[mt] = MFMA16(ft[2 * mt + ks], ks == 0 ? RB0 : RB1, VN[mt]);
                else if (kind == 2) VN[mt] = MFMA16(apply_mask(ft[2 * mt + ks], TM.keep[mt & 1], TM.diag[mt & 1]), ks == 0 ? RB0 : RB1, VN[mt]); }
        const bf16x8 VS0 = packB(ee4[0] * VN[0], ee4[1] * VN[1]), VS1 = packB(ee4[2] * VN[2], ee4[3] * VN[3]);
        const bf16x8 VB0 = packB(VN[0], VN[1]), VB1 = packB(VN[2], VN[3]);
        *(LAS bf16x8*)(xb + lane * 16) = VB0; *(LAS bf16x8*)(xb + 1024 + lane * 16) = VB1;
        asm volatile("" ::: "memory");
        if (lane == 0) *flg = (unsigned)(step + 1);
        asm volatile("" ::: "memory");
#pragma unroll
        for (int m = 0; m < 8; ++m) { Sacc[m] = Sacc[m] * ae;
#pragma unroll
            for (int ks = 0; ks < 2; ++ks) { const bf16x8 a = __builtin_shufflevector(tl[m * 2 + ks], th[m * 2 + ks], 0, 1, 2, 3, 4, 5, 6, 7);
                Sacc[m] = MFMA16(a, ks == 0 ? VS0 : VS1, Sacc[m]); } }
#pragma unroll
        for (int k = 0; k < 4; ++k) { Sb[k] = packB(Sacc[2 * k], Sacc[2 * k + 1]); *(LAS bf16x8*)(xs + ((step + 1) & 1) * 4096 + k * 1024 + lane * 16) = Sb[k]; }
        SCAN_BAR();
    }
}
template <int D> __device__ __forceinline__ void scan_out(Frame& F, int bh, int pair, int slice, bool nostore) {
    const int lane = F.lane, fr = lane & 15, fq = lane >> 4, b = bh >> 3, h = bh & 7;
    const LAS unsigned char* xs = F.lds + XS_OFF + slice * 8192; const LAS unsigned char* xb = F.lds + XB_OFF + slice * 2048;
    volatile LAS unsigned* flg = (volatile LAS unsigned*)(F.lds + FLG_OFF + slice * 8);
    const FragMask AM = frag_mask<D, false>(fr, fq);
    SCAN_BAR();
    for (int step = 0; step < 4; ++step) SCAN_BAR();
    for (int step = 4; step < NCH; ++step) {
        const LAS unsigned char* B = F.lds + (step & 1) * SB_SIZE;
        bf16x8 fqv[16], fa[8], sb[4]; f32x4 eG4[4];
#pragma unroll
        for (int k = 0; k < 4; ++k) sb[k] = *(const LAS bf16x8*)(xs + (step & 1) * 4096 + k * 1024 + lane * 16);
#pragma unroll
        for (int ks = 0; ks < 4; ++ks)
#pragma unroll
            for (int mt = 0; mt < 4; ++mt) fqv[ks * 4 + mt] = *(const LAS bf16x8*)(B + SB_QP + off256(16 * mt + fr, 4 * ks + fq));
#pragma unroll
        for (int mt = 0; mt < 4; ++mt) {
#pragma unroll
            for (int ks = 0; ks < 2; ++ks) if (frag_kind<D>(mt, ks) != 0) fa[2 * mt + ks] = *(const LAS bf16x8*)(B + SB_AP + off128(16 * mt + fr, 4 * ks + fq));
            eG4[mt] = *(const LAS f32x4*)(B + SB_SC + 512 + (16 * mt + 4 * fq) * 4); }
        const f32x4 z4 = {0.f, 0.f, 0.f, 0.f};
        f32x4 QS[4] = {z4, z4, z4, z4};
#pragma unroll
        for (int ks = 0; ks < 4; ++ks)
#pragma unroll
            for (int mt = 0; mt < 4; ++mt) QS[mt] = MFMA16(fqv[ks * 4 + mt], sb[ks], QS[mt]);
#pragma unroll
        for (int mt = 0; mt < 4; ++mt) QS[mt] = QS[mt] * eG4[mt];
        while (*flg < (unsigned)(step + 1)) __builtin_amdgcn_s_sleep(1);
        asm volatile("" ::: "memory");
        const bf16x8 VB0 = *(const LAS bf16x8*)(xb + lane * 16), VB1 = *(const LAS bf16x8*)(xb + 1024 + lane * 16);
#pragma unroll
        for (int mt = 0; mt < 4; ++mt) { f32x4 O = QS[mt];
#pragma unroll
            for (int ks = 0; ks < 2; ++ks) { const int kind = frag_kind<D>(mt, ks);
                if (kind == 1) O = MFMA16(fa[2 * mt + ks], ks == 0 ? VB0 : VB1, O);
                else if (kind == 2) { const unsigned zero4[4] = {0u, 0u, 0u, 0u}; O = MFMA16(apply_mask(fa[2 * mt + ks], AM.keep[mt & 1], zero4), ks == 0 ? VB0 : VB1, O); } }
#pragma unroll
            for (int r = 0; r < 4; ++r) { const int i = 16 * mt + 4 * fq + r; *(LAS unsigned short*)(F.lds + OST_OFF + (step & 1) * 4096 + i * 64 + (slice * 16 + fr) * 2) = (unsigned short)f2bf(O[r]); } }
        SCAN_BAR();
    }
}
__device__ __forceinline__ void phase5b(Frame& F, int probe) {
    if ((probe & 64) && F.wave < 4) { for (int i = 0; i <= NCH; ++i) SCAN_BAR(); return; }
    if ((probe & 32) && F.wave >= 4) { for (int i = 0; i <= NCH; ++i) SCAN_BAR(); return; }
    const int seqid = F.vcu >> 3, pair = F.vcu & 3, d = seqid >> 4, bh = seqid & 15;
    const bool ns = (probe & 32) != 0;
    switch (F.wave) {
        case 0: case 1: if (d) scan_chain<1>(F, F.wave); else scan_chain<0>(F, F.wave); break;
        case 2: case 3: if (d) scan_out<1>(F, bh, pair, F.wave - 2, ns); else scan_out<0>(F, bh, pair, F.wave - 2, ns); break;
        case 4: scan_dma<0>(F, d, bh, pair, probe); break;
        case 5: scan_dma<1>(F, d, bh, pair, probe); break;
        case 6: scan_dma<2>(F, d, bh, pair, probe); break;
        default: scan_dma<3>(F, d, bh, pair, probe); break;
    }
}
constexpr int PP_PITCH = 68, PP_BYTES = 64 * PP_PITCH * 4, PP_GOFF = 4 * PP_BYTES;
struct PrepUnit { const bf16 *kbase, *qbase; int rowbase, ch132, b, h; bf16* ta; };
__device__ __forceinline__ PrepUnit prep_unit(const Frame& F, int uid) {
    PrepUnit u; const bool ctx = uid < 64; const int v = ctx ? uid : uid - 64;
    const int bh = ctx ? (v >> 2) : (v >> 7), cc = ctx ? (v & 3) : (v & 127); u.b = bh >> 3; u.h = bh & 7;
    u.kbase = ctx ? WSP(bf16, WS_QKVC) + ((size_t)(16 + bh) * LCTX + cc * CHK) * 128 : WSP(bf16, WS_QKV) + ((size_t)(16 + bh) * SEQ + cc * CHK) * 128;
    u.qbase = ctx ? WSP(bf16, WS_QKVC) + ((size_t)(bh) * LCTX + cc * CHK) * 128 : WSP(bf16, WS_QKV) + ((size_t)(bh) * SEQ + cc * CHK) * 128;
    u.rowbase = ctx ? T + u.b * LCTX + cc * CHK : u.b * SEQ + cc * CHK; u.ch132 = ctx ? cc : 4 + cc;
    u.ta = ctx ? WSP(bf16, WS_CTXTA) + (size_t)v * 8192 : WSP(bf16, WS_TA) + (size_t)v * 8192;
    return u;
}
template <int M> __device__ __forceinline__ void fmac_chunk(float (&s)[4], float t, const float* x) {
    if constexpr (M == 1) asm("v_fmac_f32_dpp %0, %4, %5 row_newbcast:0 row_mask:0xf bank_mask:0xf" : "+v"(s[0]), "+v"(s[1]), "+v"(s[2]), "+v"(s[3]) : "v"(t), "v"(x[0]));
    if constexpr (M == 2) asm("v_fmac_f32_dpp %0, %4, %5 row_newbcast:0 row_mask:0xf bank_mask:0xf\n\tv_fmac_f32_dpp %1, %4, %6 row_newbcast:1 row_mask:0xf bank_mask:0xf" : "+v"(s[0]), "+v"(s[1]), "+v"(s[2]), "+v"(s[3]) : "v"(t), "v"(x[0]), "v"(x[1]));
    if constexpr (M == 3) asm("v_fmac_f32_dpp %0, %4, %5 row_newbcast:0 row_mask:0xf bank_mask:0xf\n\tv_fmac_f32_dpp %1, %4, %6 row_newbcast:1 row_mask:0xf bank_mask:0xf\n\tv_fmac_f32_dpp %2, %4, %7 row_newbcast:2 row_mask:0xf bank_mask:0xf" : "+v"(s[0]), "+v"(s[1]), "+v"(s[2]), "+v"(s[3]) : "v"(t), "v"(x[0]), "v"(x[1]), "v"(x[2]));
    if constexpr (M == 4) asm("v_fmac_f32_dpp %0, %4, %5 row_newbcast:0 row_mask:0xf bank_mask:0xf\n\tv_fmac_f32_dpp %1, %4, %6 row_newbcast:1 row_mask:0xf bank_mask:0xf\n\tv_fmac_f32_dpp %2, %4, %7 row_newbcast:2 row_mask:0xf bank_mask:0xf\n\tv_fmac_f32_dpp %3, %4, %8 row_newbcast:3 row_mask:0xf bank_mask:0xf" : "+v"(s[0]), "+v"(s[1]), "+v"(s[2]), "+v"(s[3]) : "v"(t), "v"(x[0]), "v"(x[1]), "v"(x[2]), "v"(x[3]));
    if constexpr (M == 5) asm("v_fmac_f32_dpp %0, %4, %5 row_newbcast:0 row_mask:0xf bank_mask:0xf\n\tv_fmac_f32_dpp %1, %4, %6 row_newbcast:1 row_mask:0xf bank_mask:0xf\n\tv_fmac_f32_dpp %2, %4, %7 row_newbcast:2 row_mask:0xf bank_mask:0xf\n\tv_fmac_f32_dpp %3, %4, %8 row_newbcast:3 row_mask:0xf bank_mask:0xf\n\tv_fmac_f32_dpp %0, %4, %9 row_newbcast:4 row_mask:0xf bank_mask:0xf" : "+v"(s[0]), "+v"(s[1]), "+v"(s[2]), "+v"(s[3]) : "v"(t), "v"(x[0]), "v"(x[1]), "v"(x[2]), "v"(x[3]), "v"(x[4]));
    if constexpr (M == 6) asm("v_fmac_f32_dpp %0, %4, %5 row_newbcast:0 row_mask:0xf bank_mask:0xf\n\tv_fmac_f32_dpp %1, %4, %6 row_newbcast:1 row_mask:0xf bank_mask:0xf\n\tv_fmac_f32_dpp %2, %4, %7 row_newbcast:2 row_mask:0xf bank_mask:0xf\n\tv_fmac_f32_dpp %3, %4, %8 row_newbcast:3 row_mask:0xf bank_mask:0xf\n\tv_fmac_f32_dpp %0, %4, %9 row_newbcast:4 row_mask:0xf bank_mask:0xf\n\tv_fmac_f32_dpp %1, %4, %10 row_newbcast:5 row_mask:0xf bank_mask:0xf" : "+v"(s[0]), "+v"(s[1]), "+v"(s[2]), "+v"(s[3]) : "v"(t), "v"(x[0]), "v"(x[1]), "v"(x[2]), "v"(x[3]), "v"(x[4]), "v"(x[5]));
    if constexpr (M == 7) asm("v_fmac_f32_dpp %0, %4, %5 row_newbcast:0 row_mask:0xf bank_mask:0xf\n\tv_fmac_f32_dpp %1, %4, %6 row_newbcast:1 row_mask:0xf bank_mask:0xf\n\tv_fmac_f32_dpp %2, %4, %7 row_newbcast:2 row_mask:0xf bank_mask:0xf\n\tv_fmac_f32_dpp %3, %4, %8 row_newbcast:3 row_mask:0xf bank_mask:0xf\n\tv_fmac_f32_dpp %0, %4, %9 row_newbcast:4 row_mask:0xf bank_mask:0xf\n\tv_fmac_f32_dpp %1, %4, %10 row_newbcast:5 row_mask:0xf bank_mask:0xf\n\tv_fmac_f32_dpp %2, %4, %11 row_newbcast:6 row_mask:0xf bank_mask:0xf" : "+v"(s[0]), "+v"(s[1]), "+v"(s[2]), "+v"(s[3]) : "v"(t), "v"(x[0]), "v"(x[1]), "v"(x[2]), "v"(x[3]), "v"(x[4]), "v"(x[5]), "v"(x[6]));
    if constexpr (M == 8) asm("v_fmac_f32_dpp %0, %4, %5 row_newbcast:0 row_mask:0xf bank_mask:0xf\n\tv_fmac_f32_dpp %1, %4, %6 row_newbcast:1 row_mask:0xf bank_mask:0xf\n\tv_fmac_f32_dpp %2, %4, %7 row_newbcast:2 row_mask:0xf bank_mask:0xf\n\tv_fmac_f32_dpp %3, %4, %8 row_newbcast:3 row_mask:0xf bank_mask:0xf\n\tv_fmac_f32_dpp %0, %4, %9 row_newbcast:4 row_mask:0xf bank_mask:0xf\n\tv_fmac_f32_dpp %1, %4, %10 row_newbcast:5 row_mask:0xf bank_mask:0xf\n\tv_fmac_f32_dpp %2, %4, %11 row_newbcast:6 row_mask:0xf bank_mask:0xf\n\tv_fmac_f32_dpp %3, %4, %12 row_newbcast:7 row_mask:0xf bank_mask:0xf" : "+v"(s[0]), "+v"(s[1]), "+v"(s[2]), "+v"(s[3]) : "v"(t), "v"(x[0]), "v"(x[1]), "v"(x[2]), "v"(x[3]), "v"(x[4]), "v"(x[5]), "v"(x[6]), "v"(x[7]));
    if constexpr (M == 9) asm("v_fmac_f32_dpp %0, %4, %5 row_newbcast:0 row_mask:0xf bank_mask:0xf\n\tv_fmac_f32_dpp %1, %4, %6 row_newbcast:1 row_mask:0xf bank_mask:0xf\n\tv_fmac_f32_dpp %2, %4, %7 row_newbcast:2 row_mask:0xf bank_mask:0xf\n\tv_fmac_f32_dpp %3, %4, %8 row_newbcast:3 row_mask:0xf bank_mask:0xf\n\tv_fmac_f32_dpp %0, %4, %9 row_newbcast:4 row_mask:0xf bank_mask:0xf\n\tv_fmac_f32_dpp %1, %4, %10 row_newbcast:5 row_mask:0xf bank_mask:0xf\n\tv_fmac_f32_dpp %2, %4, %11 row_newbcast:6 row_mask:0xf bank_mask:0xf\n\tv_fmac_f32_dpp %3, %4, %12 row_newbcast:7 row_mask:0xf bank_mask:0xf\n\tv_fmac_f32_dpp %0, %4, %13 row_newbcast:8 row_mask:0xf bank_mask:0xf" : "+v"(s[0]), "+v"(s[1]), "+v"(s[2]), "+v"(s[3]) : "v"(t), "v"(x[0]), "v"(x[1]), "v"(x[2]), "v"(x[3]), "v"(x[4]), "v"(x[5]), "v"(x[6]), "v"(x[7]), "v"(x[8]));
    if constexpr (M == 10) asm("v_fmac_f32_dpp %0, %4, %5 row_newbcast:0 row_mask:0xf bank_mask:0xf\n\tv_fmac_f32_dpp %1, %4, %6 row_newbcast:1 row_mask:0xf bank_mask:0xf\n\tv_fmac_f32_dpp %2, %4, %7 row_newbcast:2 row_mask:0xf bank_mask:0xf\n\tv_fmac_f32_dpp %3, %4, %8 row_newbcast:3 row_mask:0xf bank_mask:0xf\n\tv_fmac_f32_dpp %0, %4, %9 row_newbcast:4 row_mask:0xf bank_mask:0xf\n\tv_fmac_f32_dpp %1, %4, %10 row_newbcast:5 row_mask:0xf bank_mask:0xf\n\tv_fmac_f32_dpp %2, %4, %11 row_newbcast:6 row_mask:0xf bank_mask:0xf\n\tv_fmac_f32_dpp %3, %4, %12 row_newbcast:7 row_mask:0xf bank_mask:0xf\n\tv_fmac_f32_dpp %0, %4, %13 row_newbcast:8 row_mask:0xf bank_mask:0xf\n\tv_fmac_f32_dpp %1, %4, %14 row_newbcast:9 row_mask:0xf bank_mask:0xf" : "+v"(s[0]), "+v"(s[1]), "+v"(s[2]), "+v"(s[3]) : "v"(t), "v"(x[0]), "v"(x[1]), "v"(x[2]), "v"(x[3]), "v"(x[4]), "v"(x[5]), "v"(x[6]), "v"(x[7]), "v"(x[8]), "v"(x[9]));
    if constexpr (M == 11) asm("v_fmac_f32_dpp %0, %4, %5 row_newbcast:0 row_mask:0xf bank_mask:0xf\n\tv_fmac_f32_dpp %1, %4, %6 row_newbcast:1 row_mask:0xf bank_mask:0xf\n\tv_fmac_f32_dpp %2, %4, %7 row_newbcast:2 row_mask:0xf bank_mask:0xf\n\tv_fmac_f32_dpp %3, %4, %8 row_newbcast:3 row_mask:0xf bank_mask:0xf\n\tv_fmac_f32_dpp %0, %4, %9 row_newbcast:4 row_mask:0xf bank_mask:0xf\n\tv_fmac_f32_dpp %1, %4, %10 row_newbcast:5 row_mask:0xf bank_mask:0xf\n\tv_fmac_f32_dpp %2, %4, %11 row_newbcast:6 row_mask:0xf bank_mask:0xf\n\tv_fmac_f32_dpp %3, %4, %12 row_newbcast:7 row_mask:0xf bank_mask:0xf\n\tv_fmac_f32_dpp %0, %4, %13 row_newbcast:8 row_mask:0xf bank_mask:0xf\n\tv_fmac_f32_dpp %1, %4, %14 row_newbcast:9 row_mask:0xf bank_mask:0xf\n\tv_fmac_f32_dpp %2, %4, %15 row_newbcast:10 row_mask:0xf bank_mask:0xf" : "+v"(s[0]), "+v"(s[1]), "+v"(s[2]), "+v"(s[3]) : "v"(t), "v"(x[0]), "v"(x[1]), "v"(x[2]), "v"(x[3]), "v"(x[4]), "v"(x[5]), "v"(x[6]), "v"(x[7]), "v"(x[8]), "v"(x[9]), "v"(x[10]));
    if constexpr (M == 12) asm("v_fmac_f32_dpp %0, %4, %5 row_newbcast:0 row_mask:0xf bank_mask:0xf\n\tv_fmac_f32_dpp %1, %4, %6 row_newbcast:1 row_mask:0xf bank_mask:0xf\n\tv_fmac_f32_dpp %2, %4, %7 row_newbcast:2 row_mask:0xf bank_mask:0xf\n\tv_fmac_f32_dpp %3, %4, %8 row_newbcast:3 row_mask:0xf bank_mask:0xf\n\tv_fmac_f32_dpp %0, %4, %9 row_newbcast:4 row_mask:0xf bank_mask:0xf\n\tv_fmac_f32_dpp %1, %4, %10 row_newbcast:5 row_mask:0xf bank_mask:0xf\n\tv_fmac_f32_dpp %2, %4, %11 row_newbcast:6 row_mask:0xf bank_mask:0xf\n\tv_fmac_f32_dpp %3, %4, %12 row_newbcast:7 row_mask:0xf bank_mask:0xf\n\tv_fmac_f32_dpp %0, %4, %13 row_newbcast:8 row_mask:0xf bank_mask:0xf\n\tv_fmac_f32_dpp %1, %4, %14 row_newbcast:9 row_mask:0xf bank_mask:0xf\n\tv_fmac_f32_dpp %2, %4, %15 row_newbcast:10 row_mask:0xf bank_mask:0xf\n\tv_fmac_f32_dpp %3, %4, %16 row_newbcast:11 row_mask:0xf bank_mask:0xf" : "+v"(s[0]), "+v"(s[1]), "+v"(s[2]), "+v"(s[3]) : "v"(t), "v"(x[0]), "v"(x[1]), "v"(x[2]), "v"(x[3]), "v"(x[4]), "v"(x[5]), "v"(x[6]), "v"(x[7]), "v"(x[8]), "v"(x[9]), "v"(x[10]), "v"(x[11]));
    if constexpr (M == 13) asm("v_fmac_f32_dpp %0, %4, %5 row_newbcast:0 row_mask:0xf bank_mask:0xf\n\tv_fmac_f32_dpp %1, %4, %6 row_newbcast:1 row_mask:0xf bank_mask:0xf\n\tv_fmac_f32_dpp %2, %4, %7 row_newbcast:2 row_mask:0xf bank_mask:0xf\n\tv_fmac_f32_dpp %3, %4, %8 row_newbcast:3 row_mask:0xf bank_mask:0xf\n\tv_fmac_f32_dpp %0, %4, %9 row_newbcast:4 row_mask:0xf bank_mask:0xf\n\tv_fmac_f32_dpp %1, %4, %10 row_newbcast:5 row_mask:0xf bank_mask:0xf\n\tv_fmac_f32_dpp %2, %4, %11 row_newbcast:6 row_mask:0xf bank_mask:0xf\n\tv_fmac_f32_dpp %3, %4, %12 row_newbcast:7 row_mask:0xf bank_mask:0xf\n\tv_fmac_f32_dpp %0, %4, %13 row_newbcast:8 row_mask:0xf bank_mask:0xf\n\tv_fmac_f32_dpp %1, %4, %14 row_newbcast:9 row_mask:0xf bank_mask:0xf\n\tv_fmac_f32_dpp %2, %4, %15 row_newbcast:10 row_mask:0xf bank_mask:0xf\n\tv_fmac_f32_dpp %3, %4, %16 row_newbcast:11 row_mask:0xf bank_mask:0xf\n\tv_fmac_f32_dpp %0, %4, %17 row_newbcast:12 row_mask:0xf bank_mask:0xf" : "+v"(s[0]), "+v"(s[1]), "+v"(s[2]), "+v"(s[3]) : "v"(t), "v"(x[0]), "v"(x[1]), "v"(x[2]), "v"(x[3]), "v"(x[4]), "v"(x[5]), "v"(x[6]), "v"(x[7]), "v"(x[8]), "v"(x[9]), "v"(x[10]), "v"(x[11]), "v"(x[12]));
    if constexpr (M == 14) asm("v_fmac_f32_dpp %0, %4, %5 row_newbcast:0 row_mask:0xf bank_mask:0xf\n\tv_fmac_f32_dpp %1, %4, %6 row_newbcast:1 row_mask:0xf bank_mask:0xf\n\tv_fmac_f32_dpp %2, %4, %7 row_newbcast:2 row_mask:0xf bank_mask:0xf\n\tv_fmac_f32_dpp %3, %4, %8 row_newbcast:3 row_mask:0xf bank_mask:0xf\n\tv_fmac_f32_dpp %0, %4, %9 row_newbcast:4 row_mask:0xf bank_mask:0xf\n\tv_fmac_f32_dpp %1, %4, %10 row_newbcast:5 row_mask:0xf bank_mask:0xf\n\tv_fmac_f32_dpp %2, %4, %11 row_newbcast:6 row_mask:0xf bank_mask:0xf\n\tv_fmac_f32_dpp %3, %4, %12 row_newbcast:7 row_mask:0xf bank_mask:0xf\n\tv_fmac_f32_dpp %0, %4, %13 row_newbcast:8 row_mask:0xf bank_mask:0xf\n\tv_fmac_f32_dpp %1, %4, %14 row_newbcast:9 row_mask:0xf bank_mask:0xf\n\tv_fmac_f32_dpp %2, %4, %15 row_newbcast:10 row_mask:0xf bank_mask:0xf\n\tv_fmac_f32_dpp %3, %4, %16 row_newbcast:11 row_mask:0xf bank_mask:0xf\n\tv_fmac_f32_dpp %0, %4, %17 row_newbcast:12 row_mask:0xf bank_mask:0xf\n\tv_fmac_f32_dpp %1, %4, %18 row_newbcast:13 row_mask:0xf bank_mask:0xf" : "+v"(s[0]), "+v"(s[1]), "+v"(s[2]), "+v"(s[3]) : "v"(t), "v"(x[0]), "v"(x[1]), "v"(x[2]), "v"(x[3]), "v"(x[4]), "v"(x[5]), "v"(x[6]), "v"(x[7]), "v"(x[8]), "v"(x[9]), "v"(x[10]), "v"(x[11]), "v"(x[12]), "v"(x[13]));
    if constexpr (M == 15) asm("v_fmac_f32_dpp %0, %4, %5 row_newbcast:0 row_mask:0xf bank_mask:0xf\n\tv_fmac_f32_dpp %1, %4, %6 row_newbcast:1 row_mask:0xf bank_mask:0xf\n\tv_fmac_f32_dpp %2, %4, %7 row_newbcast:2 row_mask:0xf bank_mask:0xf\n\tv_fmac_f32_dpp %3, %4, %8 row_newbcast:3 row_mask:0xf bank_mask:0xf\n\tv_fmac_f32_dpp %0, %4, %9 row_newbcast:4 row_mask:0xf bank_mask:0xf\n\tv_fmac_f32_dpp %1, %4, %10 row_newbcast:5 row_mask:0xf bank_mask:0xf\n\tv_fmac_f32_dpp %2, %4, %11 row_newbcast:6 row_mask:0xf bank_mask:0xf\n\tv_fmac_f32_dpp %3, %4, %12 row_newbcast:7 row_mask:0xf bank_mask:0xf\n\tv_fmac_f32_dpp %0, %4, %13 row_newbcast:8 row_mask:0xf bank_mask:0xf\n\tv_fmac_f32_dpp %1, %4, %14 row_newbcast:9 row_mask:0xf bank_mask:0xf\n\tv_fmac_f32_dpp %2, %4, %15 row_newbcast:10 row_mask:0xf bank_mask:0xf\n\tv_fmac_f32_dpp %3, %4, %16 row_newbcast:11 row_mask:0xf bank_mask:0xf\n\tv_fmac_f32_dpp %0, %4, %17 row_newbcast:12 row_mask:0xf bank_mask:0xf\n\tv_fmac_f32_dpp %1, %4, %18 row_newbcast:13 row_mask:0xf bank_mask:0xf\n\tv_fmac_f32_dpp %2, %4, %19 row_newbcast:14 row_mask:0xf bank_mask:0xf" : "+v"(s[0]), "+v"(s[1]), "+v"(s[2]), "+v"(s[3]) : "v"(t), "v"(x[0]), "v"(x[1]), "v"(x[2]), "v"(x[3]), "v"(x[4]), "v"(x[5]), "v"(x[6]), "v"(x[7]), "v"(x[8]), "v"(x[9]), "v"(x[10]), "v"(x[11]), "v"(x[12]), "v"(x[13]), "v"(x[14]));
    if constexpr (M == 16) asm("v_fmac_f32_dpp %0, %4, %5 row_newbcast:0 row_mask:0xf bank_mask:0xf\n\tv_fmac_f32_dpp %1, %4, %6 row_newbcast:1 row_mask:0xf bank_mask:0xf\n\tv_fmac_f32_dpp %2, %4, %7 row_newbcast:2 row_mask:0xf bank_mask:0xf\n\tv_fmac_f32_dpp %3, %4, %8 row_newbcast:3 row_mask:0xf bank_mask:0xf\n\tv_fmac_f32_dpp %0, %4, %9 row_newbcast:4 row_mask:0xf bank_mask:0xf\n\tv_fmac_f32_dpp %1, %4, %10 row_newbcast:5 row_mask:0xf bank_mask:0xf\n\tv_fmac_f32_dpp %2, %4, %11 row_newbcast:6 row_mask:0xf bank_mask:0xf\n\tv_fmac_f32_dpp %3, %4, %12 row_newbcast:7 row_mask:0xf bank_mask:0xf\n\tv_fmac_f32_dpp %0, %4, %13 row_newbcast:8 row_mask:0xf bank_mask:0xf\n\tv_fmac_f32_dpp %1, %4, %14 row_newbcast:9 row_mask:0xf bank_mask:0xf\n\tv_fmac_f32_dpp %2, %4, %15 row_newbcast:10 row_mask:0xf bank_mask:0xf\n\tv_fmac_f32_dpp %3, %4, %16 row_newbcast:11 row_mask:0xf bank_mask:0xf\n\tv_fmac_f32_dpp %0, %4, %17 row_newbcast:12 row_mask:0xf bank_mask:0xf\n\tv_fmac_f32_dpp %1, %4, %18 row_newbcast:13 row_mask:0xf bank_mask:0xf\n\tv_fmac_f32_dpp %2, %4, %19 row_newbcast:14 row_mask:0xf bank_mask:0xf\n\tv_fmac_f32_dpp %3, %4, %20 row_newbcast:15 row_mask:0xf bank_mask:0xf" : "+v"(s[0]), "+v"(s[1]), "+v"(s[2]), "+v"(s[3]) : "v"(t), "v"(x[0]), "v"(x[1]), "v"(x[2]), "v"(x[3]), "v"(x[4]), "v"(x[5]), "v"(x[6]), "v"(x[7]), "v"(x[8]), "v"(x[9]), "v"(x[10]), "v"(x[11]), "v"(x[12]), "v"(x[13]), "v"(x[14]), "v"(x[15]));
}
template <int DIR> __device__ __forceinline__ int eidx(int i, int j) { return DIR == 0 ? i * PP_PITCH + j : (63 - i) * PP_PITCH + (63 - j); }
template <int R> __device__ __forceinline__ void diag_row(float (&dg)[16], const float (&t)[16], int c) {
    float s[4] = {0.f, 0.f, 0.f, 0.f};
    if constexpr (R > 0) fmac_chunk<(R > 0 ? R : 1)>(s, t[R], dg);
    dg[R] = ((c == R) ? 1.f : 0.f) - ((s[0] + s[1]) + (s[2] + s[3]));
}
template <int... Rs> __device__ __forceinline__ void diag_rows(float (&dg)[16], const float (&t)[16], int c, std::integer_sequence<int, Rs...>) { (diag_row<Rs>(dg, t, c), ...); }
template <int DIR> __device__ __forceinline__ void prep_solve(LAS float* P, LAS float* S, int lane_) {
    int lane = lane_; asm volatile("" : "+v"(lane));
    const int q = lane >> 4, n = lane & 15;
    {
        LAS float* Bd = P + eidx<DIR>(16 * q, 16 * q + n); constexpr int RS = DIR == 0 ? PP_PITCH : -PP_PITCH;
        float t[16], dg[16];
#pragma unroll
        for (int r = 0; r < 16; ++r) t[r] = Bd[r * RS];
        diag_rows(dg, t, n, std::make_integer_sequence<int, 16>{});
#pragma unroll
        for (int r = 1; r < 16; ++r) if (n < r) Bd[r * RS] = dg[r];
    }
#pragma unroll
    for (int I = 1; I < 4; ++I) {
        f32x4 xs[3];
#pragma unroll
        for (int J = I - 1; J >= 0; --J) {
            f32x4 acc = {0.f, 0.f, 0.f, 0.f};
#pragma unroll
            for (int K = J; K < I; ++K)
#pragma unroll
                for (int ks = 0; ks < 4; ++ks) { const int kk = 4 * ks + q;
                    const float a = P[eidx<DIR>(16 * I + n, 16 * K + kk)];
                    float b = P[eidx<DIR>(16 * K + kk, 16 * J + n)];
                    if (K == J) b = n < kk ? b : (n == kk ? 1.f : 0.f);
                    acc = __builtin_amdgcn_mfma_f32_16x16x4f32(a, b, acc, 0, 0, 0); }
#pragma unroll
            for (int r = 0; r < 4; ++r) S[(4 * q + r) * 17 + n] = acc[r];
            f32x4 acc2 = {0.f, 0.f, 0.f, 0.f};
#pragma unroll
            for (int ks = 0; ks < 4; ++ks) { const int kk = 4 * ks + q;
                float a = P[eidx<DIR>(16 * I + n, 16 * I + kk)]; a = kk < n ? a : (kk == n ? 1.f : 0.f);
                acc2 = __builtin_amdgcn_mfma_f32_16x16x4f32(a, S[kk * 17 + n], acc2, 0, 0, 0); }
            xs[J] = -acc2;
        }
#pragma unroll
        for (int J = 0; J < I; ++J)
#pragma unroll
            for (int r = 0; r < 4; ++r) P[eidx<DIR>(16 * I + 4 * q + r, 16 * J + n)] = xs[J][r];
    }
}
__device__ __forceinline__ void prep_store(const LAS float* P, int half, int lane, bf16* ta) {
#pragma unroll
    for (int it = 0; it < 8; ++it) { const int row = half * 32 + it * 4 + (lane >> 4), g = lane & 15;
        f32x4 v = *(const LAS f32x4*)(P + row * PP_PITCH + 4 * g);
        if ((row >> 2) == g) v[row & 3] = 1.f;
        *(v2u*)((unsigned char*)ta + off128(row, 4 * (g >> 3) + (g & 3)) + 8 * ((g >> 2) & 1)) = (v2u){pk2(v[0], v[1]), pk2(v[2], v[3])}; }
}
__device__ __forceinline__ void conv_tile(Frame& F, int uid) {
    const float* cw = F.in[I_CONVW];
    const int lane = F.lane, tg = lane >> 4, c8 = lane & 15;
    {
        int which, bh, ck, Lx; const bf16* src; bf16* dst;
        if (uid < 192) { which = uid / 64; bh = (uid % 64) >> 2; ck = uid & 3; Lx = LCTX; src = WSP(bf16, WS_QKVC_RAW) + (size_t)((which * 16 + bh) * LCTX) * 128; dst = WSP(bf16, WS_QKVC) + (size_t)((which * 16 + bh) * LCTX) * 128; }
        else { const int v = uid - 192; which = v / (16 * NCHL); const int rem = v % (16 * NCHL); bh = rem / NCHL; ck = 0; Lx = CHK; bf16* p = WSP(bf16, WS_QKV) + ((size_t)(which * 16 + bh) * SEQ + (rem % NCHL) * CHK) * 128; src = p; dst = p; }
        const int h = bh & 7, ch0 = which * 1024 + h * 128 + c8 * 8, t0 = ck * 64 + tg * 16;
        float w[5][8];
#pragma unroll
        for (int j = 0; j < 5; ++j) { const f32x4 a = *(const f32x4*)(cw + j * 3072 + ch0), b2 = *(const f32x4*)(cw + j * 3072 + ch0 + 4);
            w[j][0] = a[0]; w[j][1] = a[1]; w[j][2] = a[2]; w[j][3] = a[3]; w[j][4] = b2[0]; w[j][5] = b2[1]; w[j][6] = b2[2]; w[j][7] = b2[3]; }
        v4u xr[20];
#pragma unroll
        for (int r = 0; r < 20; ++r) { const int t = t0 + r - 2; xr[r] = (t >= 0 && t < Lx) ? *(const v4u*)(src + (size_t)t * 128 + c8 * 8) : (v4u){0u, 0u, 0u, 0u}; }
        asm volatile("s_waitcnt vmcnt(0)" ::: "memory");
        float win[5][8];
#pragma unroll
        for (int r = 0; r < 4; ++r) unpack8(xr[r], win[r + 1]);
#pragma unroll
        for (int t = 0; t < 16; ++t) {
#pragma unroll
            for (int r = 0; r < 4; ++r)
#pragma unroll
                for (int e = 0; e < 8; ++e) win[r][e] = win[r + 1][e];
            unpack8(xr[t + 4], win[4]);
            float y[8]; float ss = 0.f;
#pragma unroll
            for (int e = 0; e < 8; ++e) { float a = w[0][e] * win[0][e]; a += w[1][e] * win[1][e]; a += w[2][e] * win[2][e]; a += w[3][e] * win[3][e]; a += w[4][e] * win[4][e]; y[e] = siluf_(a); ss += y[e] * y[e]; }
            if (which < 2) { ss = sum16(ss);
                const float sc = (__builtin_amdgcn_rsqf(ss + EPS)) * (which == 0 ? 0.08838834764831845f : 1.f);
#pragma unroll
                for (int e = 0; e < 8; ++e) y[e] *= sc; }
            const v4u pk = pack8(y);
            if (which < 2) {
                const int rt = (t0 + t) & 63; unsigned char* tb = (unsigned char*)(dst + (size_t)((t0 + t) - rt) * 128);
                const int ks = c8 >> 2, bb = (c8 >> 1) & 1, fqb = 2 * (c8 & 1);
                *(v2u*)(tb + off256(rt, 4 * ks + fqb) + 8 * bb) = (v2u){pk.x, pk.y}; *(v2u*)(tb + off256(rt, 4 * ks + fqb + 1) + 8 * bb) = (v2u){pk.z, pk.w};
            } else *(v4u*)(dst + (size_t)(t0 + t) * 128 + c8 * 8) = pk;
        }
    }
}
__device__ __forceinline__ void dn_prep4(Frame& F, int item) {
    int lane_ = F.lane; asm volatile("" : "+v"(lane_));
    const int w = F.wave, lane = lane_, fr = lane & 15, fq = lane >> 4, uu = w >> 1, which = w & 1;
    const PrepUnit U = prep_unit(F, item * 4 + uu);
    LAS float* P = (LAS float*)(F.lds + uu * PP_BYTES);
    LAS float* Gf = (LAS float*)(F.lds + PP_GOFF + uu * 1024); LAS float* Gb = Gf + 64; LAS float* Bf = Gf + 128; LAS float* Bb = Gf + 192;
    {
        const float* bd = WSP(float, WS_BD) + (size_t)(U.rowbase + lane) * 32;
        const float bfv = sigmoidf_(bd[U.h]), bbv = sigmoidf_(bd[8 + U.h]);
        const float gfv = -__expf(F.in[I_ALOG][U.h]) * softplusf_(bd[16 + U.h] + F.in[I_DTB][U.h]);
        const float gbv = -__expf(F.in[I_ALOG][8 + U.h]) * softplusf_(bd[24 + U.h] + F.in[I_DTB][8 + U.h]);
        float pf = gfv, pb = gbv;
#pragma unroll
        for (int o = 1; o < 64; o <<= 1) { const float nf = __shfl_up(pf, o), nb = __shfl_up(pb, o); if (lane >= o) { pf += nf; pb += nb; } }
        const float totf = __shfl(pf, 63), totb = __shfl(pb, 63);
        const float sfx = totb - pb + gbv;
        if (which == 0) { Gf[lane] = pf; Gb[lane] = sfx; Bf[lane] = bfv; Bb[lane] = bbv;
            float* sc0 = DOP(float, DO_SC) + (size_t)(((0 * 2 + U.b) * 8 + U.h) * NCH + U.ch132) * SCBLK + lane;
            float* sc1 = DOP(float, DO_SC) + (size_t)(((1 * 2 + U.b) * 8 + U.h) * NCH + U.ch132) * SCBLK + lane;
            { const float eg = __expf(pf); sc0[0] = bfv * eg; sc0[64] = __expf(totf - pf); sc0[128] = eg; sc0[192] = bfv; }
            { const float eg = __expf(sfx); sc1[0] = bbv * eg; sc1[64] = __expf(totb - sfx); sc1[128] = eg; sc1[192] = bbv; } }
    }
    __syncthreads();
    {
        const bf16* asrc = which ? U.qbase : U.kbase;
        LAS unsigned char* AT = (LAS unsigned char*)(F.lds + PP_GOFF + 4096 + 8 * 1088 + uu * 8192);
        bf16x8 bfr[4][4], afa[4][4];
#pragma unroll
        for (int nt = 0; nt < 4; ++nt)
#pragma unroll
            for (int ks = 0; ks < 4; ++ks) { bfr[nt][ks] = *(const bf16x8*)((const unsigned char*)U.kbase + off256(16 * nt + fr, 4 * ks + fq)); afa[nt][ks] = *(const bf16x8*)((const unsigned char*)asrc + off256(16 * nt + fr, 4 * ks + fq)); }
#pragma unroll
        for (int mt = 0; mt < 4; ++mt) {
            const f32x4 gfi = *(const LAS f32x4*)(Gf + 16 * mt + 4 * fq), gbi = *(const LAS f32x4*)(Gb + 16 * mt + 4 * fq);
            const f32x4 bfi = *(const LAS f32x4*)(Bf + 16 * mt + 4 * fq), bbi = *(const LAS f32x4*)(Bb + 16 * mt + 4 * fq);
#pragma unroll
            for (int nt = 0; nt < 4; ++nt) {
                f32x4 Dm = {0.f, 0.f, 0.f, 0.f};
#pragma unroll
                for (int ks = 0; ks < 4; ++ks) Dm = MFMA16(afa[mt][ks], bfr[nt][ks], Dm);
                const int oj = 16 * nt + fr; const float gfj = Gf[oj], gbj = Gb[oj];
#pragma unroll
                for (int r = 0; r < 4; ++r) { const int oi = 16 * mt + 4 * fq + r;
                    const float dec = oi > oj ? __expf(gfi[r] - gfj) : (oi < oj ? __expf(gbi[r] - gbj) : 1.f);
                    if (which == 0) P[oi * PP_PITCH + oj] = (oi > oj ? bfi[r] : bbi[r]) * Dm[r] * dec;
                    else *(LAS bf16*)(AT + img128_byte(oi, oj)) = (bf16)f2bf(Dm[r] * dec); }
            }
        }
        if (which) {
            asm volatile("s_waitcnt lgkmcnt(0)" ::: "memory");
#pragma unroll
            for (int p8 = 0; p8 < 8; ++p8) *(v4u*)((unsigned char*)U.ta + 8192 + (p8 * 64 + lane) * 16) = *(const LAS v4u*)(AT + (p8 * 64 + lane) * 16);
        }
    }
    __syncthreads();
    { LAS float* S = (LAS float*)(F.lds + PP_GOFF + 4096 + w * 1088); if (which == 0) prep_solve<0>(P, S, lane); else prep_solve<1>(P, S, lane); }
    __syncthreads();
    prep_store(P, which, lane, U.ta);
    __syncthreads();
}
__device__ __forceinline__ void phase4(Frame& F) {
    constexpr int N_DN = (64 + 16 * NCHL) / 4;
    for (int it = F.vcu; it < N_DN; it += F.G)
#pragma unroll 1
        for (int j = F.wave; j < 12; j += NWAVES) { const int un = it * 4 + (j & 3), which = j >> 2;
            conv_tile(F, un < 64 ? which * 64 + un : 192 + which * (16 * NCHL) + (un - 64)); }
    asm volatile("s_waitcnt vmcnt(0)" ::: "memory");
    __syncthreads();
    for (int it = F.vcu; it < N_DN; it += F.G) dn_prep4(F, it);
    if (F.vcu >= 16 && F.vcu < 240) { __syncthreads(); s5a_group(F, (F.vcu - 16) & 31, (F.vcu - 16) >> 5, 7); }
}
__device__ __forceinline__ void s5c_group(Frame& F, int g, int q0, int nq) {
    const int lane = F.lane;
    constexpr int WST = S5_BUF_BYTES + 2048 + 4096;
    static_assert(8 * WST <= RING_BYTES && S5_HT_BYTES <= S5_BUF_BYTES, "S5 LDS");
    LAS float* buf = (LAS float*)(F.lds + F.wave * WST); LAS unsigned char* hT = F.lds + F.wave * WST; LAS unsigned* ubw = (LAS unsigned*)(F.lds + F.wave * WST + S5_BUF_BYTES); LAS float* yb = (LAS float*)(F.lds + F.wave * WST + S5_BUF_BYTES + 2048);
    s16x4k bbf0[8], bbf1[8]; s5_load_bbf(F, g, lane, bbf0); s5_load_bbf(F, 32 + g, lane, bbf1);
    bf16x8 cbf0[4], cbf1[4];
    { const bf16* c0 = TABP(bf16, TAB_CBT) + (size_t)g * 2048; const bf16* c1 = TABP(bf16, TAB_CBT) + (size_t)(32 + g) * 2048;
#pragma unroll
      for (int ks = 0; ks < 4; ++ks) { cbf0[ks] = *(const bf16x8*)(c0 + (lane & 15) * 128 + 32 * ks + 8 * (lane >> 4)); cbf1[ks] = *(const bf16x8*)(c1 + (lane & 15) * 128 + 32 * ks + 8 * (lane >> 4)); } }
    const f32x2 a0 = TABP(f32x2, TAB_ABAR)[g * 64 + lane], a1 = TABP(f32x2, TAB_ABAR)[(32 + g) * 64 + lane];
    float Dp[16];
#pragma unroll
    for (int c = 0; c < 16; ++c) Dp[c] = F.in[I_S5D][g * 16 + c];
    for (int un = q0 * 8 + F.wave; un < 2 * NCHL; un += nq * 8) {
        const int b = un / NCHL, lc = un % NCHL, r0 = b * SEQ + lc * CHK;
        { const bf16* src = WSP(bf16, WS_U) + (size_t)(r0 + lane) * 512 + g * 16; const v4u a = *(const v4u*)src, c2 = *(const v4u*)(src + 8);
          *(LAS v4u*)(ubw + lane * 8) = a; *(LAS v4u*)(ubw + lane * 8 + 4) = c2;
          float f[8];
          unpack8(a, f); *(LAS f32x4*)(yb + lane * 16) = (f32x4){f[0] * Dp[0], f[1] * Dp[1], f[2] * Dp[2], f[3] * Dp[3]}; *(LAS f32x4*)(yb + lane * 16 + 4) = (f32x4){f[4] * Dp[4], f[5] * Dp[5], f[6] * Dp[6], f[7] * Dp[7]};
          unpack8(c2, f); *(LAS f32x4*)(yb + lane * 16 + 8) = (f32x4){f[0] * Dp[8], f[1] * Dp[9], f[2] * Dp[10], f[3] * Dp[11]}; *(LAS f32x4*)(yb + lane * 16 + 12) = (f32x4){f[4] * Dp[12], f[5] * Dp[13], f[6] * Dp[14], f[7] * Dp[15]}; }
        const f32x2 h00 = DOP(f32x2, DO_EH)[(size_t)(((0 * 2 + b) * NCH + 4 + lc) * 32 + g) * 64 + lane], h01 = DOP(f32x2, DO_EH)[(size_t)(((1 * 2 + b) * NCH + 4 + lc) * 32 + g) * 64 + lane];
        asm volatile("" ::: "memory");
        { float hr = h00.x, hi = h00.y; for (int ib = 0; ib < 4; ++ib) s5_block<true>(buf, hT, ubw, bbf0, cbf0, a0, hr, hi, 0, ib, lane, yb); }
        { float hr = h01.x, hi = h01.y; for (int ib = 0; ib < 4; ++ib) s5_block<true>(buf, hT, ubw, bbf1, cbf1, a1, hr, hi, 1, ib, lane, yb); }
#pragma unroll
        for (int rep = 0; rep < 4; ++rep) { const int t = rep * 16 + (lane >> 2), cq = lane & 3; const f32x4 yv = *(const LAS f32x4*)(yb + t * 16 + cq * 4);
            const unsigned lo = pk2(gelu_tanh(yv[0]), gelu_tanh(yv[1])), hi2 = pk2(gelu_tanh(yv[2]), gelu_tanh(yv[3]));
            *(unsigned long long*)(DOP(bf16, DO_Y) + (size_t)(r0 + t) * 512 + g * 16 + cq * 4) = (unsigned long long)lo | ((unsigned long long)hi2 << 32); }
        LDS_WAIT(); asm volatile("" ::: "memory");
    }
}
__device__ __forceinline__ void phase7(Frame& F) {
    const int lane = F.lane;
    const int gw = F.vcu * NWAVES + F.wave, NGW = F.G * NWAVES;
    const float* nw = F.in[I_DNNW] + (lane & 7) * 16;
    for (int r = gw; r < T; r += NGW) {
        const bf16* of = WSP(bf16, WS_ODIR) + (size_t)r * 1024 + lane * 16; const bf16* ob = of + (size_t)T * 1024; const bf16* zp = WSP(bf16, WS_ZDN) + (size_t)r * 1024 + lane * 16;
        float o[16], f[8], z[16];
        unpack8(*(const v4u*)of, o); unpack8(*(const v4u*)(of + 8), o + 8);
        unpack8(*(const v4u*)ob, f);
#pragma unroll
        for (int e = 0; e < 8; ++e) o[e] += f[e];
        unpack8(*(const v4u*)(ob + 8), f);
#pragma unroll
        for (int e = 0; e < 8; ++e) o[8 + e] += f[e];
        unpack8(*(const v4u*)zp, z); unpack8(*(const v4u*)(zp + 8), z + 8);
        float ss = 0.f;
#pragma unroll
        for (int e = 0; e < 16; ++e) ss += o[e] * o[e];
        ss = sum8(ss);
        const float rinv = __builtin_amdgcn_rsqf(ss * (1.f / 128.f) + EPS);
#pragma unroll
        for (int e = 0; e < 16; ++e) o[e] = o[e] * rinv * nw[e] * z[e];
        bf16* yo = WSP(bf16, WS_YDN) + (size_t)r * 1024 + lane * 16;
        *(v4u*)yo = pack8(o); *(v4u*)(yo + 8) = pack8(o + 8);
    }
}
struct EpiGates {
    static constexpr bool PERM = true, AFTER_DRAIN = false;
    const bf16* ODIR; const float* nw; bf16 *YDN, *GDN, *GS5; LAS float* red;
    __device__ __forceinline__ void operator()(const f32x4 (&acc)[2][2][4][2], const pg8::Unit& u, int wr, int wc, int fr_, int fq_) const {
        const int pn = u.pn; int fr = fr_, fq = fq_; asm volatile("" : "+v"(fr), "+v"(fq));
        if (pn < 18) {
            const int c0 = (pn - 14) * 256 + wc * 32 + 8 * fq;
            const bf16* pbase = ODIR + (size_t)(u.pm * 256 + wr * 64 + fr) * 1024 + c0;
#define EG_ISSUE(bt, ra, rb) do { _Pragma("unroll") for (int mi = 0; mi < 2; ++mi) _Pragma("unroll") for (int bj = 0; bj < 2; ++bj) { \
                const bf16* p = pbase + (size_t)(((bt) >> 1) * 128 + (((bt) & 1) * 2 + mi) * 16) * 1024 + bj * 128; ra[mi][bj] = *(const v4u*)p; rb[mi][bj] = *(const v4u*)(p + (size_t)T * 1024); } } while (0)
            {
                v4u ra0[2][2], rb0[2][2], ra1[2][2], rb1[2][2];
                EG_ISSUE(0, ra0, rb0);
#pragma unroll
                for (int bt = 0; bt < 4; ++bt) {
                    if (bt + 1 < 4) { if (bt & 1) EG_ISSUE(bt + 1, ra0, rb0); else EG_ISSUE(bt + 1, ra1, rb1); }
                    asm volatile("" ::: "memory");
#pragma unroll
                    for (int mi = 0; mi < 2; ++mi)
#pragma unroll
                        for (int bj = 0; bj < 2; ++bj) { float a[8], b[8]; unpack8((bt & 1) ? ra1[mi][bj] : ra0[mi][bj], a); unpack8((bt & 1) ? rb1[mi][bj] : rb0[mi][bj], b); float ss = 0.f;
#pragma unroll
                            for (int e = 0; e < 8; ++e) { const float o = a[e] + b[e]; ss += o * o; }
                            ss += __shfl_xor(ss, 16); ss += __shfl_xor(ss, 32);
                            if (fq == 0) red[(wc * 2 + bj) * 256 + (bt >> 1) * 128 + wr * 64 + ((bt & 1) * 2 + mi) * 16 + fr] = ss; }
                    asm volatile("" ::: "memory");
                }
            }
            asm volatile("s_waitcnt lgkmcnt(0)" ::: "memory");
            __builtin_amdgcn_s_barrier();
            {
                v4u ra0[2][2], rb0[2][2], ra1[2][2], rb1[2][2];
                EG_ISSUE(0, ra0, rb0);
#pragma unroll
                for (int bt = 0; bt < 4; ++bt) {
                    if (bt + 1 < 4) { if (bt & 1) EG_ISSUE(bt + 1, ra0, rb0); else EG_ISSUE(bt + 1, ra1, rb1); }
                    asm volatile("" ::: "memory");
#pragma unroll
                    for (int mi = 0; mi < 2; ++mi)
#pragma unroll
                        for (int bj = 0; bj < 2; ++bj) { const int ai = bt >> 1, m = (bt & 1) * 2 + mi, rl = ai * 128 + wr * 64 + m * 16 + fr;
                            const float rinv = __builtin_amdgcn_rsqf(((red[bj * 256 + rl] + red[(2 + bj) * 256 + rl]) + (red[(4 + bj) * 256 + rl] + red[(6 + bj) * 256 + rl])) * (1.f / 128.f) + EPS);
                            float a[8], b[8]; unpack8((bt & 1) ? ra1[mi][bj] : ra0[mi][bj], a); unpack8((bt & 1) ? rb1[mi][bj] : rb0[mi][bj], b);
                            f32x4 v0 = acc[ai][bj][m][0], v1 = acc[ai][bj][m][1]; asm volatile("" : "+v"(v0), "+v"(v1));
                            const float z[8] = {v0[0], v0[1], v0[2], v0[3], v1[0], v1[1], v1[2], v1[3]};
#pragma unroll
                            for (int e = 0; e < 8; ++e) a[e] = (a[e] + b[e]) * rinv * nw[wc * 32 + 8 * fq + e] * siluf_(z[e]);
                            *(v4u*)(YDN + (size_t)(u.pm * 256 + rl) * 1024 + c0 + bj * 128) = pack8(a); }
                    asm volatile("" ::: "memory");
                }
            }
#undef EG_ISSUE
        } else {
#pragma unroll
            for (int ai = 0; ai < 2; ++ai)
#pragma unroll
                for (int m = 0; m < 4; ++m) { const int row = u.pm * 256 + ai * 128 + wr * 64 + m * 16 + fr;
#pragma unroll
                    for (int bj = 0; bj < 2; ++bj) { const f32x4 v0 = acc[ai][bj][m][0], v1 = acc[ai][bj][m][1]; float f[8] = {v0[0], v0[1], v0[2], v0[3], v1[0], v1[1], v1[2], v1[3]};
                        const int colin = bj * 128 + wc * 32 + 8 * fq;
#pragma unroll
                        for (int e = 0; e < 8; ++e) f[e] = sigmoidf_(f[e]);
                        if (pn < 24) *(v4u*)(GDN + (size_t)row * 1024 + (pn - 20) * 256 + colin) = pack8(f);
                        else *(v4u*)(GS5 + (size_t)row * 1024 + (pn - 24) * 256 + colin) = pack8(f); } }
        }
    }
};
struct EpiGlu {
    static constexpr bool PERM = true, AFTER_DRAIN = false;
    const bf16* Y; const bf16* ZS5; const float* gb; bf16* O;
    __device__ __forceinline__ void operator()(const f32x4 (&acc)[2][2][4][2], const pg8::Unit& u, int wr, int wc, int fr, int fq) const {
#pragma unroll
        for (int ai = 0; ai < 2; ++ai)
#pragma unroll
            for (int m = 0; m < 4; ++m) { const int row = u.pm * 256 + ai * 128 + wr * 64 + m * 16 + fr;
#pragma unroll
                for (int bj = 0; bj < 2; ++bj) { const int col = u.pn * 256 + bj * 128 + wc * 32 + 8 * fq; const size_t o = (size_t)row * 512 + col;
                    const f32x4 v0 = acc[ai][bj][m][0], v1 = acc[ai][bj][m][1]; float a[8] = {v0[0], v0[1], v0[2], v0[3], v1[0], v1[1], v1[2], v1[3]}, y[8], z[8];
                    unpack8(*(const v4u*)(Y + o), y); unpack8(*(const v4u*)(ZS5 + o), z);
#pragma unroll
                    for (int e = 0; e < 8; ++e) a[e] = y[e] * sigmoidf_(a[e] + gb[col + e]) * z[e];
                    *(v4u*)(O + o) = pack8(a); } }
    }
};
struct EpiGate {
    static constexpr bool PERM = true, AFTER_DRAIN = false;
    const bf16* Gt; const bf16* P; bf16* O; int add;
    __device__ __forceinline__ void operator()(const f32x4 (&acc)[2][2][4][2], const pg8::Unit& u, int wr, int wc, int fr, int fq) const {
#pragma unroll
        for (int ai = 0; ai < 2; ++ai)
#pragma unroll
            for (int m = 0; m < 4; ++m) { const int row = u.pm * 256 + ai * 128 + wr * 64 + m * 16 + fr;
#pragma unroll
                for (int bj = 0; bj < 2; ++bj) { const int col = u.pn * 256 + bj * 128 + wc * 32 + 8 * fq; const size_t o = (size_t)row * 1024 + col;
                    const f32x4 v0 = acc[ai][bj][m][0], v1 = acc[ai][bj][m][1]; float a[8] = {v0[0], v0[1], v0[2], v0[3], v1[0], v1[1], v1[2], v1[3]}, g[8], p[8];
                    unpack8(*(const v4u*)(Gt + o), g);
                    if (add) { unpack8(*(const v4u*)(P + o), p);
#pragma unroll
                        for (int e = 0; e < 8; ++e) a[e] = p[e] + g[e] * a[e]; }
                    else {
#pragma unroll
                        for (int e = 0; e < 8; ++e) a[e] = g[e] * a[e]; }
                    *(v4u*)(O + o) = pack8(a); } }
    }
};
struct EpiMerge {
    static constexpr bool PERM = true, AFTER_DRAIN = false;
    const bf16* GDN; const bf16* GS5; bf16* O;
    __device__ __forceinline__ void mid(f32x4 (&acc)[2][2][4][2], const pg8::Unit& u, int wr, int wc, int fr, int fq) const {
#pragma unroll
        for (int ai = 0; ai < 2; ++ai)
#pragma unroll
            for (int m = 0; m < 4; ++m) { const int row = u.pm * 256 + ai * 128 + wr * 64 + m * 16 + fr;
#pragma unroll
                for (int bj = 0; bj < 2; ++bj) { const int col = u.pn * 256 + bj * 128 + wc * 32 + 8 * fq; const size_t o = (size_t)row * 1024 + col;
                    const v4u r1 = *(const v4u*)(GDN + o), r2 = *(const v4u*)(GS5 + o);
                    const unsigned w1[4] = {r1.x, r1.y, r1.z, r1.w}, w2[4] = {r2.x, r2.y, r2.z, r2.w};
#pragma unroll
                    for (int w = 0; w < 4; ++w) {
                        const float ra = bf2f(w1[w] & 0xffffu) * __builtin_amdgcn_rcpf(fmaxf(bf2f(w2[w] & 0xffffu), 1e-30f)), rb = bf2f(w1[w] >> 16) * __builtin_amdgcn_rcpf(fmaxf(bf2f(w2[w] >> 16), 1e-30f));
                        acc[ai][bj][m][w >> 1][2 * (w & 1)] *= ra; acc[ai][bj][m][w >> 1][2 * (w & 1) + 1] *= rb; }
                    asm volatile("" ::: "memory"); } }
    }
    __device__ __forceinline__ void operator()(const f32x4 (&acc)[2][2][4][2], const pg8::Unit& u, int wr, int wc, int fr, int fq) const {
#pragma unroll
        for (int ai = 0; ai < 2; ++ai)
#pragma unroll
            for (int m = 0; m < 4; ++m) { const int row = u.pm * 256 + ai * 128 + wr * 64 + m * 16 + fr;
#pragma unroll
                for (int bj = 0; bj < 2; ++bj) { const int col = u.pn * 256 + bj * 128 + wc * 32 + 8 * fq; const size_t o = (size_t)row * 1024 + col;
                    const f32x4 v0 = acc[ai][bj][m][0], v1 = acc[ai][bj][m][1]; float a[8] = {v0[0], v0[1], v0[2], v0[3], v1[0], v1[1], v1[2], v1[3]}, g2[8];
                    unpack8(*(const v4u*)(GS5 + o), g2);
#pragma unroll
                    for (int e = 0; e < 8; ++e) a[e] *= g2[e];
                    *(v4u*)(O + o) = pack8(a); } }
    }
};
struct EpiOut {
    static constexpr bool PERM = false, AFTER_DRAIN = false;
    const float* X; const float* gate; float* O;
    __device__ __forceinline__ void operator()(const f32x4 (&acc)[2][2][4][2], const pg8::Unit& u, int wr, int wc, int fr, int fq) const {
#pragma unroll
        for (int ai = 0; ai < 2; ++ai)
#pragma unroll
            for (int m = 0; m < 4; ++m) { const int row = u.pm * 256 + ai * 128 + wr * 64 + m * 16 + fr; const float* gt = gate + (row >> 13) * 1024;
#pragma unroll
                for (int bj = 0; bj < 2; ++bj)
#pragma unroll
                    for (int n = 0; n < 2; ++n) { const int col = u.pn * 256 + bj * 128 + wc * 32 + 16 * n + 4 * fq; const size_t o = (size_t)row * 1024 + col;
                        *(f32x4*)(O + o) = *(const f32x4*)(X + o) + *(const f32x4*)(gt + col) * acc[ai][bj][m][n]; } }
    }
};
struct EpiOutNorm {
    static constexpr bool PERM = false, AFTER_DRAIN = true;
    const float* X; const float* gate; const float* fnw; float* O; unsigned long long* gran;
    __device__ __forceinline__ void operator()(const f32x4 (&acc)[2][2][4][2], const pg8::Unit& u, int wr, int wc, int fr, int fq) const {}
    __device__ __forceinline__ void fused(f32x4 (&acc)[2][2][4][2], const pg8::Unit& u, int wr, int wc, int fr, int fq, LAS unsigned char* lds, int wid, int lane) const {
        LAS float* red = (LAS float*)lds;
#pragma unroll
        for (int ai = 0; ai < 2; ++ai)
#pragma unroll
            for (int m = 0; m < 4; ++m) { const int rl = ai * 128 + wr * 64 + m * 16 + fr, row = u.pm * 256 + rl; const float* gt = gate + (row >> 13) * 1024; float s = 0.f;
#pragma unroll
                for (int bj = 0; bj < 2; ++bj)
#pragma unroll
                    for (int n = 0; n < 2; ++n) { const int col = u.pn * 256 + bj * 128 + wc * 32 + 16 * n + 4 * fq; const size_t o = (size_t)row * 1024 + col;
                        const f32x4 y = *(const f32x4*)(X + o) + *(const f32x4*)(gt + col) * acc[ai][bj][m][n]; acc[ai][bj][m][n] = y;
                        s += (y.x * y.x + y.y * y.y) + (y.z * y.z + y.w * y.w); }
                s += __shfl_xor(s, 16); s += __shfl_xor(s, 32);
                if (fq == 0) red[wc * 256 + rl] = s; }
        __syncthreads();
        const int t = wid * 64 + lane;
        if (t < 256) {
            const float mine = (red[t] + red[256 + t]) + (red[512 + t] + red[768 + t]);
            unsigned long long* g = gran + u.pm * 256 + t;
            __hip_atomic_store(g + (size_t)u.pn * T, (unsigned long long)__builtin_bit_cast(unsigned, mine) | (1ull << 32), __ATOMIC_RELAXED, __HIP_MEMORY_SCOPE_AGENT);
            float s4 = 0.f;
#pragma unroll
            for (int j = 0; j < 4; ++j) { unsigned long long v;
                if (j == u.pn) { s4 += mine; continue; }
                while (((v = __hip_atomic_load(g + (size_t)j * T, __ATOMIC_RELAXED, __HIP_MEMORY_SCOPE_AGENT)) >> 32) == 0ull) __builtin_amdgcn_s_sleep(1);
                s4 += __builtin_bit_cast(float, (unsigned)v); }
            red[1024 + t] = __builtin_amdgcn_rsqf(s4 * (1.f / D) + EPS); }
        __syncthreads();
#pragma unroll
        for (int ai = 0; ai < 2; ++ai)
#pragma unroll
            for (int m = 0; m < 4; ++m) { const int rl = ai * 128 + wr * 64 + m * 16 + fr, row = u.pm * 256 + rl; const float rinv = red[1024 + rl];
#pragma unroll
                for (int bj = 0; bj < 2; ++bj)
#pragma unroll
                    for (int n = 0; n < 2; ++n) { const int col = u.pn * 256 + bj * 128 + wc * 32 + 16 * n + 4 * fq; const size_t o = (size_t)row * 1024 + col;
                        *(f32x4*)(O + o) = acc[ai][bj][m][n] * rinv * *(const f32x4*)(fnw + col); } }
    }
};
__device__ __forceinline__ void phase11(Frame& F) {
    const int gw = F.vcu * NWAVES + F.wave, NGW = F.G * NWAVES; const f32x4* wv = (const f32x4*)F.in[I_FNW] + F.lane;
    for (int r = gw; r < T; r += NGW) {
        f32x4* xr = (f32x4*)(F.out + (size_t)r * D) + F.lane; f32x4 xv[4]; float s = 0.f;
#pragma unroll
        for (int j = 0; j < 4; ++j) { xv[j] = xr[64 * j]; s += (xv[j].x * xv[j].x + xv[j].y * xv[j].y) + (xv[j].z * xv[j].z + xv[j].w * xv[j].w); }
        const float rinv = __builtin_amdgcn_rsqf(wave_sum(s) * (1.f / D) + EPS);
#pragma unroll
        for (int j = 0; j < 4; ++j) xr[64 * j] = xv[j] * rinv * wv[64 * j];
    }
}
__device__ __forceinline__ void panel_sync(unsigned* cnt) {
    asm volatile("s_waitcnt vmcnt(0)" ::: "memory");
    __syncthreads();
    if (threadIdx.x == 0) {
        __builtin_amdgcn_fence(__ATOMIC_RELEASE, "agent");
        asm volatile("s_waitcnt vmcnt(0)" ::: "memory");
        __hip_atomic_fetch_add(cnt, 1u, __ATOMIC_RELAXED, __HIP_MEMORY_SCOPE_AGENT);
        while (__hip_atomic_load(cnt, __ATOMIC_RELAXED, __HIP_MEMORY_SCOPE_AGENT) < 4u) __builtin_amdgcn_s_sleep(1);
        __builtin_amdgcn_fence(__ATOMIC_ACQUIRE, "agent");
        asm volatile("s_waitcnt vmcnt(0)" ::: "memory");
    }
    __syncthreads();
}
struct Args { const float* in[26]; float* out; unsigned char* ws; int ph_lo, ph_hi, sub, pad; };
__global__ void __launch_bounds__(NWAVES * 64, 2) mk_fwd(Args args) {
    extern __shared__ __attribute__((aligned(16))) unsigned char lds[];
    Frame F;
    F.lds = (LAS unsigned char*)lds;
    F.tid = threadIdx.x; F.lane = F.tid & 63; F.wave = __builtin_amdgcn_readfirstlane(F.tid >> 6);
    F.G = gridDim.x; { const int bx = blockIdx.x; F.vcu = (F.G % 8 == 0) ? (bx % 8) * (F.G / 8) + bx / 8 : bx; }
#pragma unroll
    for (int i = 0; i < 26; ++i) F.in[i] = args.in[i];
    F.out = args.out; F.ws = args.ws;
    volatile LAS unsigned* MISC = (volatile LAS unsigned*)(F.lds + MISC_OFF);
    for (int u = F.tid; u < (LDS_BYTES - LDSCTL_OFF) / 4; u += NTHR) ((LAS unsigned*)(F.lds + LDSCTL_OFF))[u] = 0u;
    __syncthreads();
    XcdBarrier bar; bar.bar = (unsigned*)(F.ws + WS_CTL) + CW_BAR; bar.x = 0; bar.st = nullptr; bar.ngrp = 0u;
    if (!MK_PER_PHASE) bar = xcd_barrier_post((unsigned*)(F.ws + WS_CTL) + CW_BAR, MISC + 8);
    const int lo = args.ph_lo, hi = args.ph_hi;
#define IN(k) (lo <= (k) && (k) < hi)
#if MK_STAMP >= 0
    unsigned long long tstamp[NPHASE + 1]; tstamp[0] = __builtin_amdgcn_s_memrealtime();
#define SEAM(k) do { if (IN(k) && IN((k) + 1)) xcd_barrier(bar); tstamp[(k) + 1] = __builtin_amdgcn_s_memrealtime(); } while (0)
#define SEAMP(k, cw) do { if (IN(k) && IN((k) + 1)) panel_sync((unsigned*)(F.ws + WS_CTL) + (cw) + 64 * mypm); tstamp[(k) + 1] = __builtin_amdgcn_s_memrealtime(); } while (0)
#else
#define SEAM(k) do { if (IN(k) && IN((k) + 1)) xcd_barrier(bar); } while (0)
#define SEAMP(k, cw) do { if (IN(k) && IN((k) + 1)) panel_sync((unsigned*)(F.ws + WS_CTL) + (cw) + 64 * mypm); } while (0)
#endif
    if (IN(0)) { phase0(F); } SEAM(0);
    if (IN(1)) { phase1(F); } SEAM(1);
    if (IN(2)) {
        pg8::Gemm g{DOP(bf16, DO_H), WSP(bf16, WS_WIN), MROWS, NPAD, D}; OrderIn S; S.init(true, F.G, (int)blockIdx.x);
        EpiIn E{WSP(bf16, WS_QKV), WSP(bf16, WS_QKVC_RAW), WSP(bf16, WS_U), WSP(bf16, WS_ZDN), WSP(bf16, WS_ZS5), WSP(bf16, WS_GDN), WSP(bf16, WS_GS5), WSP(float, WS_BD)};
        pg8::gemm_phase<EpiIn, OrderIn, true, true>(F.lds, g, S, E);
    } SEAM(2);
    if (IN(3)) { phase4(F); } SEAM(3);
    if (IN(4) && F.G == 256) {
        if ((F.vcu & 4) == 0) { if (args.sub & 1) phase5b(F, args.sub); }
        else if (args.sub & 30) {
            const int sidx = (F.vcu >> 3) * 4 + (F.vcu & 3);
            XcdBarrier bar2 = xcd_barrier_post((unsigned*)(F.ws + WS_CTL) + CW_BAR2, MISC + 12); bar2.ngrp = 128u;
            if (args.sub & 4) s5_state_scan(F, sidx);
            xcd_barrier(bar2);
            if (args.sub & 8) s5c_group(F, sidx & 31, sidx >> 5, 4);
            __syncthreads();
            if (args.sub & 8) {
                pg8::Gemm g{DOP(bf16, DO_H), WSP(bf16, WS_WIN), T, NPAD, D}; OrderOne S; S.u0.pm = sidx >> 1; S.u0.pn = 18 + (sidx & 1);
                EpiIn E{WSP(bf16, WS_QKV), WSP(bf16, WS_QKVC_RAW), WSP(bf16, WS_U), WSP(bf16, WS_ZDN), WSP(bf16, WS_ZS5), WSP(bf16, WS_GDN), WSP(bf16, WS_GS5), WSP(float, WS_BD)};
                pg8::gemm_phase<EpiIn, OrderOne, false, true>(F.lds, g, S, E); }
            xcd_barrier(bar2);
            if (args.sub & 16) {
                pg8::Gemm g{DOP(bf16, DO_Y), WSP(bf16, WS_GLU), T, 512, 512}; pg8::StaticOrder S; S.init(T, 512, 128, sidx);
                EpiGlu E{DOP(bf16, DO_Y), WSP(bf16, WS_ZS5), F.in[I_GLUB], WSP(bf16, WS_YS5)};
                pg8::gemm_phase<EpiGlu, pg8::StaticOrder, false, true>(F.lds, g, S, E); }
        }
    } SEAM(4);
    if (IN(5)) {
        pg8::Gemm g{DOP(bf16, DO_H), WSP(bf16, WS_WIN), T, NPAD, D}; OrderIn S; S.init(false, F.G, (int)blockIdx.x);
        EpiGates E{WSP(bf16, WS_ODIR), F.in[I_DNNW], WSP(bf16, WS_YDN), WSP(bf16, WS_GDN), WSP(bf16, WS_GS5), (LAS float*)(F.lds + 8 * pg8::HTB)};
        pg8::gemm_phase<EpiGates, OrderIn, true, true>(F.lds, g, S, E);
    }
    const int mypm = 8 * ((int)blockIdx.x & 7) + (((int)blockIdx.x >> 3) & 7);
    SEAM(5);
    if (IN(6)) {
        pg8::Gemm g1{WSP(bf16, WS_YDN), WSP(bf16, WS_WPD), T, 1024, 1024}, g2{WSP(bf16, WS_YS5), WSP(bf16, WS_WPS), T, 1024, 512}; pg8::StaticOrder S; S.init(T, 1024, F.G, (int)blockIdx.x);
        EpiMerge E{WSP(bf16, WS_GDN), WSP(bf16, WS_GS5), WSP(bf16, WS_MERGED)};
        pg8::gemm_dual<EpiMerge, pg8::StaticOrder, 1024, 512>(F.lds, g1, g2, S, E);
    } SEAM(6);
    { int t_ = threadIdx.x; asm volatile("" : "+v"(t_)); F.tid = t_; F.lane = t_ & 63; }
    if (IN(7)) {
        pg8::Gemm g{WSP(bf16, WS_MERGED), WSP(bf16, WS_WOUT), T, 1024, 1024}; pg8::StaticOrder S; S.init(T, 1024, F.G, (int)blockIdx.x);
        EpiOutNorm E{F.in[I_X], TABP(float, TAB_GATE), F.in[I_FNW], F.out, (unsigned long long*)(F.ws + WS_CTL + CTL_GRAN)};
        pg8::gemm_phase<EpiOutNorm, pg8::StaticOrder, false, true>(F.lds, g, S, E);
    }
#if MK_STAMP >= 0
    tstamp[NPHASE] = __builtin_amdgcn_s_memrealtime();
#if MK_STAMP == 200
    {
        asm volatile("s_waitcnt vmcnt(0)" ::: "memory"); __syncthreads();
        if (threadIdx.x == 0) { unsigned* cw = (unsigned*)(F.ws + WS_CTL) + 28672;
            __hip_atomic_fetch_max(cw, ~(unsigned)tstamp[0], __ATOMIC_RELAXED, __HIP_MEMORY_SCOPE_AGENT); __hip_atomic_fetch_max(cw + 64, (unsigned)tstamp[NPHASE], __ATOMIC_RELAXED, __HIP_MEMORY_SCOPE_AGENT);
            __builtin_amdgcn_fence(__ATOMIC_RELEASE, "agent"); asm volatile("s_waitcnt vmcnt(0)" ::: "memory");
            const unsigned old = __hip_atomic_fetch_add(cw + 128, 1u, __ATOMIC_RELAXED, __HIP_MEMORY_SCOPE_AGENT);
            if (old == gridDim.x - 1) { __builtin_amdgcn_fence(__ATOMIC_ACQUIRE, "agent"); asm volatile("s_waitcnt vmcnt(0)" ::: "memory");
                const unsigned s0 = ~__hip_atomic_load(cw, __ATOMIC_RELAXED, __HIP_MEMORY_SCOPE_AGENT), e1 = __hip_atomic_load(cw + 64, __ATOMIC_RELAXED, __HIP_MEMORY_SCOPE_AGENT);
                float* o = F.out; const float v = __hip_atomic_load(o, __ATOMIC_RELAXED, __HIP_MEMORY_SCOPE_AGENT); __hip_atomic_store(o, v + 0.00001f * (float)(e1 - s0), __ATOMIC_RELAXED, __HIP_MEMORY_SCOPE_AGENT); } }
    }
#else
    if (blockIdx.x == 0 && F.tid == 0) { asm volatile("s_waitcnt vmcnt(0)" ::: "memory"); F.out[0] += (MK_STAMP >= 100 ? 0.00001f : 0.01f) * (float)(MK_STAMP >= 100 ? tstamp[MK_STAMP - 100 + 1] - tstamp[0] : tstamp[MK_STAMP + 1] - tstamp[MK_STAMP]); }
#endif
#endif
#undef IN
#undef SEAM
#undef SEAMP
}
extern "C" void kernel_launch(void* const* d_in, const int* in_sizes, int n_in, void* d_out, int out_size, void* d_ws, size_t ws_size, hipStream_t stream) {
    static int grid = 0;
    if (grid == 0) {
        if (n_in != 26 || in_sizes[0] != T * D || out_size != T * D || ws_size < WS_END) { fprintf(stderr, "kernel_launch: unexpected shapes (n_in %d, in0 %d, out %d, ws %zu)\n", n_in, n_in > 0 ? in_sizes[0] : -1, out_size, ws_size); grid = -1; return; }
        int dev = 0, cus = 0;
        if (hipGetDevice(&dev) != hipSuccess || hipDeviceGetAttribute(&cus, hipDeviceAttributeMultiprocessorCount, dev) != hipSuccess) { grid = -1; return; }
        if (hipFuncSetAttribute((const void*)mk_fwd, hipFuncAttributeMaxDynamicSharedMemorySize, LDS_BYTES) != hipSuccess) { fprintf(stderr, "kernel_launch: hipFuncSetAttribute failed\n"); grid = -1; return; }
        (void)hipGetLastError();
        grid = cus;
        if (grid != 256) fprintf(stderr, "kernel_launch: %d CUs; this build assumes 256\n", grid);
    }
    if (grid < 0) return;
    if (hipMemsetAsync((char*)d_ws + WS_CTL, 0, CTL_ZERO_BYTES, stream) != hipSuccess) return;
    Args a{};
    for (int i = 0; i < 26; ++i) a.in[i] = (const float*)d_in[i];
    a.out = (float*)d_out; a.ws = (unsigned char*)d_ws; a.sub = 31;
#if MK_PER_PHASE
    for (int p = 0; p < NPHASE; ++p) { a.ph_lo = p; a.ph_hi = p + 1;
        if (p == 4 && MK_REP == 100) { a.sub = 1; hipLaunchKernelGGL(mk_fwd, dim3(grid), dim3(NWAVES * 64), LDS_BYTES, stream, a); a.sub = 30; }
        for (int rp = 0; rp < ((MK_REP == p && p != 4 && p != 9) ? 2 : 1); ++rp) hipLaunchKernelGGL(mk_fwd, dim3(grid), dim3(NWAVES * 64), LDS_BYTES, stream, a);
        if (p == 4 && MK_REP > 100) { a.sub = MK_REP - 100; (void)hipMemsetAsync((char*)d_ws + WS_CTL + (size_t)CW_BAR2 * 4, 0, 16384, stream); hipLaunchKernelGGL(mk_fwd, dim3(grid), dim3(NWAVES * 64), LDS_BYTES, stream, a); }

        a.sub = 31; }
#else
    a.ph_lo = 0; a.ph_hi = NPHASE; hipLaunchKernelGGL(mk_fwd, dim3(grid), dim3(NWAVES * 64), LDS_BYTES, stream, a);
#endif
}
```

```cpp
#include <hip/hip_runtime.h>
#include <cstdio>
#include <cstdint>
#define MK_PER_PHASE 0
#define MK_REP -1
#define MK_STAMP -1
namespace pg8 {
#define PG8_LAS __attribute__((address_space(3)))
typedef unsigned short bf16_t;
typedef short bf16x8 __attribute__((ext_vector_type(8)));
typedef float f32x4 __attribute__((ext_vector_type(4)));
typedef unsigned u32x4 __attribute__((ext_vector_type(4)));
constexpr int BM = 256, BK = 64, HALF = 128, HTB = HALF * BK * 2  , STAGE_BYTES = 8 * HTB, NXCD = 8, WGM = 8;

__host__ __device__ __forceinline__ int lds_byte(int r, int c) { const int st = (r >> 4) * 2 + (c >> 5), rr = r & 15, cc = c & 31, ob = rr * 64 + cc * 2; return st * 1024 + (ob ^ (((ob >> 9) & 1) << 5)); }
__host__ __device__ __forceinline__ void stage_rc(int b, int& R, int& C) { const int st = b / 1024, sb = b % 1024, swz = sb ^ (((sb >> 9) & 1) << 5); R = (st >> 1) * 16 + swz / 64; C = (st & 1) * 32 + (swz % 64) / 2; }
__host__ __device__ __forceinline__ int perm32(int rho) { const int n = rho >> 4, i = rho & 15; return 8 * (i >> 2) + 4 * n + (i & 3); }

struct Unit { int pm, pn; };
struct Gemm { const bf16_t* A; const bf16_t* Bt; int M, N, K; };

struct StaticOrder {
    int nM, nN, nwg, G, c;
    __host__ __device__ void init(int M, int N, int G_, int c_) { nM = M / BM; nN = N / BM; nwg = nM * nN; G = G_; c = c_; }
    __host__ __device__ bool next(int i, Unit& u) const {
        const long L = (long)i * G + c; if (L >= nwg) return false;
        int wgid = (int)L; { const int q = nwg / NXCD, r = nwg % NXCD, xcd = wgid % NXCD, off = wgid / NXCD; wgid = (xcd < r ? xcd * (q + 1) : r * (q + 1) + (xcd - r) * q) + off; }
        const int nig = WGM * nN, gid = wgid / nig, fm = gid * WGM, gsz = (nM - fm) < WGM ? (nM - fm) : WGM;
        u.pm = fm + ((wgid % nig) % gsz); u.pn = (wgid % nig) / gsz; return true;
    }
    __device__ __forceinline__ void a_ready(const Unit&) const {}
    __device__ __forceinline__ void done(const Unit&) const {}
};

__device__ __forceinline__ unsigned cvt_pk_bf16(float lo, float hi) { unsigned r; asm volatile("v_cvt_pk_bf16_f32 %0, %1, %2" : "=v"(r) : "v"(lo), "v"(hi)); return r; }
template <class Epi, class Sched, bool ALIGN_EPI = false, bool SP2 = false>
__device__ __forceinline__ void gemm_phase(PG8_LAS unsigned char* lds, const Gemm g, const Sched& S, const Epi& E) {
    int tid_ = threadIdx.x; asm volatile("" : "+v"(tid_));
    const int tid = tid_, wid = __builtin_amdgcn_readfirstlane(tid >> 6), lane = tid & 63, wr = wid >> 2, wc = wid & 3, fr = lane & 15, fq = lane >> 4;
    const int K = g.K, nt = K / BK;
    unsigned voffA[2], voffB[2];
#pragma unroll
    for (int i = 0; i < 2; ++i) { int R, C; stage_rc(tid * 16 + i * 8192, R, C); const int Rb = Epi::PERM ? ((R & ~31) + perm32(R & 31)) : R;
        voffA[i] = (unsigned)(R * K + C) * 2u; voffB[i] = (unsigned)(Rb * K + C) * 2u; }
    const size_t kstep = (size_t)(BK * 2);
    const size_t hstep = (size_t)HALF * K * 2;
    const size_t tstep = 2 * hstep;
    const unsigned ldsw = (unsigned)wid * 1024u;
    const int aoff = lds_byte(wr * 64 + fr, fq * 8), boff = lds_byte(wc * 32 + fr, fq * 8);
#define PG8_SA(b, h) (((b) * 2 + (h)) * HTB)
#define PG8_SB(b, h) ((4 + (b) * 2 + (h)) * HTB)
#define PG8_STAGE(bufoff, gbase, voff) do { _Pragma("unroll") for (int _i = 0; _i < 2; ++_i) \
        __builtin_amdgcn_global_load_lds((const unsigned*)((const char*)(gbase) + (voff)[_i]), (PG8_LAS unsigned*)(lds + (bufoff) + ldsw + _i * 8192), 16, 0, 0); } while (0)
#define PG8_LDA(dst, b, h) do { _Pragma("unroll") for (int m = 0; m < 4; ++m) _Pragma("unroll") for (int k = 0; k < 2; ++k) dst[m][k] = *(const PG8_LAS bf16x8*)(lds + PG8_SA(b, h) + aoff + m * 2048 + k * 1024); } while (0)
#define PG8_LDB(dst, b, h) do { _Pragma("unroll") for (int n = 0; n < 2; ++n) _Pragma("unroll") for (int k = 0; k < 2; ++k) dst[n][k] = *(const PG8_LAS bf16x8*)(lds + PG8_SB(b, h) + boff + n * 2048 + k * 1024); } while (0)
#define PG8_MMA(ai, bj, At, Bt) do { __builtin_amdgcn_s_setprio(1); _Pragma("unroll") for (int m = 0; m < 4; ++m) _Pragma("unroll") for (int n = 0; n < 2; ++n) _Pragma("unroll") for (int k = 0; k < 2; ++k) \
        acc[ai][bj][m][n] = __builtin_amdgcn_mfma_f32_16x16x32_bf16(Bt[n][k], At[m][k], acc[ai][bj][m][n], 0, 0, 0); __builtin_amdgcn_s_setprio(0); } while (0)
#define PG8_WAIT_V(n) asm volatile("s_waitcnt vmcnt(" #n ")" ::: "memory")
#define PG8_WAIT_L(n) asm volatile("s_waitcnt lgkmcnt(" #n ")" ::: "memory")
#define PG8_BAR __builtin_amdgcn_s_barrier()
#define PG8_SCHED __builtin_amdgcn_sched_barrier(0)
    Unit cur, nxt; int ui = 0;
    if (!S.next(0, cur)) return;
    f32x4 acc[2][2][4][2];
#pragma unroll
    for (int a = 0; a < 2; ++a)
#pragma unroll
        for (int b = 0; b < 2; ++b)
#pragma unroll
            for (int m = 0; m < 4; ++m)
#pragma unroll
                for (int n = 0; n < 2; ++n) acc[a][b][m][n] = (f32x4){0.f, 0.f, 0.f, 0.f};
    bf16x8 At[4][2], B0[2][2], B1[2][2];
    const char* cA = (const char*)g.A + (size_t)cur.pm * tstep; const char* cB = (const char*)g.Bt + (size_t)cur.pn * tstep;
    S.a_ready(cur);
    if constexpr (SP2) {
        PG8_STAGE(PG8_SB(0, 0), cB, voffB); PG8_STAGE(PG8_SB(0, 1), cB + hstep, voffB); PG8_STAGE(PG8_SA(0, 0), cA, voffA); PG8_STAGE(PG8_SA(0, 1), cA + hstep, voffA);
        if (wr == 1) PG8_BAR;
        PG8_WAIT_V(2); PG8_BAR;
        PG8_STAGE(PG8_SB(1, 0), cB + kstep, voffB); PG8_STAGE(PG8_SA(1, 0), cA + kstep, voffA); PG8_STAGE(PG8_SB(1, 1), cB + hstep + kstep, voffB);
        PG8_WAIT_V(6); PG8_BAR;
    } else {
        PG8_STAGE(PG8_SB(0, 0), cB, voffB); PG8_STAGE(PG8_SA(0, 0), cA, voffA); PG8_STAGE(PG8_SB(0, 1), cB + hstep, voffB); PG8_STAGE(PG8_SA(0, 1), cA + hstep, voffA);
        if (wr == 1) PG8_BAR;
        PG8_WAIT_V(4); PG8_BAR;
        PG8_STAGE(PG8_SB(1, 0), cB + kstep, voffB); PG8_STAGE(PG8_SA(1, 0), cA + kstep, voffA); PG8_STAGE(PG8_SB(1, 1), cB + hstep + kstep, voffB);
        PG8_WAIT_V(6); PG8_BAR;
    }
    for (;;) {
        const bool has_next = S.next(ui + 1, nxt);
        const char* nA = has_next ? (const char*)g.A + (size_t)nxt.pm * tstep : cA; const char* nB = has_next ? (const char*)g.Bt + (size_t)nxt.pn * tstep : cB;
        for (int t = 0; t < nt; t += 2) {
            const bool last = (t == nt - 2);
            const char* a1 = cA + (size_t)(t + 1) * kstep;
            const char* a2 = last ? nA : cA + (size_t)(t + 2) * kstep; const char* b2 = last ? nB : cB + (size_t)(t + 2) * kstep;
            const char* a3 = a2 + kstep; const char* b3 = b2 + kstep;
            if (last && has_next) S.a_ready(nxt);
            if constexpr (SP2) {
            PG8_LDB(B0, 0, 0); PG8_LDB(B1, 0, 1); PG8_SCHED; PG8_LDA(At, 0, 0); PG8_STAGE(PG8_SA(1, 1), a1 + hstep, voffA);
            PG8_WAIT_V(8); PG8_WAIT_L(0); PG8_BAR; PG8_MMA(0, 0, At, B0); PG8_MMA(0, 1, At, B1); PG8_BAR; PG8_SCHED;
            PG8_LDA(At, 0, 1); PG8_STAGE(PG8_SB(0, 0), b2, voffB); PG8_STAGE(PG8_SB(0, 1), b2 + hstep, voffB); PG8_STAGE(PG8_SA(0, 0), a2, voffA);
            PG8_WAIT_V(8); PG8_WAIT_L(0); PG8_BAR; PG8_MMA(1, 0, At, B0); PG8_MMA(1, 1, At, B1); PG8_BAR; PG8_SCHED;
            PG8_LDB(B0, 1, 0); PG8_LDB(B1, 1, 1); PG8_SCHED; PG8_LDA(At, 1, 0); PG8_STAGE(PG8_SA(0, 1), a2 + hstep, voffA);
            PG8_WAIT_V(8); PG8_WAIT_L(0); PG8_BAR; PG8_MMA(0, 0, At, B0); PG8_MMA(0, 1, At, B1); PG8_BAR; PG8_SCHED;
            PG8_LDA(At, 1, 1); PG8_STAGE(PG8_SB(1, 0), b3, voffB); PG8_STAGE(PG8_SB(1, 1), b3 + hstep, voffB); PG8_STAGE(PG8_SA(1, 0), a3, voffA);
            PG8_WAIT_V(8); PG8_WAIT_L(0); PG8_BAR; PG8_MMA(1, 0, At, B0); PG8_MMA(1, 1, At, B1); PG8_BAR; PG8_SCHED;
            } else {
            PG8_LDB(B0, 0, 0); PG8_SCHED; PG8_LDA(At, 0, 0); PG8_STAGE(PG8_SA(1, 1), a1 + hstep, voffA);
            PG8_WAIT_L(8); PG8_BAR; PG8_WAIT_L(0); PG8_MMA(0, 0, At, B0); PG8_BAR; PG8_SCHED;
            PG8_LDB(B1, 0, 1); PG8_STAGE(PG8_SB(0, 0), b2, voffB);
            PG8_BAR; PG8_WAIT_L(0); PG8_MMA(0, 1, At, B1); PG8_BAR;
            PG8_LDA(At, 0, 1); PG8_STAGE(PG8_SA(0, 0), a2, voffA);
            PG8_BAR; PG8_WAIT_L(0); PG8_MMA(1, 0, At, B0); PG8_BAR; PG8_SCHED;
            PG8_STAGE(PG8_SB(0, 1), b2 + hstep, voffB);
            PG8_WAIT_V(6); PG8_BAR; PG8_MMA(1, 1, At, B1); PG8_BAR;
            PG8_LDB(B0, 1, 0); PG8_SCHED; PG8_LDA(At, 1, 0); PG8_STAGE(PG8_SA(0, 1), a2 + hstep, voffA);
            PG8_WAIT_L(8); PG8_BAR; PG8_WAIT_L(0); PG8_MMA(0, 0, At, B0); PG8_BAR; PG8_SCHED;
            PG8_LDB(B1, 1, 1); PG8_STAGE(PG8_SB(1, 0), b3, voffB);
            PG8_BAR; PG8_WAIT_L(0); PG8_MMA(0, 1, At, B1); PG8_BAR;
            PG8_LDA(At, 1, 1); PG8_STAGE(PG8_SA(1, 0), a3, voffA);
            PG8_BAR; PG8_WAIT_L(0); PG8_MMA(1, 0, At, B0); PG8_BAR; PG8_SCHED;
            PG8_STAGE(PG8_SB(1, 1), b3 + hstep, voffB);
            PG8_WAIT_V(6); PG8_BAR; PG8_MMA(1, 1, At, B1); PG8_BAR;
            }
        }
        if constexpr (ALIGN_EPI) { if (wr == 0) PG8_BAR; }
        if constexpr (!Epi::AFTER_DRAIN) { E(acc, cur, wr, wc, fr, fq); S.done(cur); }
        if (!has_next) break;
#pragma unroll
        for (int a = 0; a < 2; ++a)
#pragma unroll
            for (int b = 0; b < 2; ++b)
#pragma unroll
                for (int m = 0; m < 4; ++m)
#pragma unroll
                    for (int n = 0; n < 2; ++n) acc[a][b][m][n] = (f32x4){0.f, 0.f, 0.f, 0.f};
        cur = nxt; cA = nA; cB = nB; ++ui;
        if constexpr (ALIGN_EPI) { if (wr == 1) PG8_BAR; }
    }
    PG8_WAIT_V(0);
    if constexpr (!ALIGN_EPI) { if (wr == 0) PG8_BAR; }
    PG8_BAR;
    if constexpr (Epi::AFTER_DRAIN) { E.fused(acc, cur, wr, wc, fr, fq, lds, wid, lane); S.done(cur); }
#undef PG8_SA
#undef PG8_SB
#undef PG8_STAGE
#undef PG8_LDA
#undef PG8_LDB
#undef PG8_MMA
#undef PG8_WAIT_V
#undef PG8_WAIT_L
#undef PG8_BAR
#undef PG8_SCHED
}

template <class Epi, class Sched, int K1, int K2>
__device__ __forceinline__ void gemm_dual(PG8_LAS unsigned char* lds, const Gemm g1, const Gemm g2, const Sched& S, const Epi& E) {
    const int tid = threadIdx.x, wid = __builtin_amdgcn_readfirstlane(tid >> 6), lane = tid & 63, wr = wid >> 2, wc = wid & 3, fr = lane & 15, fq = lane >> 4;
    static_assert(K1 == 1024 && K2 == 512, "offset trick below"); constexpr int nt1 = K1 / BK, nt = nt1 + K2 / BK;
    unsigned voffA1[2], voffB1[2];
#pragma unroll
    for (int i = 0; i < 2; ++i) { int R, C; stage_rc(tid * 16 + i * 8192, R, C); const int Rb = Epi::PERM ? ((R & ~31) + perm32(R & 31)) : R;
        voffA1[i] = (unsigned)(R * K1 + C) * 2u; voffB1[i] = (unsigned)(Rb * K1 + C) * 2u; }
    constexpr size_t kstep = (size_t)(BK * 2), hstep1 = (size_t)HALF * K1 * 2, hstep2 = (size_t)HALF * K2 * 2;
    const unsigned ldsw = (unsigned)wid * 1024u;
    const int aoff = lds_byte(wr * 64 + fr, fq * 8), boff = lds_byte(wc * 32 + fr, fq * 8);
#define PG8_SA(b, h) (((b) * 2 + (h)) * HTB)
#define PG8_SB(b, h) ((4 + (b) * 2 + (h)) * HTB)
#define PG8_STAGE(bufoff, gbase, voff) do { _Pragma("unroll") for (int _i = 0; _i < 2; ++_i) \
        __builtin_amdgcn_global_load_lds((const unsigned*)((const char*)(gbase) + (voff)[_i]), (PG8_LAS unsigned*)(lds + (bufoff) + ldsw + _i * 8192), 16, 0, 0); } while (0)
#define PG8_STAGE2(bufoff, gbase, voff) do { _Pragma("unroll") for (int _i = 0; _i < 2; ++_i) \
        __builtin_amdgcn_global_load_lds((const unsigned*)((const char*)(gbase) + (((voff)[_i] >> 11) << 10) + ((voff)[_i] & 2047u)), (PG8_LAS unsigned*)(lds + (bufoff) + ldsw + _i * 8192), 16, 0, 0); } while (0)
#define PG8_STAGE_A(bufoff, tau, half) do { if ((tau) < nt1) PG8_STAGE(bufoff, cA1 + (size_t)(tau) * kstep + (half) * hstep1, voffA1); else PG8_STAGE2(bufoff, cA2 + (size_t)((tau) - nt1) * kstep + (half) * hstep2, voffA1); } while (0)
#define PG8_STAGE_B(bufoff, tau, half) do { if ((tau) < nt1) PG8_STAGE(bufoff, cB1 + (size_t)(tau) * kstep + (half) * hstep1, voffB1); else PG8_STAGE2(bufoff, cB2 + (size_t)((tau) - nt1) * kstep + (half) * hstep2, voffB1); } while (0)
#define PG8_LDA(dst, b, h) do { _Pragma("unroll") for (int m = 0; m < 4; ++m) _Pragma("unroll") for (int k = 0; k < 2; ++k) dst[m][k] = *(const PG8_LAS bf16x8*)(lds + PG8_SA(b, h) + aoff + m * 2048 + k * 1024); } while (0)
#define PG8_LDB(dst, b, h) do { _Pragma("unroll") for (int n = 0; n < 2; ++n) _Pragma("unroll") for (int k = 0; k < 2; ++k) dst[n][k] = *(const PG8_LAS bf16x8*)(lds + PG8_SB(b, h) + boff + n * 2048 + k * 1024); } while (0)
#define PG8_MMA(ai, bj, At, Bt) do { __builtin_amdgcn_s_setprio(1); _Pragma("unroll") for (int m = 0; m < 4; ++m) _Pragma("unroll") for (int n = 0; n < 2; ++n) _Pragma("unroll") for (int k = 0; k < 2; ++k) \
        acc[ai][bj][m][n] = __builtin_amdgcn_mfma_f32_16x16x32_bf16(Bt[n][k], At[m][k], acc[ai][bj][m][n], 0, 0, 0); __builtin_amdgcn_s_setprio(0); } while (0)
#define PG8_WAIT_V(n) asm volatile("s_waitcnt vmcnt(" #n ")" ::: "memory")
#define PG8_WAIT_L(n) asm volatile("s_waitcnt lgkmcnt(" #n ")" ::: "memory")
#define PG8_BAR __builtin_amdgcn_s_barrier()
#define PG8_SCHED __builtin_amdgcn_sched_barrier(0)
    Unit cur;
    if (!S.next(0, cur)) return;
    f32x4 acc[2][2][4][2];
#pragma unroll
    for (int a = 0; a < 2; ++a)
#pragma unroll
        for (int b = 0; b < 2; ++b)
#pragma unroll
            for (int m = 0; m < 4; ++m)
#pragma unroll
                for (int n = 0; n < 2; ++n) acc[a][b][m][n] = (f32x4){0.f, 0.f, 0.f, 0.f};
    bf16x8 At[4][2], B0[2][2], B1[2][2];
    const char* cA1 = (const char*)g1.A + (size_t)cur.pm * 2 * hstep1; const char* cB1 = (const char*)g1.Bt + (size_t)cur.pn * 2 * hstep1;
    const char* cA2 = (const char*)g2.A + (size_t)cur.pm * 2 * hstep2; const char* cB2 = (const char*)g2.Bt + (size_t)cur.pn * 2 * hstep2;
    PG8_STAGE_B(PG8_SB(0, 0), 0, 0); PG8_STAGE_B(PG8_SB(0, 1), 0, 1); PG8_STAGE_A(PG8_SA(0, 0), 0, 0); PG8_STAGE_A(PG8_SA(0, 1), 0, 1);
    if (wr == 1) PG8_BAR;
    PG8_WAIT_V(2); PG8_BAR;
    PG8_STAGE_B(PG8_SB(1, 0), 1, 0); PG8_STAGE_A(PG8_SA(1, 0), 1, 0); PG8_STAGE_B(PG8_SB(1, 1), 1, 1);
    PG8_WAIT_V(6); PG8_BAR;
#define PG8_DUAL_TRIP(t) do { \
        const int t2 = (t == nt - 2) ? 0 : t + 2, t3 = t2 + 1; \
        PG8_LDB(B0, 0, 0); PG8_LDB(B1, 0, 1); PG8_SCHED; PG8_LDA(At, 0, 0); PG8_STAGE_A(PG8_SA(1, 1), t + 1, 1); \
        PG8_WAIT_V(8); PG8_WAIT_L(0); PG8_BAR; PG8_MMA(0, 0, At, B0); PG8_MMA(0, 1, At, B1); PG8_BAR; PG8_SCHED; \
        PG8_LDA(At, 0, 1); PG8_STAGE_B(PG8_SB(0, 0), t2, 0); PG8_STAGE_B(PG8_SB(0, 1), t2, 1); PG8_STAGE_A(PG8_SA(0, 0), t2, 0); \
        PG8_WAIT_V(8); PG8_WAIT_L(0); PG8_BAR; PG8_MMA(1, 0, At, B0); PG8_MMA(1, 1, At, B1); PG8_BAR; PG8_SCHED; \
        PG8_LDB(B0, 1, 0); PG8_LDB(B1, 1, 1); PG8_SCHED; PG8_LDA(At, 1, 0); PG8_STAGE_A(PG8_SA(0, 1), t2, 1); \
        PG8_WAIT_V(8); PG8_WAIT_L(0); PG8_BAR; PG8_MMA(0, 0, At, B0); PG8_MMA(0, 1, At, B1); PG8_BAR; PG8_SCHED; \
        PG8_LDA(At, 1, 1); PG8_STAGE_B(PG8_SB(1, 0), t3, 0); PG8_STAGE_B(PG8_SB(1, 1), t3, 1); PG8_STAGE_A(PG8_SA(1, 0), t3, 0); \
        PG8_WAIT_V(8); PG8_WAIT_L(0); PG8_BAR; PG8_MMA(1, 0, At, B0); PG8_MMA(1, 1, At, B1); PG8_BAR; PG8_SCHED; \
    } while (0)
    for (int t = 0; t < nt1; t += 2) PG8_DUAL_TRIP(t);
    E.mid(acc, cur, wr, wc, fr, fq);
    for (int t = nt1; t < nt; t += 2) PG8_DUAL_TRIP(t);
#undef PG8_DUAL_TRIP
    E(acc, cur, wr, wc, fr, fq);
    PG8_WAIT_V(0);
    if (wr == 0) PG8_BAR;
    PG8_BAR;
#undef PG8_SA
#undef PG8_SB
#undef PG8_STAGE
#undef PG8_STAGE2
#undef PG8_STAGE_A
#undef PG8_STAGE_B
#undef PG8_LDA
#undef PG8_LDB
#undef PG8_MMA
#undef PG8_WAIT_V
#undef PG8_WAIT_L
#undef PG8_BAR
#undef PG8_SCHED
}
}
#define GAS __attribute__((address_space(1)))
#define LAS __attribute__((address_space(3)))
typedef unsigned short bf16;
typedef unsigned v4u __attribute__((ext_vector_type(4)));
typedef float f32x4 __attribute__((ext_vector_type(4)));
typedef short bf16x8 __attribute__((ext_vector_type(8)));
typedef GAS unsigned gu32;
typedef GAS unsigned long long gu64;
#define RLX_AGENT __ATOMIC_RELAXED, __HIP_MEMORY_SCOPE_AGENT
#define LDS_WAIT() asm volatile("s_waitcnt lgkmcnt(0)" ::: "memory")
#define VM_WAIT() asm volatile("s_waitcnt vmcnt(0)" ::: "memory")
__device__ __forceinline__ unsigned long long rt() { return __builtin_amdgcn_s_memrealtime(); }
__device__ __forceinline__ unsigned f2bf(float f) { unsigned u = __builtin_bit_cast(unsigned, f); return (u + 0x7fffu + ((u >> 16) & 1u)) >> 16; }
typedef __bf16 bf16x2_t __attribute__((ext_vector_type(2)));
typedef float f32x2p __attribute__((ext_vector_type(2)));
__device__ __forceinline__ unsigned pk2(float lo, float hi) { const f32x2p v = {lo, hi}; const bf16x2_t b = __builtin_convertvector(v, bf16x2_t); return __builtin_bit_cast(unsigned, b); }

#define XB_TMO      128
#define XB_XCNT(j)  (256  + 64 * (j))
#define XB_XSUB(j)  (1280 + 64 * (j))
#define XB_XGEN(j)  (2304 + 64 * (j))
#define XB_TOP      3328
#define XB_TOPGEN   3392
#define XCD_BAR_WORDS 3456
#define XB_SPIN_CAP (1u << 18)

__device__ __forceinline__ unsigned xb_ld(unsigned* p)              { return __hip_atomic_load(p, __ATOMIC_RELAXED, __HIP_MEMORY_SCOPE_AGENT); }
__device__ __forceinline__ unsigned xb_add(unsigned* p, unsigned v) { return __hip_atomic_fetch_add(p, v, __ATOMIC_RELAXED, __HIP_MEMORY_SCOPE_AGENT); }
__device__ __forceinline__ unsigned xb_xcc_id() { return (unsigned)__builtin_amdgcn_s_getreg((3 << 11) | 20) & 0xFu; }
#define XB_SPIN(cond, bar) do { unsigned _sp = 0; while (cond) { __builtin_amdgcn_s_sleep(1); \
    if ((++_sp & 255u) == 0u) { if (xb_ld(&(bar)[XB_TMO])) break; if (_sp > XB_SPIN_CAP) { atomicAdd(&(bar)[XB_TMO], 1u); break; } } } } while (0)

struct XcdBarrier {
    unsigned* bar; unsigned x; unsigned ngrp;
    volatile LAS unsigned* st;
};

__device__ __forceinline__ XcdBarrier xcd_barrier_post(unsigned* bar, volatile LAS unsigned* st) {
    XcdBarrier b; b.bar = bar; b.x = xb_xcc_id(); b.st = st; b.ngrp = 0u;
    if (threadIdx.x == 0) (void)xb_add(&bar[XB_XCNT(b.x)], 1u);
    return b;
}
__device__ __forceinline__ void xcd_barrier_complete(unsigned* bar, unsigned x, unsigned& nloc, unsigned& nx, unsigned ngrp) {
    const unsigned G = ngrp ? ngrp : gridDim.x * gridDim.y * gridDim.z;
    unsigned sum, cnt, mine, sp = 0u;
    for (;;) {
        sum = 0u; cnt = 0u; mine = 0u;
#pragma unroll
        for (unsigned j = 0; j < 16; ++j) { const unsigned c = xb_ld(&bar[XB_XCNT(j)]); sum += c; cnt += (c > 0u) ? 1u : 0u; mine = (j == x) ? c : mine; }
        if (sum == G) break;
        __builtin_amdgcn_s_sleep(1);
        if ((++sp & 255u) == 0u) { if (xb_ld(&bar[XB_TMO])) break; if (sp > XB_SPIN_CAP) { atomicAdd(&bar[XB_TMO], 1u); break; } }
    }
    nloc = mine > 0u ? mine : 1u; nx = cnt > 0u ? cnt : 1u;
}

__device__ __forceinline__ void xcd_barrier(const XcdBarrier& b) {
    asm volatile("s_waitcnt vmcnt(0)" ::: "memory");
    __syncthreads();
    if (threadIdx.x == 0) {
        unsigned* bar = b.bar;
        __builtin_amdgcn_s_waitcnt(0);
        unsigned nloc = b.st[0], nx = b.st[1];
        if (nloc == 0u) { xcd_barrier_complete(bar, b.x, nloc, nx, b.ngrp); b.st[0] = nloc; b.st[1] = nx; }
        const unsigned old = xb_add(&bar[XB_XSUB(b.x)], 1u);
        const unsigned gen = old / nloc;
        if (old + 1u == (gen + 1u) * nloc) {
            __builtin_amdgcn_fence(__ATOMIC_RELEASE, "agent");
            asm volatile("s_waitcnt vmcnt(0)" ::: "memory");
            const unsigned og = xb_add(&bar[XB_TOP], 1u);
            const unsigned tg = og / nx;
            if (og + 1u == (tg + 1u) * nx) xb_add(&bar[XB_TOPGEN], 1u);
            else XB_SPIN(xb_ld(&bar[XB_TOPGEN]) == tg, bar);
            __builtin_amdgcn_fence(__ATOMIC_ACQUIRE, "agent");
            xb_add(&bar[XB_XGEN(b.x)], 1u);
            asm volatile("s_waitcnt vmcnt(0)" ::: "memory");
        } else {
            XB_SPIN(xb_ld(&bar[XB_XGEN(b.x)]) == gen, bar);
            __builtin_amdgcn_fence(__ATOMIC_ACQUIRE, "agent");
            asm volatile("s_waitcnt vmcnt(0)" ::: "memory");
        }
    }
    __syncthreads();
}
constexpr int NWAVES = 8, NTHR = 512;
#ifndef MK_PER_PHASE
#define MK_PER_PHASE 0
#endif
constexpr int NPHASE = 8;
constexpr int BATCH = 2, SEQ = 8192, D = 1024, T = BATCH * SEQ, LCTX = 256, TCX = BATCH * LCTX, MROWS = T + TCX;
constexpr int NH = 8, CHK = 64, NCHL = SEQ / CHK, NCHC = LCTX / CHK, NCH = NCHL + NCHC;
constexpr int INW = 7200, NPAD = 7424;
constexpr float EPS = 1e-6f;
constexpr size_t MiB = 1u << 20;
constexpr size_t WS_CTL = 0, CTL_ZERO_BYTES = 1 * MiB, CTL_GRAN = 256 * 1024;
constexpr size_t WS_TAB = 1 * MiB;
constexpr size_t TAB_MODP = 0, TAB_GATE = 589824, TAB_ABAR = 598016, TAB_A64 = 630784, TAB_BBAR = 663552, TAB_BBT = 1187840, TAB_CBT = 1449984;
constexpr size_t WS_WIN = 3 * MiB, WS_WPD = WS_WIN + (size_t)NPAD * D * 2, WS_WPS = WS_WPD + 2 * MiB, WS_WOUT = WS_WPS + 1 * MiB, WS_GLU = WS_WOUT + 2 * MiB;
constexpr size_t WS_QKV = 23 * MiB, WS_QKVC = 119 * MiB, WS_U = 122 * MiB, WS_BD = WS_U + (size_t)MROWS * 512 * 2, WS_RG = 141 * MiB, WS_CTXTA = 253 * MiB, WS_END = 254 * MiB;
static_assert(WS_GLU + 512 * 512 * 2 <= WS_QKV && WS_BD + (size_t)MROWS * 32 * 4 <= WS_RG, "ws map");
constexpr size_t WS_TA = WS_RG, WS_ODIR = WS_RG + 32 * MiB, WS_YDN = WS_RG, WS_M1 = WS_RG + 32 * MiB, WS_MERGED = WS_RG + 64 * MiB, WS_ZS5 = WS_RG + 96 * MiB;
constexpr size_t WS_QKVC_RAW = WS_RG + 32 * MiB;
constexpr size_t WS_ZDN = WS_QKV, WS_GDN = WS_QKV + 32 * MiB, WS_GS5 = WS_QKV + 64 * MiB, WS_YS5 = WS_U;
constexpr size_t DO_H = 0, DO_SC = 33 * MiB, DO_EH = 38 * MiB, DO_Y = 47 * MiB;
constexpr int SCBLK = 256;
constexpr int CW_BAR = 4096, CW_BAR2 = 8192, CW_PAN = 16384, CW_PAN2 = 20480, CW_PAN3 = 24576;
constexpr int RING_BYTES = 143360, LDSCTL_OFF = RING_BYTES, MISC_OFF = LDSCTL_OFF + 320, LDS_BYTES = 147456;
typedef float f32x2 __attribute__((ext_vector_type(2)));
typedef unsigned v2u __attribute__((ext_vector_type(2)));
#define MFMA16(a, b, c) __builtin_amdgcn_mfma_f32_16x16x32_bf16((a), (b), (c), 0, 0, 0)
__device__ __forceinline__ int off256(int row, int slot) { return row * 256 + ((slot ^ (row & 15)) << 4); }
__device__ __forceinline__ int off128(int row, int slot) { return row * 128 + ((slot ^ ((row >> 1) & 7)) << 4); }
__device__ __forceinline__ int img128_byte(int oi, int oj) { return off128(oi, 4 * (oj >> 5) + ((oj >> 2) & 3)) + 8 * ((oj >> 4) & 1) + 2 * (oj & 3); }
typedef short s16x4 __attribute__((ext_vector_type(4)));
__device__ __forceinline__ s16x4 ds_tr(const LAS unsigned char* p) { return __builtin_bit_cast(s16x4, __builtin_amdgcn_ds_read_tr16_b64_v4i16((LAS s16x4*)p)); }
__device__ __forceinline__ unsigned cvtpk_c(float lo, float hi) { const f32x2 v = {lo, hi}; const bf16x2_t b = __builtin_convertvector(v, bf16x2_t); return __builtin_bit_cast(unsigned, b); }
__device__ __forceinline__ float bf2f(unsigned v) { return __builtin_bit_cast(float, v << 16); }
__device__ __forceinline__ float sigmoidf_(float x) { return __builtin_amdgcn_rcpf(1.f + __expf(-x)); }
__device__ __forceinline__ float siluf_(float x) { return x * __builtin_amdgcn_rcpf(1.f + __expf(-x)); }
__device__ __forceinline__ float softplusf_(float x) { return x > 20.f ? x : log1pf(__expf(x)); }
__device__ __forceinline__ float gelu_tanh(float x) { const float u = 0.7978845608028654f * (x + 0.044715f * x * x * x); const float e = __expf(2.f * u); const float th = 1.f - 2.f * __builtin_amdgcn_rcpf(e + 1.f); return 0.5f * x * (1.f + th); }
__device__ __forceinline__ void unpack8(const v4u r, float* f) { f[0] = bf2f(r.x & 0xffffu); f[1] = bf2f(r.x >> 16); f[2] = bf2f(r.y & 0xffffu); f[3] = bf2f(r.y >> 16); f[4] = bf2f(r.z & 0xffffu); f[5] = bf2f(r.z >> 16); f[6] = bf2f(r.w & 0xffffu); f[7] = bf2f(r.w >> 16); }
__device__ __forceinline__ v4u pack8(const float* f) { v4u o; o.x = pk2(f[0], f[1]); o.y = pk2(f[2], f[3]); o.z = pk2(f[4], f[5]); o.w = pk2(f[6], f[7]); return o; }
__device__ __forceinline__ float wave_sum(float v) {
#pragma unroll
    for (int o = 1; o < 64; o <<= 1) v += __shfl_xor(v, o);
    return v;
}

__device__ __forceinline__ float dpp_add(float x, int ctrl_sel) {
    const int xi = __builtin_bit_cast(int, x); int yi;
    if (ctrl_sel == 0) yi = __builtin_amdgcn_update_dpp(0, xi, 0xB1, 0xF, 0xF, false);
    else if (ctrl_sel == 1) yi = __builtin_amdgcn_update_dpp(0, xi, 0x4E, 0xF, 0xF, false);
    else if (ctrl_sel == 2) yi = __builtin_amdgcn_update_dpp(0, xi, 0x141, 0xF, 0xF, false);
    else yi = __builtin_amdgcn_update_dpp(0, xi, 0x140, 0xF, 0xF, false);
    return x + __builtin_bit_cast(float, yi);
}
__device__ __forceinline__ float sum8(float x) { x = dpp_add(x, 0); x = dpp_add(x, 1); return dpp_add(x, 2); }
__device__ __forceinline__ float sum16(float x) { return dpp_add(sum8(x), 3); }
struct Frame {
    LAS unsigned char* lds;
    int tid, lane, wave, vcu, G;
    const float* in[26]; float* out; unsigned char* ws;
};
#define WSP(T_, off) ((T_*)(F.ws + (off)))
#define DOP(T_, off) ((T_*)((unsigned char*)F.out + (off)))
#define TABP(T_, off) ((T_*)(F.ws + WS_TAB + (off)))
enum { I_X = 0, I_C, I_CTX, I_CCTX, I_WADA, I_BADA, I_NORMW, I_WIN, I_CONVW, I_ALOG, I_DTB, I_DNNW, I_LRE, I_LIM, I_LSTEP, I_BRE, I_BIM, I_CRE, I_CIM, I_S5D, I_GLUW, I_GLUB, I_WPD, I_WPS, I_WOUT, I_FNW };

template <int NB> __device__ __forceinline__ void tr_item(const float* W, int K, int N, bf16* WT, LAS float* scr, int k0, int sn0, int dn0, int lane) {
#pragma unroll
    for (int hh = 0; hh < 32 / NB; ++hh) { float tv[NB];
#pragma unroll
        for (int i = 0; i < NB; ++i) tv[i] = W[(size_t)(k0 + 2 * (NB * hh + i) + (lane >> 5)) * N + sn0 + (lane & 31)];
#pragma unroll
        for (int i = 0; i < NB; ++i) scr[(2 * (NB * hh + i) + (lane >> 5)) * 33 + (lane & 31)] = tv[i]; }
    LDS_WAIT(); asm volatile("" ::: "memory");
    const int c = lane & 7;
#pragma unroll
    for (int j = 0; j < 4; ++j) { const int n = (lane >> 3) + 8 * j; const LAS float* s = scr + (8 * c) * 33 + n;
        v4u o; o.x = pk2(s[0 * 33], s[1 * 33]); o.y = pk2(s[2 * 33], s[3 * 33]); o.z = pk2(s[4 * 33], s[5 * 33]); o.w = pk2(s[6 * 33], s[7 * 33]);
        *(v4u*)(WT + (size_t)(dn0 + n) * K + k0 + 8 * c) = o; }
    LDS_WAIT(); asm volatile("" ::: "memory");
}
__device__ __forceinline__ void phase0(Frame& F) {
    LAS float* scr = (LAS float*)(F.lds + F.wave * 16384);
    const int gw = F.vcu * NWAVES + F.wave, NGW = F.G * NWAVES, lane = F.lane;
    constexpr int N_WIN = 16 * 225, N_PD = 512, N_PS = 256, N_OUT = 512, N_GLU = 128, N_Z = 28, N_MOD = 768, N_S5 = 64;
    constexpr int N_ALL = N_WIN + N_PD + N_PS + N_OUT + N_GLU + N_Z + N_MOD + N_S5;
    for (int it = gw; it < N_ALL; it += NGW) {
        int r = it;
        if (r < N_WIN) { const int kb = r / 225, sb = r % 225, db = sb < 96 ? sb : (sb == 96 ? 224 : sb - 1); tr_item<32>(F.in[I_WIN], 1024, INW, WSP(bf16, WS_WIN), scr, kb * 64, sb * 32, db * 32, lane); continue; } r -= N_WIN;
        if (r < N_PD) { tr_item<32>(F.in[I_WPD], 1024, 1024, WSP(bf16, WS_WPD), scr, (r / 32) * 64, (r % 32) * 32, (r % 32) * 32, lane); continue; } r -= N_PD;
        if (r < N_PS) { tr_item<32>(F.in[I_WPS], 512, 1024, WSP(bf16, WS_WPS), scr, (r / 32) * 64, (r % 32) * 32, (r % 32) * 32, lane); continue; } r -= N_PS;
        if (r < N_OUT) { tr_item<32>(F.in[I_WOUT], 1024, 1024, WSP(bf16, WS_WOUT), scr, (r / 32) * 64, (r % 32) * 32, (r % 32) * 32, lane); continue; } r -= N_OUT;
        if (r < N_GLU) { tr_item<32>(F.in[I_GLUW], 512, 512, WSP(bf16, WS_GLU), scr, (r / 16) * 64, (r % 16) * 32, (r % 16) * 32, lane); continue; } r -= N_GLU;
        if (r < N_Z) { v4u* zb = (v4u*)(WSP(bf16, WS_WIN) + (size_t)INW * 1024 + (size_t)r * 8192); const v4u z = {0u, 0u, 0u, 0u};
#pragma unroll
            for (int j = 0; j < 16; ++j) zb[j * 64 + lane] = z; continue; } r -= N_Z;
        if (r < N_MOD) { const int ks = r / 48, j = (r % 48) * 64 + lane; float s0 = 0.f, s1 = 0.f, s2 = 0.f;
            const float* wa = F.in[I_WADA]; const float* cv = F.in[I_C]; const float* cc = F.in[I_CCTX];
#pragma unroll 16
            for (int k = ks * 64; k < ks * 64 + 64; ++k) { const float w = wa[(size_t)k * 3072 + j]; s0 += siluf_(cv[k]) * w; s1 += siluf_(cv[1024 + k]) * w; s2 += siluf_(cc[k]) * w; }
            float* mp = TABP(float, TAB_MODP); mp[(ks * 3 + 0) * 3072 + j] = s0; mp[(ks * 3 + 1) * 3072 + j] = s1; mp[(ks * 3 + 2) * 3072 + j] = s2; continue; } r -= N_MOD;
        { const int idx = r * 64 + lane;
          const int dg = idx >> 6;
          const float lre = F.in[I_LRE][idx], lim = F.in[I_LIM][idx], dt = __expf(F.in[I_LSTEP][dg]);
          const float th = lim * dt, mag = __expf(lre * dt), ct = cosf(th), st = sinf(th), sh = sinf(0.5f * th);
          const float ar = mag * ct, ai = mag * st;
          const float nr = expm1f(lre * dt) * ct - 2.f * sh * sh, ni = ai, den = lre * lre + lim * lim;
          const float fr = (nr * lre + ni * lim) / den, fi = (ni * lre - nr * lim) / den;
          TABP(f32x2, TAB_ABAR)[idx] = (f32x2){ar, ai};
          const double th64 = (double)lim * (double)dt * 64.0; const double tw = th64 - 6.283185307179586 * rint(th64 / 6.283185307179586);
          const float m64 = __expf(64.f * lre * dt);
          TABP(f32x2, TAB_A64)[idx] = (f32x2){m64 * cosf((float)tw), m64 * sinf((float)tw)};
          const float* bre = F.in[I_BRE] + (size_t)idx * 16; const float* bim = F.in[I_BIM] + (size_t)idx * 16; f32x2* bb = TABP(f32x2, TAB_BBAR) + (size_t)idx * 16;
#pragma unroll
          for (int c = 0; c < 16; ++c) bb[c] = (f32x2){fr * bre[c] - fi * bim[c], fr * bim[c] + fi * bre[c]};
          const int p = idx & 63; bf16* bbt = TABP(bf16, TAB_BBT) + (size_t)dg * 2048; bf16* cbt = TABP(bf16, TAB_CBT) + (size_t)dg * 2048;
          float tr_[16], ti_[16];
#pragma unroll
          for (int c = 0; c < 16; ++c) { tr_[c] = fr * bre[c] - fi * bim[c]; ti_[c] = fr * bim[c] + fi * bre[c]; }
          *(v4u*)(bbt + p * 16) = pack8(tr_); *(v4u*)(bbt + p * 16 + 8) = pack8(tr_ + 8);
          *(v4u*)(bbt + (64 + p) * 16) = pack8(ti_); *(v4u*)(bbt + (64 + p) * 16 + 8) = pack8(ti_ + 8);
          const float* cre = F.in[I_CRE] + (size_t)dg * 1024 + p; const float* cim = F.in[I_CIM] + (size_t)dg * 1024 + p;
#pragma unroll
          for (int c = 0; c < 16; ++c) { cbt[c * 128 + p] = (bf16)f2bf(cre[c * 64]); cbt[c * 128 + 64 + p] = (bf16)f2bf(-cim[c * 64]); } }
    }
}
__device__ __forceinline__ void phase1(Frame& F) {
    LAS float* mult = (LAS float*)F.lds; LAS float* shf = mult + 3072;
    const float* mp = TABP(float, TAB_MODP); const float* bada = F.in[I_BADA]; const float* nw = F.in[I_NORMW];
    for (int e = F.tid; e < 3072; e += NTHR) { const int v = e >> 10, d = e & 1023; float sh = bada[d], sc = bada[1024 + d];
        for (int ks = 0; ks < 16; ++ks) { sh += mp[(ks * 3 + v) * 3072 + d]; sc += mp[(ks * 3 + v) * 3072 + 1024 + d]; }
        mult[e] = nw[d] * (1.f + sc); shf[e] = sh; }
    if (blockIdx.x == 0) for (int e = F.tid; e < 2048; e += NTHR) { const int v = e >> 10, d = e & 1023; float gt = bada[2048 + d];
        for (int ks = 0; ks < 16; ++ks) gt += mp[(ks * 3 + v) * 3072 + 2048 + d];
        TABP(float, TAB_GATE)[e] = gt; }
    __syncthreads();
    const int gw = F.vcu * NWAVES + F.wave, NGW = F.G * NWAVES;
    bf16* Hb = DOP(bf16, DO_H);
    for (int r = gw; r < MROWS; r += NGW) {
        const int v = r < SEQ ? 0 : (r < T ? 1 : 2);
        const float* src = r < T ? F.in[I_X] + (size_t)r * D : F.in[I_CTX] + (size_t)(r - T) * D;
        const f32x4* xr = (const f32x4*)src + F.lane;
        f32x4 xv[4]; float s = 0.f;
#pragma unroll
        for (int j = 0; j < 4; ++j) { xv[j] = xr[64 * j]; s += (xv[j].x * xv[j].x + xv[j].y * xv[j].y) + (xv[j].z * xv[j].z + xv[j].w * xv[j].w); }
        const float rinv = __builtin_amdgcn_rsqf(wave_sum(s) * (1.f / D) + EPS);
        unsigned long long* o8 = (unsigned long long*)(Hb + (size_t)r * D) + F.lane;
#pragma unroll
        for (int j = 0; j < 4; ++j) { const int e0 = v * 1024 + 4 * F.lane + 256 * j;
            const f32x4 m = *(const LAS f32x4*)(mult + e0), sh = *(const LAS f32x4*)(shf + e0);
            const f32x4 y = xv[j] * rinv * m + sh;
            o8[64 * j] = (unsigned long long)pk2(y.x, y.y) | ((unsigned long long)pk2(y.z, y.w) << 32); }
    }
}
struct OrderIn {
    pg8::StaticOrder so; bool first;
    __device__ void init(bool first_, int G, int c) { first = first_; if (first_) so.init(MROWS, 15 * 256, G, c); else so.init(T, 12 * 256, G, c); }
    __device__ bool next(int i, pg8::Unit& u) const {
        if (!so.next(i, u)) return false;
        u.pn = first ? (u.pn < 14 ? u.pn : 28) : (u.pn < 4 ? 14 + u.pn : 16 + u.pn); return true;
    }
    __device__ __forceinline__ void a_ready(const pg8::Unit&) const {}
    __device__ __forceinline__ void done(const pg8::Unit&) const {}
};
struct OrderOne {
    pg8::Unit u0;
    __device__ bool next(int i, pg8::Unit& u) const { if (i != 0) return false; u = u0; return true; }
    __device__ __forceinline__ void a_ready(const pg8::Unit&) const {}
    __device__ __forceinline__ void done(const pg8::Unit&) const {}
};
struct EpiIn {
    static constexpr bool PERM = true, AFTER_DRAIN = false;
    bf16 *QKV, *QKVC, *U, *ZDN, *ZS5, *GDN, *GS5; float* BD;
    __device__ __forceinline__ void operator()(const f32x4 (&acc)[2][2][4][2], const pg8::Unit& u, int wr, int wc, int fr, int fq) const {
        const int pn = u.pn; const bool ctx = u.pm >= 64;
#pragma unroll
        for (int ai = 0; ai < 2; ++ai)
#pragma unroll
            for (int m = 0; m < 4; ++m) {
                const int row = u.pm * 256 + ai * 128 + wr * 64 + m * 16 + fr;
#pragma unroll
                for (int bj = 0; bj < 2; ++bj) {
                    const f32x4 v0 = acc[ai][bj][m][0], v1 = acc[ai][bj][m][1];
                    float f[8] = {v0[0], v0[1], v0[2], v0[3], v1[0], v1[1], v1[2], v1[3]};
                    const int colin = bj * 128 + wc * 32 + 8 * fq;
                    if (pn < 12) {
                        const int which = pn >> 2, head = 2 * (pn & 3) + bj, d0 = wc * 32 + 8 * fq;
                        bf16* dst;
                        if (!ctx) { const int b = row >> 13, t = row & 8191; dst = QKV + ((size_t)(((which * 2 + b) * 8 + head) * SEQ + t)) * 128 + d0; }
                        else { const int rr = row - T, b = rr >> 8, t = rr & 255; dst = QKVC + ((size_t)(((which * 2 + b) * 8 + head) * LCTX + t)) * 128 + d0; }
                        *(v4u*)dst = pack8(f);
                    } else if (pn < 14) {
                        *(v4u*)(U + (size_t)row * 512 + (pn - 12) * 256 + colin) = pack8(f);
                    } else if (pn < 28) {
                        if (!ctx) {
                            if (pn < 20) {
#pragma unroll
                                for (int e = 0; e < 8; ++e) f[e] = siluf_(f[e]);
                                if (pn < 18) *(v4u*)(ZDN + (size_t)row * 1024 + (pn - 14) * 256 + colin) = pack8(f);
                                else *(v4u*)(ZS5 + (size_t)row * 512 + (pn - 18) * 256 + colin) = pack8(f);
                            } else {
#pragma unroll
                                for (int e = 0; e < 8; ++e) f[e] = sigmoidf_(f[e]);
                                if (pn < 24) *(v4u*)(GDN + (size_t)row * 1024 + (pn - 20) * 256 + colin) = pack8(f);
                                else *(v4u*)(GS5 + (size_t)row * 1024 + (pn - 24) * 256 + colin) = pack8(f);
                            }
                        }
                    } else {
                        if (bj == 0 && wc == 0) { float* dst = BD + (size_t)row * 32 + 8 * fq; *(f32x4*)dst = v0; *(f32x4*)(dst + 4) = v1; }
                    }
                }
            }
    }
};
typedef short s16x4k __attribute__((ext_vector_type(4)));
#define MFMA16K16(a, b, c) __builtin_amdgcn_mfma_f32_16x16x16bf16_1k((a), (b), (c), 0, 0, 0)
constexpr int S5_BUF_BYTES = 128 * 20 * 4, S5_HT_BYTES = 128 * 48;
template <bool OUT> __device__ __forceinline__ void s5_block(LAS float* buf, LAS unsigned char* hT, const LAS unsigned* ubw, const s16x4k (&bbf)[8], const bf16x8 (&cbf)[4], const f32x2 a, float& hr, float& hi,
                                                             int d, int ib, int lane, LAS float* yb) {
    const int fr = lane & 15, fq = lane >> 4;
    { const int i = 16 * ib + fr, t = d ? 63 - i : i; const v2u au = *(const LAS v2u*)(ubw + t * 8 + 2 * fq); const s16x4k af = __builtin_bit_cast(s16x4k, au);
#pragma unroll
      for (int nt = 0; nt < 8; ++nt) { const f32x4 Dm = MFMA16K16(af, bbf[nt], ((f32x4){0.f, 0.f, 0.f, 0.f}));
          *(LAS f32x4*)(buf + (16 * nt + fr) * 20 + 4 * fq) = Dm; } }
    asm volatile("" ::: "memory");
    f32x4 br[4], bi[4];
#pragma unroll
    for (int q = 0; q < 4; ++q) { br[q] = *(const LAS f32x4*)(buf + lane * 20 + 4 * q); bi[q] = *(const LAS f32x4*)(buf + (64 + lane) * 20 + 4 * q); }
    float hre[16], him[16];
#pragma unroll
    for (int il = 0; il < 16; ++il) { const float nr = a.x * hr - a.y * hi + br[il >> 2][il & 3], ni = a.x * hi + a.y * hr + bi[il >> 2][il & 3]; hr = nr; hi = ni; hre[il] = hr; him[il] = hi; }
    if (OUT) {
        v4u w0, w1;
        w0.x = cvtpk_c(hre[0], hre[1]); w0.y = cvtpk_c(hre[2], hre[3]); w0.z = cvtpk_c(hre[4], hre[5]); w0.w = cvtpk_c(hre[6], hre[7]);
        w1.x = cvtpk_c(hre[8], hre[9]); w1.y = cvtpk_c(hre[10], hre[11]); w1.z = cvtpk_c(hre[12], hre[13]); w1.w = cvtpk_c(hre[14], hre[15]);
        *(LAS v4u*)(hT + lane * 48) = w0; *(LAS v4u*)(hT + lane * 48 + 16) = w1;
        w0.x = cvtpk_c(him[0], him[1]); w0.y = cvtpk_c(him[2], him[3]); w0.z = cvtpk_c(him[4], him[5]); w0.w = cvtpk_c(him[6], him[7]);
        w1.x = cvtpk_c(him[8], him[9]); w1.y = cvtpk_c(him[10], him[11]); w1.z = cvtpk_c(him[12], him[13]); w1.w = cvtpk_c(him[14], him[15]);
        *(LAS v4u*)(hT + (64 + lane) * 48) = w0; *(LAS v4u*)(hT + (64 + lane) * 48 + 16) = w1;
        asm volatile("" ::: "memory");
        f32x4 acc = {0.f, 0.f, 0.f, 0.f};
#pragma unroll
        for (int ks = 0; ks < 4; ++ks) {
            const s16x4 lo = ds_tr(hT + (32 * ks + 8 * fq + (fr >> 2)) * 48 + 8 * (fr & 3)), hi4 = ds_tr(hT + (32 * ks + 8 * fq + 4 + (fr >> 2)) * 48 + 8 * (fr & 3));
            const bf16x8 bfrag = __builtin_shufflevector(lo, hi4, 0, 1, 2, 3, 4, 5, 6, 7);
            acc = MFMA16(cbf[ks], bfrag, acc); }
        { const int i = 16 * ib + fr, t = d ? 63 - i : i; LAS f32x4* yp = (LAS f32x4*)(yb + t * 16 + 4 * fq); *yp = *yp + acc; }
        asm volatile("" ::: "memory");
    }
}
__device__ __forceinline__ void s5_load_bbf(const Frame& F, int dg, int lane, s16x4k (&bbf)[8]) {
    const bf16* bbt = TABP(bf16, TAB_BBT) + (size_t)dg * 2048;
#pragma unroll
    for (int nt = 0; nt < 8; ++nt) bbf[nt] = *(const s16x4k*)(bbt + (16 * nt + (lane & 15)) * 16 + 4 * (lane >> 4));
}
__device__ __forceinline__ void s5a_group(Frame& F, int g, int q0, int nq, int mbase, int nw, int wv, int mlim) {
    if (wv < 0) return;
    LAS float* buf = (LAS float*)(F.lds + F.wave * 12288); LAS unsigned* ubw = (LAS unsigned*)(F.lds + F.wave * 12288 + S5_BUF_BYTES);
    const bf16x8 cdummy[4] = {};
    s16x4k bbf0[8], bbf1[8]; s5_load_bbf(F, g, F.lane, bbf0); s5_load_bbf(F, 32 + g, F.lane, bbf1);
    const f32x2 a0 = TABP(f32x2, TAB_ABAR)[g * 64 + F.lane], a1 = TABP(f32x2, TAB_ABAR)[(32 + g) * 64 + F.lane];
    auto unit_of = [&](int m) { return m < mlim ? 8 * q0 + (m & 7) + 8 * nq * (m >> 3) : 2 * NCH; };
    auto urow = [&](int un) { const int b = un / NCH, ch = un % NCH, r0 = ch < 4 ? T + b * LCTX + ch * CHK : b * SEQ + (ch - 4) * CHK; return WSP(bf16, WS_U) + (size_t)(r0 + F.lane) * 512 + g * 16; };
    v4u n0 = {0u, 0u, 0u, 0u}, n1 = n0;
    { const int un0 = unit_of(mbase + wv); if (un0 < 2 * NCH) { const bf16* src = urow(un0); n0 = *(const v4u*)src; n1 = *(const v4u*)(src + 8); } }
    for (int m = mbase + wv; unit_of(m) < 2 * NCH; m += nw) {
        const int un = unit_of(m), unn = unit_of(m + nw);
        const int b = un / NCH, ch = un % NCH;
        *(LAS v4u*)(ubw + F.lane * 8) = n0; *(LAS v4u*)(ubw + F.lane * 8 + 4) = n1;
        if (unn < 2 * NCH) { const bf16* src = urow(unn); n0 = *(const v4u*)src; n1 = *(const v4u*)(src + 8); }
        asm volatile("" ::: "memory");
        { float hr = 0.f, hi = 0.f;
          for (int ib = 0; ib < 4; ++ib) s5_block<false>(buf, nullptr, ubw, bbf0, cdummy, a0, hr, hi, 0, ib, F.lane, nullptr);
          DOP(f32x2, DO_EH)[(size_t)(((0 * 2 + b) * NCH + ch) * 32 + g) * 64 + F.lane] = (f32x2){hr, hi}; }
        { float hr = 0.f, hi = 0.f;
          for (int ib = 0; ib < 4; ++ib) s5_block<false>(buf, nullptr, ubw, bbf1, cdummy, a1, hr, hi, 1, ib, F.lane, nullptr);
          DOP(f32x2, DO_EH)[(size_t)(((1 * 2 + b) * NCH + ch) * 32 + g) * 64 + F.lane] = (f32x2){hr, hi}; }
        LDS_WAIT(); asm volatile("" ::: "memory");
    }
}
__device__ __forceinline__ void s5_state_scan(Frame& F, int sidx) {
    if (sidx < 16) {
        const int idx = sidx * NTHR + F.tid, d = idx >> 12, b = (idx >> 11) & 1, g = (idx >> 6) & 31, p = idx & 63;
        const f32x2 a64 = TABP(f32x2, TAB_A64)[(d * 32 + g) * 64 + p];
        f32x2* base = DOP(f32x2, DO_EH) + (size_t)((d * 2 + b) * NCH) * 2048 + g * 64 + p;
        float hr = 0.f, hi = 0.f;
        for (int kb = 0; kb < NCH; kb += 12) { f32x2 e[12];
#pragma unroll
            for (int j = 0; j < 12; ++j) { const int k = kb + j, ch = d == 0 ? k : (k < 4 ? 3 - k : 135 - k); e[j] = base[(size_t)ch * 2048]; }
#pragma unroll
            for (int j = 0; j < 12; ++j) { const int k = kb + j, ch = d == 0 ? k : (k < 4 ? 3 - k : 135 - k); base[(size_t)ch * 2048] = (f32x2){hr, hi};
                const float nr = a64.x * hr - a64.y * hi + e[j].x, ni = a64.x * hi + a64.y * hr + e[j].y; hr = nr; hi = ni; } }
    }
}
constexpr int SB_KP = 0, SB_QP = 16384, SB_TP = 32768, SB_AP = 40960, SB_V = 49152, SB_SC = 53248, SB_SIZE = 54272;
constexpr int XS_OFF = 2 * SB_SIZE, XB_OFF = XS_OFF + 16384, OST_OFF = XB_OFF + 4096, FLG_OFF = OST_OFF + 8192;
static_assert(FLG_OFF + 16 <= RING_BYTES, "scan LDS");
__device__ __forceinline__ bf16x8 packB(const f32x4 a, const f32x4 b) {
    v4u o; o.x = cvtpk_c(a[0], a[1]); o.y = cvtpk_c(a[2], a[3]); o.z = cvtpk_c(b[0], b[1]); o.w = cvtpk_c(b[2], b[3]);
    return __builtin_bit_cast(bf16x8, o);
}
struct ScanStep { bool ctx; int cc; const unsigned char *qimg, *kimg, *vrow, *ta, *sc; };
__device__ __forceinline__ ScanStep scan_step(const Frame& F, int step, int d, int bh) {
    ScanStep s; s.ctx = step < 4; s.cc = s.ctx ? (d ? 3 - step : step) : (d ? 131 - step : step - 4); const int ch132 = s.ctx ? s.cc : 4 + s.cc;
    const bf16* base = s.ctx ? WSP(bf16, WS_QKVC) : WSP(bf16, WS_QKV); const int Lx = s.ctx ? LCTX : SEQ;
    s.qimg = (const unsigned char*)(base + ((size_t)(bh) * Lx + s.cc * CHK) * 128); s.kimg = (const unsigned char*)(base + ((size_t)(16 + bh) * Lx + s.cc * CHK) * 128);
    s.vrow = (const unsigned char*)(base + ((size_t)(32 + bh) * Lx + s.cc * CHK) * 128);
    s.ta = (const unsigned char*)(s.ctx ? WSP(bf16, WS_CTXTA) + (size_t)(bh * 4 + s.cc) * 8192 : WSP(bf16, WS_TA) + (size_t)(bh * NCHL + s.cc) * 8192);
    s.sc = (const unsigned char*)(DOP(float, DO_SC) + (size_t)(((d * 2 + (bh >> 3)) * 8 + (bh & 7)) * NCH + ch132) * SCBLK);
    return s;
}
#define SCAN_BAR() do { asm volatile("s_waitcnt lgkmcnt(0)" ::: "memory"); __builtin_amdgcn_s_barrier(); asm volatile("" ::: "memory"); } while (0)
#define GLDS16(gp, lp) __builtin_amdgcn_global_load_lds((const unsigned*)(gp), (LAS unsigned*)(lp), 16, 0, 0)
template <int LW> __device__ __forceinline__ void dma_issue(const ScanStep& s, LAS unsigned char* B, int pair, int lane) {
    if (LW == 0) {
#pragma unroll
        for (int u = 0; u < 16; ++u) GLDS16(s.kimg + u * 1024 + lane * 16, B + SB_KP + u * 1024);
    } else if (LW == 1) {
        if (!s.ctx) {
#pragma unroll
            for (int u = 0; u < 16; ++u) GLDS16(s.qimg + u * 1024 + lane * 16, B + SB_QP + u * 1024);
        }
    } else if (LW == 2) {
#pragma unroll
        for (int u = 0; u < 8; ++u) GLDS16(s.ta + u * 1024 + lane * 16, B + SB_TP + u * 1024);
        if (!s.ctx) {
#pragma unroll
            for (int u = 0; u < 8; ++u) GLDS16(s.ta + 8192 + u * 1024 + lane * 16, B + SB_AP + u * 1024);
        }
    } else {
#pragma unroll
        for (int u = 0; u < 4; ++u) GLDS16(s.vrow + (16 * u + (lane >> 2)) * 256 + pair * 64 + (lane & 3) * 16, B + SB_V + u * 1024);
        GLDS16(s.sc + lane * 16, B + SB_SC);
    }
}
__device__ __forceinline__ void ost_store(Frame& F, int d, int bh, int pair, int step, int lane) {
    const int cc = d ? 131 - step : step - 4, b = bh >> 3, h = bh & 7;
    bf16* ob = WSP(bf16, WS_ODIR) + ((size_t)d * T + b * SEQ + cc * CHK) * 1024 + h * 128 + pair * 32;
#pragma unroll
    for (int u = 0; u < 4; ++u) { const v4u v = *(const LAS v4u*)(F.lds + OST_OFF + (step & 1) * 4096 + u * 1024 + lane * 16); *(v4u*)(ob + (size_t)(16 * u + (lane >> 2)) * 1024 + (lane & 3) * 8) = v; }
}
template <int LW> __device__ __forceinline__ void scan_dma(Frame& F, int d, int bh, int pair, int probe) {
    const int lane = F.lane;
    if ((probe & 512) && LW != 0) { for (int i = 0; i <= NCH; ++i) SCAN_BAR(); return; }
    if ((probe & 1024) && (LW == 1 || LW == 3)) { for (int i = 0; i <= NCH; ++i) SCAN_BAR(); return; }
    { const ScanStep s0 = scan_step(F, 0, d, bh); dma_issue<LW>(s0, F.lds, pair, lane); }
    asm volatile("s_waitcnt vmcnt(0)" ::: "memory");
    SCAN_BAR();
    for (int step = 0; step < NCH; ++step) {
        if (LW == 3 && step >= 5 && !(probe & 32)) ost_store(F, d, bh, pair, step - 1, lane);
        if (step + 1 < NCH) { const ScanStep s1 = scan_step(F, step + 1, d, bh); dma_issue<LW>(s1, F.lds + ((step + 1) & 1) * SB_SIZE, pair, lane); }
        asm volatile("s_waitcnt vmcnt(0)" ::: "memory");
        SCAN_BAR();
    }
    if (LW == 3 && !(probe & 32)) ost_store(F, d, bh, pair, NCH - 1, lane);
}
struct FragMask { unsigned keep[2][4], diag[2][4]; };
template <int D, bool STRICT> __device__ __forceinline__ FragMask frag_mask(int fr, int fq) {
    FragMask M;
#pragma unroll
    for (int h = 0; h < 2; ++h)
#pragma unroll
        for (int w = 0; w < 4; ++w) { unsigned k = 0u, dg = 0u;
#pragma unroll
            for (int e = 0; e < 2; ++e) { const int jj = 2 * w + e, irel = 16 * h + fr, jrel = 16 * (jj >> 2) + 4 * fq + (jj & 3);
                const bool kp = STRICT ? (D == 0 ? irel > jrel : irel < jrel) : (D == 0 ? irel >= jrel : irel <= jrel);
                k |= kp ? (0xffffu << (16 * e)) : 0u; dg |= (STRICT && irel == jrel) ? (0x3f80u << (16 * e)) : 0u; }
            M.keep[h][w] = k; M.diag[h][w] = dg; }
    return M;
}
__device__ __forceinline__ bf16x8 apply_mask(const bf16x8 f, const unsigned (&keep)[4], const unsigned (&diag)[4]) {
    v4u v = __builtin_bit_cast(v4u, f); v.x = (v.x & keep[0]) | diag[0]; v.y = (v.y & keep[1]) | diag[1]; v.z = (v.z & keep[2]) | diag[2]; v.w = (v.w & keep[3]) | diag[3];
    return __builtin_bit_cast(bf16x8, v);
}
template <int D> __device__ __forceinline__ constexpr int frag_kind(int mt, int ks) { return ks == (mt >> 1) ? 2 : ((ks > (mt >> 1)) == (D == 1) ? 1 : 0); }
template <int D> __device__ __forceinline__ void scan_chain(Frame& F, int slice) {
    const int lane = F.lane, fr = lane & 15, fq = lane >> 4;
    f32x4 Sacc[8]; bf16x8 Sb[4];
#pragma unroll
    for (int m = 0; m < 8; ++m) Sacc[m] = (f32x4){0.f, 0.f, 0.f, 0.f};
#pragma unroll
    for (int k = 0; k < 4; ++k) Sb[k] = (bf16x8){0, 0, 0, 0, 0, 0, 0, 0};
    LAS unsigned char* xs = F.lds + XS_OFF + slice * 8192; LAS unsigned char* xb = F.lds + XB_OFF + slice * 2048;
    volatile LAS unsigned* flg = (volatile LAS unsigned*)(F.lds + FLG_OFF + slice * 8);
    if (lane == 0) *flg = 0u;
    const FragMask TM = frag_mask<D, true>(fr, fq);
    SCAN_BAR();
    for (int step = 0; step < NCH; ++step) {
        const LAS unsigned char* B = F.lds + (step & 1) * SB_SIZE;
        bf16x8 fk[16], ft[8];
#pragma unroll
        for (int ks = 0; ks < 4; ++ks)
#pragma unroll
            for (int mt = 0; mt < 4; ++mt) fk[ks * 4 + mt] = *(const LAS bf16x8*)(B + SB_KP + off256(16 * mt + fr, 4 * ks + fq));
        f32x4 bg4[4], ee4[4], be4[4]; s16x4 vv[4];
#pragma unroll
        for (int mt = 0; mt < 4; ++mt) { const int i0 = 16 * mt + 4 * fq;
            bg4[mt] = *(const LAS f32x4*)(B + SB_SC + i0 * 4); ee4[mt] = *(const LAS f32x4*)(B + SB_SC + 256 + i0 * 4); be4[mt] = *(const LAS f32x4*)(B + SB_SC + 768 + i0 * 4);
            vv[mt] = ds_tr(B + SB_V + (16 * mt + 4 * fq + (fr >> 2)) * 64 + slice * 32 + 8 * (fr & 3)); }
#pragma unroll
        for (int mt = 0; mt < 4; ++mt)
#pragma unroll
            for (int ks = 0; ks < 2; ++ks) if (frag_kind<D>(mt, ks) != 0) ft[2 * mt + ks] = *(const LAS bf16x8*)(B + SB_TP + off128(16 * mt + fr, 4 * ks + fq));
        const float ae = *(const LAS float*)(B + SB_SC + 512 + (D ? 0 : 63) * 4);
        const f32x4 z4 = {0.f, 0.f, 0.f, 0.f};
        f32x4 R[4] = {z4, z4, z4, z4};
#pragma unroll
        for (int ks = 0; ks < 4; ++ks)
#pragma unroll
            for (int mt = 0; mt < 4; ++mt) R[mt] = MFMA16(fk[ks * 4 + mt], Sb[ks], R[mt]);
        __builtin_amdgcn_sched_barrier(0);
        s16x4 tl[16], th[16];
#pragma unroll
        for (int m = 0; m < 8; ++m)
#pragma unroll
            for (int ks = 0; ks < 2; ++ks) {
                tl[m * 2 + ks] = ds_tr(B + SB_KP + off256(32 * ks + 4 * fq + (fr >> 2), 4 * (m >> 1) + (fr & 3)) + 8 * (m & 1));
                th[m * 2 + ks] = ds_tr(B + SB_KP + off256(32 * ks + 16 + 4 * fq + (fr >> 2), 4 * (m >> 1) + (fr & 3)) + 8 * (m & 1)); }
        f32x4 rhs[4];
#pragma unroll
        for (int mt = 0; mt < 4; ++mt) { const f32x4 vf = {bf2f((unsigned short)vv[mt][0]), bf2f((unsigned short)vv[mt][1]), bf2f((unsigned short)vv[mt][2]), bf2f((unsigned short)vv[mt][3])};
            rhs[mt] = be4[mt] * vf - bg4[mt] * R[mt]; }
        const bf16x8 RB0 = packB(rhs[0], rhs[1]), RB1 = packB(rhs[2], rhs[3]);
        f32x4 VN[4] = {z4, z4, z4, z4};
#pragma unroll
        for (int mt = 0; mt < 4; ++mt)
#pragma unroll
            for (int ks = 0; ks < 2; ++ks) {
                const int kind = frag_kind<D>(mt, ks);
                if (kind == 1) VN[mt] = MFMA16(ft[2 * mt + ks], ks == 0 ? RB0 : RB1, VN[mt]);
                else if (kind == 2) VN[mt] = MFMA16(apply_mask(ft[2 * mt + ks], TM.keep[mt & 1], TM.diag[mt & 1]), ks == 0 ? RB0 : RB1, VN[mt]); }
        const bf16x8 VS0 = packB(ee4[0] * VN[0], ee4[1] * VN[1]), VS1 = packB(ee4[2] * VN[2], ee4[3] * VN[3]);
        const bf16x8 VB0 = packB(VN[0], VN[1]), VB1 = packB(VN[2], VN[3]);
        *(LAS bf16x8*)(xb + lane * 16) = VB0; *(LAS bf16x8*)(xb + 1024 + lane * 16) = VB1;
        asm volatile("" ::: "memory");
        if (lane == 0) *flg = (unsigned)(step + 1);
        asm volatile("" ::: "memory");
#pragma unroll
        for (int m = 0; m < 8; ++m) { Sacc[m] = Sacc[m] * ae;
#pragma unroll
            for (int ks = 0; ks < 2; ++ks) { const bf16x8 a = __builtin_shufflevector(tl[m * 2 + ks], th[m * 2 + ks], 0, 1, 2, 3, 4, 5, 6, 7);
                Sacc[m] = MFMA16(a, ks == 0 ? VS0 : VS1, Sacc[m]); } }
#pragma unroll
        for (int k = 0; k < 4; ++k) { Sb[k] = packB(Sacc[2 * k], Sacc[2 * k + 1]); *(LAS bf16x8*)(xs + ((step + 1) & 1) * 4096 + k * 1024 + lane * 16) = Sb[k]; }
        SCAN_BAR();
    }
}
template <int D> __device__ __forceinline__ void scan_out(Frame& F, int bh, int pair, int slice, bool nostore) {
    const int lane = F.lane, fr = lane & 15, fq = lane >> 4, b = bh >> 3, h = bh & 7;
    const LAS unsigned char* xs = F.lds + XS_OFF + slice * 8192; const LAS unsigned char* xb = F.lds + XB_OFF + slice * 2048;
    volatile LAS unsigned* flg = (volatile LAS unsigned*)(F.lds + FLG_OFF + slice * 8);
    const FragMask AM = frag_mask<D, false>(fr, fq);
    SCAN_BAR();
    for (int step = 0; step < 4; ++step) SCAN_BAR();
    for (int step = 4; step < NCH; ++step) {
        const LAS unsigned char* B = F.lds + (step & 1) * SB_SIZE;
        bf16x8 fqv[16], fa[8], sb[4]; f32x4 eG4[4];
#pragma unroll
        for (int k = 0; k < 4; ++k) sb[k] = *(const LAS bf16x8*)(xs + (step & 1) * 4096 + k * 1024 + lane * 16);
#pragma unroll
        for (int ks = 0; ks < 4; ++ks)
#pragma unroll
            for (int mt = 0; mt < 4; ++mt) fqv[ks * 4 + mt] = *(const LAS bf16x8*)(B + SB_QP + off256(16 * mt + fr, 4 * ks + fq));
#pragma unroll
        for (int mt = 0; mt < 4; ++mt) {
#pragma unroll
            for (int ks = 0; ks < 2; ++ks) if (frag_kind<D>(mt, ks) != 0) fa[2 * mt + ks] = *(const LAS bf16x8*)(B + SB_AP + off128(16 * mt + fr, 4 * ks + fq));
            eG4[mt] = *(const LAS f32x4*)(B + SB_SC + 512 + (16 * mt + 4 * fq) * 4); }
        const f32x4 z4 = {0.f, 0.f, 0.f, 0.f};
        f32x4 QS[4] = {z4, z4, z4, z4};
#pragma unroll
        for (int ks = 0; ks < 4; ++ks)
#pragma unroll
            for (int mt = 0; mt < 4; ++mt) QS[mt] = MFMA16(fqv[ks * 4 + mt], sb[ks], QS[mt]);
#pragma unroll
        for (int mt = 0; mt < 4; ++mt) QS[mt] = QS[mt] * eG4[mt];
        while (*flg < (unsigned)(step + 1)) __builtin_amdgcn_s_sleep(1);
        asm volatile("" ::: "memory");
        const bf16x8 VB0 = *(const LAS bf16x8*)(xb + lane * 16), VB1 = *(const LAS bf16x8*)(xb + 1024 + lane * 16);
#pragma unroll
        for (int mt = 0; mt < 4; ++mt) { f32x4 O = QS[mt];
#pragma unroll
            for (int ks = 0; ks < 2; ++ks) { const int kind = frag_kind<D>(mt, ks);
                if (kind == 1) O = MFMA16(fa[2 * mt + ks], ks == 0 ? VB0 : VB1, O);
                else if (kind == 2) { const unsigned zero4[4] = {0u, 0u, 0u, 0u}; O = MFMA16(apply_mask(fa[2 * mt + ks], AM.keep[mt & 1], zero4), ks == 0 ? VB0 : VB1, O); } }
#pragma unroll
            for (int r = 0; r < 4; ++r) { const int i = 16 * mt + 4 * fq + r; *(LAS unsigned short*)(F.lds + OST_OFF + (step & 1) * 4096 + i * 64 + (slice * 16 + fr) * 2) = (unsigned short)f2bf(O[r]); } }
        SCAN_BAR();
    }
}
__device__ __forceinline__ void phase5b(Frame& F, int probe) {
    if ((probe & 64) && F.wave < 4) { for (int i = 0; i <= NCH; ++i) SCAN_BAR(); return; }
    if ((probe & 32) && F.wave >= 4) { for (int i = 0; i <= NCH; ++i) SCAN_BAR(); return; }
    const int seqid = F.vcu >> 3, pair = F.vcu & 3, d = seqid >> 4, bh = seqid & 15;
    const bool ns = (probe & 32) != 0;
    switch (F.wave) {
        case 0: case 1: if (d) scan_chain<1>(F, F.wave); else scan_chain<0>(F, F.wave); break;
        case 2: case 3: if (d) scan_out<1>(F, bh, pair, F.wave - 2, ns); else scan_out<0>(F, bh, pair, F.wave - 2, ns); break;
        case 4: scan_dma<0>(F, d, bh, pair, probe); break;
        case 5: scan_dma<1>(F, d, bh, pair, probe); break;
        case 6: scan_dma<2>(F, d, bh, pair, probe); break;
        default: scan_dma<3>(F, d, bh, pair, probe); break;
    }
}
constexpr int PP_PITCH = 68, PP_BYTES = 64 * PP_PITCH * 4, PP_GOFF = 4 * PP_BYTES;
struct PrepUnit { const bf16 *kbase, *qbase; int rowbase, ch132, b, h; bf16* ta; };
__device__ __forceinline__ PrepUnit prep_unit(const Frame& F, int uid) {
    PrepUnit u; const bool ctx = uid < 64; const int v = ctx ? uid : uid - 64;
    const int bh = ctx ? (v >> 2) : (v >> 7), cc = ctx ? (v & 3) : (v & 127); u.b = bh >> 3; u.h = bh & 7;
    u.kbase = ctx ? WSP(bf16, WS_QKVC) + ((size_t)(16 + bh) * LCTX + cc * CHK) * 128 : WSP(bf16, WS_QKV) + ((size_t)(16 + bh) * SEQ + cc * CHK) * 128;
    u.qbase = ctx ? WSP(bf16, WS_QKVC) + ((size_t)(bh) * LCTX + cc * CHK) * 128 : WSP(bf16, WS_QKV) + ((size_t)(bh) * SEQ + cc * CHK) * 128;
    u.rowbase = ctx ? T + u.b * LCTX + cc * CHK : u.b * SEQ + cc * CHK; u.ch132 = ctx ? cc : 4 + cc;
    u.ta = ctx ? WSP(bf16, WS_CTXTA) + (size_t)v * 8192 : WSP(bf16, WS_TA) + (size_t)v * 8192;
    return u;
}
template <int M> __device__ __forceinline__ void fmac_chunk(float (&s)[4], float t, const float* x) {
    if constexpr (M == 1) asm("v_fmac_f32_dpp %0, %4, %5 row_newbcast:0 row_mask:0xf bank_mask:0xf" : "+v"(s[0]), "+v"(s[1]), "+v"(s[2]), "+v"(s[3]) : "v"(t), "v"(x[0]));
    if constexpr (M == 2) asm("v_fmac_f32_dpp %0, %4, %5 row_newbcast:0 row_mask:0xf bank_mask:0xf\n\tv_fmac_f32_dpp %1, %4, %6 row_newbcast:1 row_mask:0xf bank_mask:0xf" : "+v"(s[0]), "+v"(s[1]), "+v"(s[2]), "+v"(s[3]) : "v"(t), "v"(x[0]), "v"(x[1]));
    if constexpr (M == 3) asm("v_fmac_f32_dpp %0, %4, %5 row_newbcast:0 row_mask:0xf bank_mask:0xf\n\tv_fmac_f32_dpp %1, %4, %6 row_newbcast:1 row_mask:0xf bank_mask:0xf\n\tv_fmac_f32_dpp %2, %4, %7 row_newbcast:2 row_mask:0xf bank_mask:0xf" : "+v"(s[0]), "+v"(s[1]), "+v"(s[2]), "+v"(s[3]) : "v"(t), "v"(x[0]), "v"(x[1]), "v"(x[2]));
    if constexpr (M == 4) asm("v_fmac_f32_dpp %0, %4, %5 row_newbcast:0 row_mask:0xf bank_mask:0xf\n\tv_fmac_f32_dpp %1, %4, %6 row_newbcast:1 row_mask:0xf bank_mask:0xf\n\tv_fmac_f32_dpp %2, %4, %7 row_newbcast:2 row_mask:0xf bank_mask:0xf\n\tv_fmac_f32_dpp %3, %4, %8 row_newbcast:3 row_mask:0xf bank_mask:0xf" : "+v"(s[0]), "+v"(s[1]), "+v"(s[2]), "+v"(s[3]) : "v"(t), "v"(x[0]), "v"(x[1]), "v"(x[2]), "v"(x[3]));
    if constexpr (M == 5) asm("v_fmac_f32_dpp %0, %4, %5 row_newbcast:0 row_mask:0xf bank_mask:0xf\n\tv_fmac_f32_dpp %1, %4, %6 row_newbcast:1 row_mask:0xf bank_mask:0xf\n\tv_fmac_f32_dpp %2, %4, %7 row_newbcast:2 row_mask:0xf bank_mask:0xf\n\tv_fmac_f32_dpp %3, %4, %8 row_newbcast:3 row_mask:0xf bank_mask:0xf\n\tv_fmac_f32_dpp %0, %4, %9 row_newbcast:4 row_mask:0xf bank_mask:0xf" : "+v"(s[0]), "+v"(s[1]), "+v"(s[2]), "+v"(s[3]) : "v"(t), "v"(x[0]), "v"(x[1]), "v"(x[2]), "v"(x[3]), "v"(x[4]));
    if constexpr (M == 6) asm("v_fmac_f32_dpp %0, %4, %5 row_newbcast:0 row_mask:0xf bank_mask:0xf\n\tv_fmac_f32_dpp %1, %4, %6 row_newbcast:1 row_mask:0xf bank_mask:0xf\n\tv_fmac_f32_dpp %2, %4, %7 row_newbcast:2 row_mask:0xf bank_mask:0xf\n\tv_fmac_f32_dpp %3, %4, %8 row_newbcast:3 row_mask:0xf bank_mask:0xf\n\tv_fmac_f32_dpp %0, %4, %9 row_newbcast:4 row_mask:0xf bank_mask:0xf\n\tv_fmac_f32_dpp %1, %4, %10 row_newbcast:5 row_mask:0xf bank_mask:0xf" : "+v"(s[0]), "+v"(s[1]), "+v"(s[2]), "+v"(s[3]) : "v"(t), "v"(x[0]), "v"(x[1]), "v"(x[2]), "v"(x[3]), "v"(x[4]), "v"(x[5]));
    if constexpr (M == 7) asm("v_fmac_f32_dpp %0, %4, %5 row_newbcast:0 row_mask:0xf bank_mask:0xf\n\tv_fmac_f32_dpp %1, %4, %6 row_newbcast:1 row_mask:0xf bank_mask:0xf\n\tv_fmac_f32_dpp %2, %4, %7 row_newbcast:2 row_mask:0xf bank_mask:0xf\n\tv_fmac_f32_dpp %3, %4, %8 row_newbcast:3 row_mask:0xf bank_mask:0xf\n\tv_fmac_f32_dpp %0, %4, %9 row_newbcast:4 row_mask:0xf bank_mask:0xf\n\tv_fmac_f32_dpp %1, %4, %10 row_newbcast:5 row_mask:0xf bank_mask:0xf\n\tv_fmac_f32_dpp %2, %4, %11 row_newbcast:6 row_mask:0xf bank_mask:0xf" : "+v"(s[0]), "+v"(s[1]), "+v"(s[2]), "+v"(s[3]) : "v"(t), "v"(x[0]), "v"(x[1]), "v"(x[2]), "v"(x[3]), "v"(x[4]), "v"(x[5]), "v"(x[6]));
    if constexpr (M == 8) asm("v_fmac_f32_dpp %0, %4, %5 row_newbcast:0 row_mask:0xf bank_mask:0xf\n\tv_fmac_f32_dpp %1, %4, %6 row_newbcast:1 row_mask:0xf bank_mask:0xf\n\tv_fmac_f32_dpp %2, %4, %7 row_newbcast:2 row_mask:0xf bank_mask:0xf\n\tv_fmac_f32_dpp %3, %4, %8 row_newbcast:3 row_mask:0xf bank_mask:0xf\n\tv_fmac_f32_dpp %0, %4, %9 row_newbcast:4 row_mask:0xf bank_mask:0xf\n\tv_fmac_f32_dpp %1, %4, %10 row_newbcast:5 row_mask:0xf bank_mask:0xf\n\tv_fmac_f32_dpp %2, %4, %11 row_newbcast:6 row_mask:0xf bank_mask:0xf\n\tv_fmac_f32_dpp %3, %4, %12 row_newbcast:7 row_mask:0xf bank_mask:0xf" : "+v"(s[0]), "+v"(s[1]), "+v"(s[2]), "+v"(s[3]) : "v"(t), "v"(x[0]), "v"(x[1]), "v"(x[2]), "v"(x[3]), "v"(x[4]), "v"(x[5]), "v"(x[6]), "v"(x[7]));
    if constexpr (M == 9) asm("v_fmac_f32_dpp %0, %4, %5 row_newbcast:0 row_mask:0xf bank_mask:0xf\n\tv_fmac_f32_dpp %1, %4, %6 row_newbcast:1 row_mask:0xf bank_mask:0xf\n\tv_fmac_f32_dpp %2, %4, %7 row_newbcast:2 row_mask:0xf bank_mask:0xf\n\tv_fmac_f32_dpp %3, %4, %8 row_newbcast:3 row_mask:0xf bank_mask:0xf\n\tv_fmac_f32_dpp %0, %4, %9 row_newbcast:4 row_mask:0xf bank_mask:0xf\n\tv_fmac_f32_dpp %1, %4, %10 row_newbcast:5 row_mask:0xf bank_mask:0xf\n\tv_fmac_f32_dpp %2, %4, %11 row_newbcast:6 row_mask:0xf bank_mask:0xf\n\tv_fmac_f32_dpp %3, %4, %12 row_newbcast:7 row_mask:0xf bank_mask:0xf\n\tv_fmac_f32_dpp %0, %4, %13 row_newbcast:8 row_mask:0xf bank_mask:0xf" : "+v"(s[0]), "+v"(s[1]), "+v"(s[2]), "+v"(s[3]) : "v"(t), "v"(x[0]), "v"(x[1]), "v"(x[2]), "v"(x[3]), "v"(x[4]), "v"(x[5]), "v"(x[6]), "v"(x[7]), "v"(x[8]));
    if constexpr (M == 10) asm("v_fmac_f32_dpp %0, %4, %5 row_newbcast:0 row_mask:0xf bank_mask:0xf\n\tv_fmac_f32_dpp %1, %4, %6 row_newbcast:1 row_mask:0xf bank_mask:0xf\n\tv_fmac_f32_dpp %2, %4, %7 row_newbcast:2 row_mask:0xf bank_mask:0xf\n\tv_fmac_f32_dpp %3, %4, %8 row_newbcast:3 row_mask:0xf bank_mask:0xf\n\tv_fmac_f32_dpp %0, %4, %9 row_newbcast:4 row_mask:0xf bank_mask:0xf\n\tv_fmac_f32_dpp %1, %4, %10 row_newbcast:5 row_mask:0xf bank_mask:0xf\n\tv_fmac_f32_dpp %2, %4, %11 row_newbcast:6 row_mask:0xf bank_mask:0xf\n\tv_fmac_f32_dpp %3, %4, %12 row_newbcast:7 row_mask:0xf bank_mask:0xf\n\tv_fmac_f32_dpp %0, %4, %13 row_newbcast:8 row_mask:0xf bank_mask:0xf\n\tv_fmac_f32_dpp %1, %4, %14 row_newbcast:9 row_mask:0xf bank_mask:0xf" : "+v"(s[0]), "+v"(s[1]), "+v"(s[2]), "+v"(s[3]) : "v"(t), "v"(x[0]), "v"(x[1]), "v"(x[2]), "v"(x[3]), "v"(x[4]), "v"(x[5]), "v"(x[6]), "v"(x[7]), "v"(x[8]), "v"(x[9]));
    if constexpr (M == 11) asm("v_fmac_f32_dpp %0, %4, %5 row_newbcast:0 row_mask:0xf bank_mask:0xf\n\tv_fmac_f32_dpp %1, %4, %6 row_newbcast:1 row_mask:0xf bank_mask:0xf\n\tv_fmac_f32_dpp %2, %4, %7 row_newbcast:2 row_mask:0xf bank_mask:0xf\n\tv_fmac_f32_dpp %3, %4, %8 row_newbcast:3 row_mask:0xf bank_mask:0xf\n\tv_fmac_f32_dpp %0, %4, %9 row_newbcast:4 row_mask:0xf bank_mask:0xf\n\tv_fmac_f32_dpp %1, %4, %10 row_newbcast:5 row_mask:0xf bank_mask:0xf\n\tv_fmac_f32_dpp %2, %4, %11 row_newbcast:6 row_mask:0xf bank_mask:0xf\n\tv_fmac_f32_dpp %3, %4, %12 row_newbcast:7 row_mask:0xf bank_mask:0xf\n\tv_fmac_f32_dpp %0, %4, %13 row_newbcast:8 row_mask:0xf bank_mask:0xf\n\tv_fmac_f32_dpp %1, %4, %14 row_newbcast:9 row_mask:0xf bank_mask:0xf\n\tv_fmac_f32_dpp %2, %4, %15 row_newbcast:10 row_mask:0xf bank_mask:0xf" : "+v"(s[0]), "+v"(s[1]), "+v"(s[2]), "+v"(s[3]) : "v"(t), "v"(x[0]), "v"(x[1]), "v"(x[2]), "v"(x[3]), "v"(x[4]), "v"(x[5]), "v"(x[6]), "v"(x[7]), "v"(x[8]), "v"(x[9]), "v"(x[10]));
    if constexpr (M == 12) asm("v_fmac_f32_dpp %0, %4, %5 row_newbcast:0 row_mask:0xf bank_mask:0xf\n\tv_fmac_f32_dpp %1, %4, %6 row_newbcast:1 row_mask:0xf bank_mask:0xf\n\tv_fmac_f32_dpp %2, %4, %7 row_newbcast:2 row_mask:0xf bank_mask:0xf\n\tv_fmac_f32_dpp %3, %4, %8 row_newbcast:3 row_mask:0xf bank_mask:0xf\n\tv_fmac_f32_dpp %0, %4, %9 row_newbcast:4 row_mask:0xf bank_mask:0xf\n\tv_fmac_f32_dpp %1, %4, %10 row_newbcast:5 row_mask:0xf bank_mask:0xf\n\tv_fmac_f32_dpp %2, %4, %11 row_newbcast:6 row_mask:0xf bank_mask:0xf\n\tv_fmac_f32_dpp %3, %4, %12 row_newbcast:7 row_mask:0xf bank_mask:0xf\n\tv_fmac_f32_dpp %0, %4, %13 row_newbcast:8 row_mask:0xf bank_mask:0xf\n\tv_fmac_f32_dpp %1, %4, %14 row_newbcast:9 row_mask:0xf bank_mask:0xf\n\tv_fmac_f32_dpp %2, %4, %15 row_newbcast:10 row_mask:0xf bank_mask:0xf\n\tv_fmac_f32_dpp %3, %4, %16 row_newbcast:11 row_mask:0xf bank_mask:0xf" : "+v"(s[0]), "+v"(s[1]), "+v"(s[2]), "+v"(s[3]) : "v"(t), "v"(x[0]), "v"(x[1]), "v"(x[2]), "v"(x[3]), "v"(x[4]), "v"(x[5]), "v"(x[6]), "v"(x[7]), "v"(x[8]), "v"(x[9]), "v"(x[10]), "v"(x[11]));
    if constexpr (M == 13) asm("v_fmac_f32_dpp %0, %4, %5 row_newbcast:0 row_mask:0xf bank_mask:0xf\n\tv_fmac_f32_dpp %1, %4, %6 row_newbcast:1 row_mask:0xf bank_mask:0xf\n\tv_fmac_f32_dpp %2, %4, %7 row_newbcast:2 row_mask:0xf bank_mask:0xf\n\tv_fmac_f32_dpp %3, %4, %8 row_newbcast:3 row_mask:0xf bank_mask:0xf\n\tv_fmac_f32_dpp %0, %4, %9 row_newbcast:4 row_mask:0xf bank_mask:0xf\n\tv_fmac_f32_dpp %1, %4, %10 row_newbcast:5 row_mask:0xf bank_mask:0xf\n\tv_fmac_f32_dpp %2, %4, %11 row_newbcast:6 row_mask:0xf bank_mask:0xf\n\tv_fmac_f32_dpp %3, %4, %12 row_newbcast:7 row_mask:0xf bank_mask:0xf\n\tv_fmac_f32_dpp %0, %4, %13 row_newbcast:8 row_mask:0xf bank_mask:0xf\n\tv_fmac_f32_dpp %1, %4, %14 row_newbcast:9 row_mask:0xf bank_mask:0xf\n\tv_fmac_f32_dpp %2, %4, %15 row_newbcast:10 row_mask:0xf bank_mask:0xf\n\tv_fmac_f32_dpp %3, %4, %16 row_newbcast:11 row_mask:0xf bank_mask:0xf\n\tv_fmac_f32_dpp %0, %4, %17 row_newbcast:12 row_mask:0xf bank_mask:0xf" : "+v"(s[0]), "+v"(s[1]), "+v"(s[2]), "+v"(s[3]) : "v"(t), "v"(x[0]), "v"(x[1]), "v"(x[2]), "v"(x[3]), "v"(x[4]), "v"(x[5]), "v"(x[6]), "v"(x[7]), "v"(x[8]), "v"(x[9]), "v"(x[10]), "v"(x[11]), "v"(x[12]));
    if constexpr (M == 14) asm("v_fmac_f32_dpp %0, %4, %5 row_newbcast:0 row_mask:0xf bank_mask:0xf\n\tv_fmac_f32_dpp %1, %4, %6 row_newbcast:1 row_mask:0xf bank_mask:0xf\n\tv_fmac_f32_dpp %2, %4, %7 row_newbcast:2 row_mask:0xf bank_mask:0xf\n\tv_fmac_f32_dpp %3, %4, %8 row_newbcast:3 row_mask:0xf bank_mask:0xf\n\tv_fmac_f32_dpp %0, %4, %9 row_newbcast:4 row_mask:0xf bank_mask:0xf\n\tv_fmac_f32_dpp %1, %4, %10 row_newbcast:5 row_mask:0xf bank_mask:0xf\n\tv_fmac_f32_dpp %2, %4, %11 row_newbcast:6 row_mask:0xf bank_mask:0xf\n\tv_fmac_f32_dpp %3, %4, %12 row_newbcast:7 row_mask:0xf bank_mask:0xf\n\tv_fmac_f32_dpp %0, %4, %13 row_newbcast:8 row_mask:0xf bank_mask:0xf\n\tv_fmac_f32_dpp %1, %4, %14 row_newbcast:9 row_mask:0xf bank_mask:0xf\n\tv_fmac_f32_dpp %2, %4, %15 row_newbcast:10 row_mask:0xf bank_mask:0xf\n\tv_fmac_f32_dpp %3, %4, %16 row_newbcast:11 row_mask:0xf bank_mask:0xf\n\tv_fmac_f32_dpp %0, %4, %17 row_newbcast:12 row_mask:0xf bank_mask:0xf\n\tv_fmac_f32_dpp %1, %4, %18 row_newbcast:13 row_mask:0xf bank_mask:0xf" : "+v"(s[0]), "+v"(s[1]), "+v"(s[2]), "+v"(s[3]) : "v"(t), "v"(x[0]), "v"(x[1]), "v"(x[2]), "v"(x[3]), "v"(x[4]), "v"(x[5]), "v"(x[6]), "v"(x[7]), "v"(x[8]), "v"(x[9]), "v"(x[10]), "v"(x[11]), "v"(x[12]), "v"(x[13]));
    if constexpr (M == 15) asm("v_fmac_f32_dpp %0, %4, %5 row_newbcast:0 row_mask:0xf bank_mask:0xf\n\tv_fmac_f32_dpp %1, %4, %6 row_newbcast:1 row_mask:0xf bank_mask:0xf\n\tv_fmac_f32_dpp %2, %4, %7 row_newbcast:2 row_mask:0xf bank_mask:0xf\n\tv_fmac_f32_dpp %3, %4, %8 row_newbcast:3 row_mask:0xf bank_mask:0xf\n\tv_fmac_f32_dpp %0, %4, %9 row_newbcast:4 row_mask:0xf bank_mask:0xf\n\tv_fmac_f32_dpp %1, %4, %10 row_newbcast:5 row_mask:0xf bank_mask:0xf\n\tv_fmac_f32_dpp %2, %4, %11 row_newbcast:6 row_mask:0xf bank_mask:0xf\n\tv_fmac_f32_dpp %3, %4, %12 row_newbcast:7 row_mask:0xf bank_mask:0xf\n\tv_fmac_f32_dpp %0, %4, %13 row_newbcast:8 row_mask:0xf bank_mask:0xf\n\tv_fmac_f32_dpp %1, %4, %14 row_newbcast:9 row_mask:0xf bank_mask:0xf\n\tv_fmac_f32_dpp %2, %4, %15 row_newbcast:10 row_mask:0xf bank_mask:0xf\n\tv_fmac_f32_dpp %3, %4, %16 row_newbcast:11 row_mask:0xf bank_mask:0xf\n\tv_fmac_f32_dpp %0, %4, %17 row_newbcast:12 row_mask:0xf bank_mask:0xf\n\tv_fmac_f32_dpp %1, %4, %18 row_newbcast:13 row_mask:0xf bank_mask:0xf\n\tv_fmac_f32_dpp %2, %4, %19 row_newbcast:14 row_mask:0xf bank_mask:0xf" : "+v"(s[0]), "+v"(s[1]), "+v"(s[2]), "+v"(s[3]) : "v"(t), "v"(x[0]), "v"(x[1]), "v"(x[2]), "v"(x[3]), "v"(x[4]), "v"(x[5]), "v"(x[6]), "v"(x[7]), "v"(x[8]), "v"(x[9]), "v"(x[10]), "v"(x[11]), "v"(x[12]), "v"(x[13]), "v"(x[14]));
    if constexpr (M == 16) asm("v_fmac_f32_dpp %0, %4, %5 row_newbcast:0 row_mask:0xf bank_mask:0xf\n\tv_fmac_f32_dpp %1, %4, %6 row_newbcast:1 row_mask:0xf bank_mask:0xf\n\tv_fmac_f32_dpp %2, %4, %7 row_newbcast:2 row_mask:0xf bank_mask:0xf\n\tv_fmac_f32_dpp %3, %4, %8 row_newbcast:3 row_mask:0xf bank_mask:0xf\n\tv_fmac_f32_dpp %0, %4, %9 row_newbcast:4 row_mask:0xf bank_mask:0xf\n\tv_fmac_f32_dpp %1, %4, %10 row_newbcast:5 row_mask:0xf bank_mask:0xf\n\tv_fmac_f32_dpp %2, %4, %11 row_newbcast:6 row_mask:0xf bank_mask:0xf\n\tv_fmac_f32_dpp %3, %4, %12 row_newbcast:7 row_mask:0xf bank_mask:0xf\n\tv_fmac_f32_dpp %0, %4, %13 row_newbcast:8 row_mask:0xf bank_mask:0xf\n\tv_fmac_f32_dpp %1, %4, %14 row_newbcast:9 row_mask:0xf bank_mask:0xf\n\tv_fmac_f32_dpp %2, %4, %15 row_newbcast:10 row_mask:0xf bank_mask:0xf\n\tv_fmac_f32_dpp %3, %4, %16 row_newbcast:11 row_mask:0xf bank_mask:0xf\n\tv_fmac_f32_dpp %0, %4, %17 row_newbcast:12 row_mask:0xf bank_mask:0xf\n\tv_fmac_f32_dpp %1, %4, %18 row_newbcast:13 row_mask:0xf bank_mask:0xf\n\tv_fmac_f32_dpp %2, %4, %19 row_newbcast:14 row_mask:0xf bank_mask:0xf\n\tv_fmac_f32_dpp %3, %4, %20 row_newbcast:15 row_mask:0xf bank_mask:0xf" : "+v"(s[0]), "+v"(s[1]), "+v"(s[2]), "+v"(s[3]) : "v"(t), "v"(x[0]), "v"(x[1]), "v"(x[2]), "v"(x[3]), "v"(x[4]), "v"(x[5]), "v"(x[6]), "v"(x[7]), "v"(x[8]), "v"(x[9]), "v"(x[10]), "v"(x[11]), "v"(x[12]), "v"(x[13]), "v"(x[14]), "v"(x[15]));
}
template <int DIR> __device__ __forceinline__ int eidx(int i, int j) { return DIR == 0 ? i * PP_PITCH + j : (63 - i) * PP_PITCH + (63 - j); }
template <int R> __device__ __forceinline__ void diag_row(float (&dg)[16], const float (&t)[16], int c) {
    float s[4] = {0.f, 0.f, 0.f, 0.f};
    if constexpr (R > 0) fmac_chunk<(R > 0 ? R : 1)>(s, t[R], dg);
    dg[R] = ((c == R) ? 1.f : 0.f) - ((s[0] + s[1]) + (s[2] + s[3]));
}
template <int... Rs> __device__ __forceinline__ void diag_rows(float (&dg)[16], const float (&t)[16], int c, std::integer_sequence<int, Rs...>) { (diag_row<Rs>(dg, t, c), ...); }
template <int DIR> __device__ __forceinline__ void prep_solve(LAS float* P, LAS float* S, int lane_) {
    int lane = lane_; asm volatile("" : "+v"(lane));
    const int q = lane >> 4, n = lane & 15;
    {
        LAS float* Bd = P + eidx<DIR>(16 * q, 16 * q + n); constexpr int RS = DIR == 0 ? PP_PITCH : -PP_PITCH;
        float t[16], dg[16];
#pragma unroll
        for (int r = 0; r < 16; ++r) t[r] = Bd[r * RS];
        diag_rows(dg, t, n, std::make_integer_sequence<int, 16>{});
#pragma unroll
        for (int r = 1; r < 16; ++r) if (n < r) Bd[r * RS] = dg[r];
    }
#pragma unroll
    for (int I = 1; I < 4; ++I) {
        f32x4 xs[3];
#pragma unroll
        for (int J = I - 1; J >= 0; --J) {
            f32x4 acc = {0.f, 0.f, 0.f, 0.f};
#pragma unroll
            for (int K = J; K < I; ++K)
#pragma unroll
                for (int ks = 0; ks < 4; ++ks) { const int kk = 4 * ks + q;
                    const float a = P[eidx<DIR>(16 * I + n, 16 * K + kk)];
                    float b = P[eidx<DIR>(16 * K + kk, 16 * J + n)];
                    if (K == J) b = n < kk ? b : (n == kk ? 1.f : 0.f);
                    acc = __builtin_amdgcn_mfma_f32_16x16x4f32(a, b, acc, 0, 0, 0); }
#pragma unroll
            for (int r = 0; r < 4; ++r) S[(4 * q + r) * 17 + n] = acc[r];
            f32x4 acc2 = {0.f, 0.f, 0.f, 0.f};
#pragma unroll
            for (int ks = 0; ks < 4; ++ks) { const int kk = 4 * ks + q;
                float a = P[eidx<DIR>(16 * I + n, 16 * I + kk)]; a = kk < n ? a : (kk == n ? 1.f : 0.f);
                acc2 = __builtin_amdgcn_mfma_f32_16x16x4f32(a, S[kk * 17 + n], acc2, 0, 0, 0); }
            xs[J] = -acc2;
        }
#pragma unroll
        for (int J = 0; J < I; ++J)
#pragma unroll
            for (int r = 0; r < 4; ++r) P[eidx<DIR>(16 * I + 4 * q + r, 16 * J + n)] = xs[J][r];
    }
}
__device__ __forceinline__ void prep_store(const LAS float* P, int half, int lane, bf16* ta) {
#pragma unroll
    for (int it = 0; it < 8; ++it) { const int row = half * 32 + it * 4 + (lane >> 4), g = lane & 15;
        f32x4 v = *(const LAS f32x4*)(P + row * PP_PITCH + 4 * g);
        if ((row >> 2) == g) v[row & 3] = 1.f;
        *(v2u*)((unsigned char*)ta + off128(row, 4 * (g >> 3) + (g & 3)) + 8 * ((g >> 2) & 1)) = (v2u){pk2(v[0], v[1]), pk2(v[2], v[3])}; }
}
__device__ __forceinline__ void conv_tile(Frame& F, int uid) {
    const float* cw = F.in[I_CONVW];
    const int lane = F.lane, tg = lane >> 4, c8 = lane & 15;
    {
        int which, bh, ck, Lx; const bf16* src; bf16* dst;
        if (uid < 192) { which = uid / 64; bh = (uid % 64) >> 2; ck = uid & 3; Lx = LCTX; src = WSP(bf16, WS_QKVC_RAW) + (size_t)((which * 16 + bh) * LCTX) * 128; dst = WSP(bf16, WS_QKVC) + (size_t)((which * 16 + bh) * LCTX) * 128; }
        else { const int v = uid - 192; which = v / (16 * NCHL); const int rem = v % (16 * NCHL); bh = rem / NCHL; ck = 0; Lx = CHK; bf16* p = WSP(bf16, WS_QKV) + ((size_t)(which * 16 + bh) * SEQ + (rem % NCHL) * CHK) * 128; src = p; dst = p; }
        const int h = bh & 7, ch0 = which * 1024 + h * 128 + c8 * 8, t0 = ck * 64 + tg * 16;
        float w[5][8];
#pragma unroll
        for (int j = 0; j < 5; ++j) { const f32x4 a = *(const f32x4*)(cw + j * 3072 + ch0), b2 = *(const f32x4*)(cw + j * 3072 + ch0 + 4);
            w[j][0] = a[0]; w[j][1] = a[1]; w[j][2] = a[2]; w[j][3] = a[3]; w[j][4] = b2[0]; w[j][5] = b2[1]; w[j][6] = b2[2]; w[j][7] = b2[3]; }
        v4u xr[20];
#pragma unroll
        for (int r = 0; r < 20; ++r) { const int t = t0 + r - 2; xr[r] = (t >= 0 && t < Lx) ? *(const v4u*)(src + (size_t)t * 128 + c8 * 8) : (v4u){0u, 0u, 0u, 0u}; }
        asm volatile("s_waitcnt vmcnt(0)" ::: "memory");
        float win[5][8];
#pragma unroll
        for (int r = 0; r < 4; ++r) unpack8(xr[r], win[r + 1]);
#pragma unroll
        for (int t = 0; t < 16; ++t) {
#pragma unroll
            for (int r = 0; r < 4; ++r)
#pragma unroll
                for (int e = 0; e < 8; ++e) win[r][e] = win[r + 1][e];
            unpack8(xr[t + 4], win[4]);
            float y[8]; float ss = 0.f;
#pragma unroll
            for (int e = 0; e < 8; ++e) { float a = w[0][e] * win[0][e]; a += w[1][e] * win[1][e]; a += w[2][e] * win[2][e]; a += w[3][e] * win[3][e]; a += w[4][e] * win[4][e]; y[e] = siluf_(a); ss += y[e] * y[e]; }
            if (which < 2) { ss = sum16(ss);
                const float sc = (__builtin_amdgcn_rsqf(ss + EPS)) * (which == 0 ? 0.08838834764831845f : 1.f);
#pragma unroll
                for (int e = 0; e < 8; ++e) y[e] *= sc; }
            const v4u pk = pack8(y);
            if (which < 2) {
                const int rt = (t0 + t) & 63; unsigned char* tb = (unsigned char*)(dst + (size_t)((t0 + t) - rt) * 128);
                const int ks = c8 >> 2, bb = (c8 >> 1) & 1, fqb = 2 * (c8 & 1);
                *(v2u*)(tb + off256(rt, 4 * ks + fqb) + 8 * bb) = (v2u){pk.x, pk.y}; *(v2u*)(tb + off256(rt, 4 * ks + fqb + 1) + 8 * bb) = (v2u){pk.z, pk.w};
            } else *(v4u*)(dst + (size_t)(t0 + t) * 128 + c8 * 8) = pk;
        }
    }
}
__device__ __forceinline__ void dn_prep4(Frame& F, int item) {
    int lane_ = F.lane; asm volatile("" : "+v"(lane_));
    const int w = F.wave, lane = lane_, fr = lane & 15, fq = lane >> 4, uu = w >> 1, which = w & 1;
    const PrepUnit U = prep_unit(F, item * 4 + uu);
    LAS float* P = (LAS float*)(F.lds + uu * PP_BYTES);
    LAS float* Gf = (LAS float*)(F.lds + PP_GOFF + uu * 1024); LAS float* Gb = Gf + 64; LAS float* Bf = Gf + 128; LAS float* Bb = Gf + 192;
    {
        const float* bd = WSP(float, WS_BD) + (size_t)(U.rowbase + lane) * 32;
        const float bfv = sigmoidf_(bd[U.h]), bbv = sigmoidf_(bd[8 + U.h]);
        const float gfv = -__expf(F.in[I_ALOG][U.h]) * softplusf_(bd[16 + U.h] + F.in[I_DTB][U.h]);
        const float gbv = -__expf(F.in[I_ALOG][8 + U.h]) * softplusf_(bd[24 + U.h] + F.in[I_DTB][8 + U.h]);
        float pf = gfv, pb = gbv;
#pragma unroll
        for (int o = 1; o < 64; o <<= 1) { const float nf = __shfl_up(pf, o), nb = __shfl_up(pb, o); if (lane >= o) { pf += nf; pb += nb; } }
        const float totf = __shfl(pf, 63), totb = __shfl(pb, 63);
        const float sfx = totb - pb + gbv;
        if (which == 0) { Gf[lane] = pf; Gb[lane] = sfx; Bf[lane] = bfv; Bb[lane] = bbv;
            float* sc0 = DOP(float, DO_SC) + (size_t)(((0 * 2 + U.b) * 8 + U.h) * NCH + U.ch132) * SCBLK + lane;
            float* sc1 = DOP(float, DO_SC) + (size_t)(((1 * 2 + U.b) * 8 + U.h) * NCH + U.ch132) * SCBLK + lane;
            { const float eg = __expf(pf); sc0[0] = bfv * eg; sc0[64] = __expf(totf - pf); sc0[128] = eg; sc0[192] = bfv; }
            { const float eg = __expf(sfx); sc1[0] = bbv * eg; sc1[64] = __expf(totb - sfx); sc1[128] = eg; sc1[192] = bbv; } }
    }
    __syncthreads();
    {
        const bf16* asrc = which ? U.qbase : U.kbase;
        LAS unsigned char* AT = (LAS unsigned char*)(F.lds + PP_GOFF + 4096 + 8 * 1088 + uu * 8192);
        bf16x8 bfr[4][4], afa[4][4];
#pragma unroll
        for (int nt = 0; nt < 4; ++nt)
#pragma unroll
            for (int ks = 0; ks < 4; ++ks) { bfr[nt][ks] = *(const bf16x8*)((const unsigned char*)U.kbase + off256(16 * nt + fr, 4 * ks + fq)); afa[nt][ks] = *(const bf16x8*)((const unsigned char*)asrc + off256(16 * nt + fr, 4 * ks + fq)); }
#pragma unroll
        for (int mt = 0; mt < 4; ++mt) {
            const f32x4 gfi = *(const LAS f32x4*)(Gf + 16 * mt + 4 * fq), gbi = *(const LAS f32x4*)(Gb + 16 * mt + 4 * fq);
            const f32x4 bfi = *(const LAS f32x4*)(Bf + 16 * mt + 4 * fq), bbi = *(const LAS f32x4*)(Bb + 16 * mt + 4 * fq);
#pragma unroll
            for (int nt = 0; nt < 4; ++nt) {
                f32x4 Dm = {0.f, 0.f, 0.f, 0.f};
#pragma unroll
                for (int ks = 0; ks < 4; ++ks) Dm = MFMA16(afa[mt][ks], bfr[nt][ks], Dm);
                const int oj = 16 * nt + fr; const float gfj = Gf[oj], gbj = Gb[oj];
#pragma unroll
                for (int r = 0; r < 4; ++r) { const int oi = 16 * mt + 4 * fq + r;
                    const float dec = oi > oj ? __expf(gfi[r] - gfj) : (oi < oj ? __expf(gbi[r] - gbj) : 1.f);
                    if (which == 0) P[oi * PP_PITCH + oj] = (oi > oj ? bfi[r] : bbi[r]) * Dm[r] * dec;
                    else *(LAS bf16*)(AT + img128_byte(oi, oj)) = (bf16)f2bf(Dm[r] * dec); }
            }
        }
        if (which) {
            asm volatile("s_waitcnt lgkmcnt(0)" ::: "memory");
#pragma unroll
            for (int p8 = 0; p8 < 8; ++p8) *(v4u*)((unsigned char*)U.ta + 8192 + (p8 * 64 + lane) * 16) = *(const LAS v4u*)(AT + (p8 * 64 + lane) * 16);
        }
    }
    __syncthreads();
    { LAS float* S = (LAS float*)(F.lds + PP_GOFF + 4096 + w * 1088); if (which == 0) prep_solve<0>(P, S, lane); else prep_solve<1>(P, S, lane); }
    __syncthreads();
    prep_store(P, which, lane, U.ta);
    __syncthreads();
}
__device__ __forceinline__ void phase4(Frame& F) {
    constexpr int N_DN = (64 + 16 * NCHL) / 4;
    const bool s5wg = F.vcu >= 16 && F.vcu < 240;
    if (s5wg) {
        if (F.wave < 4) {
            for (int it = F.vcu; it < N_DN; it += F.G)
#pragma unroll 1
                for (int j = F.wave; j < 12; j += 4) { const int un = it * 4 + (j & 3), which = j >> 2;
                    conv_tile(F, un < 64 ? which * 64 + un : 192 + which * (16 * NCHL) + (un - 64)); }
        } else s5a_group(F, (F.vcu - 16) & 31, (F.vcu - 16) >> 5, 7, 0, 4, F.wave - 4, 16);
    } else {
        for (int it = F.vcu; it < N_DN; it += F.G)
#pragma unroll 1
            for (int j = F.wave; j < 12; j += NWAVES) { const int un = it * 4 + (j & 3), which = j >> 2;
                conv_tile(F, un < 64 ? which * 64 + un : 192 + which * (16 * NCHL) + (un - 64)); }
    }
    asm volatile("s_waitcnt vmcnt(0)" ::: "memory");
    __syncthreads();
    for (int it = F.vcu; it < N_DN; it += F.G) dn_prep4(F, it);
    if (s5wg) { __syncthreads(); s5a_group(F, (F.vcu - 16) & 31, (F.vcu - 16) >> 5, 7, 16, 8, F.wave, 1 << 20); }
}
__device__ __forceinline__ void s5c_group(Frame& F, int g, int q0, int nq) {
    const int lane = F.lane;
    constexpr int WST = S5_BUF_BYTES + 2048 + 4096;
    static_assert(8 * WST <= RING_BYTES && S5_HT_BYTES <= S5_BUF_BYTES, "S5 LDS");
    LAS float* buf = (LAS float*)(F.lds + F.wave * WST); LAS unsigned char* hT = F.lds + F.wave * WST; LAS unsigned* ubw = (LAS unsigned*)(F.lds + F.wave * WST + S5_BUF_BYTES); LAS float* yb = (LAS float*)(F.lds + F.wave * WST + S5_BUF_BYTES + 2048);
    s16x4k bbf0[8], bbf1[8]; s5_load_bbf(F, g, lane, bbf0); s5_load_bbf(F, 32 + g, lane, bbf1);
    bf16x8 cbf0[4], cbf1[4];
    { const bf16* c0 = TABP(bf16, TAB_CBT) + (size_t)g * 2048; const bf16* c1 = TABP(bf16, TAB_CBT) + (size_t)(32 + g) * 2048;
#pragma unroll
      for (int ks = 0; ks < 4; ++ks) { cbf0[ks] = *(const bf16x8*)(c0 + (lane & 15) * 128 + 32 * ks + 8 * (lane >> 4)); cbf1[ks] = *(const bf16x8*)(c1 + (lane & 15) * 128 + 32 * ks + 8 * (lane >> 4)); } }
    const f32x2 a0 = TABP(f32x2, TAB_ABAR)[g * 64 + lane], a1 = TABP(f32x2, TAB_ABAR)[(32 + g) * 64 + lane];
    float Dp[16];
#pragma unroll
    for (int c = 0; c < 16; ++c) Dp[c] = F.in[I_S5D][g * 16 + c];
    for (int un = q0 * 8 + F.wave; un < 2 * NCHL; un += nq * 8) {
        const int b = un / NCHL, lc = un % NCHL, r0 = b * SEQ + lc * CHK;
        { const bf16* src = WSP(bf16, WS_U) + (size_t)(r0 + lane) * 512 + g * 16; const v4u a = *(const v4u*)src, c2 = *(const v4u*)(src + 8);
          *(LAS v4u*)(ubw + lane * 8) = a; *(LAS v4u*)(ubw + lane * 8 + 4) = c2;
          float f[8];
          unpack8(a, f); *(LAS f32x4*)(yb + lane * 16) = (f32x4){f[0] * Dp[0], f[1] * Dp[1], f[2] * Dp[2], f[3] * Dp[3]}; *(LAS f32x4*)(yb + lane * 16 + 4) = (f32x4){f[4] * Dp[4], f[5] * Dp[5], f[6] * Dp[6], f[7] * Dp[7]};
          unpack8(c2, f); *(LAS f32x4*)(yb + lane * 16 + 8) = (f32x4){f[0] * Dp[8], f[1] * Dp[9], f[2] * Dp[10], f[3] * Dp[11]}; *(LAS f32x4*)(yb + lane * 16 + 12) = (f32x4){f[4] * Dp[12], f[5] * Dp[13], f[6] * Dp[14], f[7] * Dp[15]}; }
        const f32x2 h00 = DOP(f32x2, DO_EH)[(size_t)(((0 * 2 + b) * NCH + 4 + lc) * 32 + g) * 64 + lane], h01 = DOP(f32x2, DO_EH)[(size_t)(((1 * 2 + b) * NCH + 4 + lc) * 32 + g) * 64 + lane];
        asm volatile("" ::: "memory");
        { float hr = h00.x, hi = h00.y; for (int ib = 0; ib < 4; ++ib) s5_block<true>(buf, hT, ubw, bbf0, cbf0, a0, hr, hi, 0, ib, lane, yb); }
        { float hr = h01.x, hi = h01.y; for (int ib = 0; ib < 4; ++ib) s5_block<true>(buf, hT, ubw, bbf1, cbf1, a1, hr, hi, 1, ib, lane, yb); }
#pragma unroll
        for (int rep = 0; rep < 4; ++rep) { const int t = rep * 16 + (lane >> 2), cq = lane & 3; const f32x4 yv = *(const LAS f32x4*)(yb + t * 16 + cq * 4);
            const unsigned lo = pk2(gelu_tanh(yv[0]), gelu_tanh(yv[1])), hi2 = pk2(gelu_tanh(yv[2]), gelu_tanh(yv[3]));
            *(unsigned long long*)(DOP(bf16, DO_Y) + (size_t)(r0 + t) * 512 + g * 16 + cq * 4) = (unsigned long long)lo | ((unsigned long long)hi2 << 32); }
        LDS_WAIT(); asm volatile("" ::: "memory");
    }
}
__device__ __forceinline__ void phase7(Frame& F) {
    const int lane = F.lane;
    const int gw = F.vcu * NWAVES + F.wave, NGW = F.G * NWAVES;
    const float* nw = F.in[I_DNNW] + (lane & 7) * 16;
    for (int r = gw; r < T; r += NGW) {
        const bf16* of = WSP(bf16, WS_ODIR) + (size_t)r * 1024 + lane * 16; const bf16* ob = of + (size_t)T * 1024; const bf16* zp = WSP(bf16, WS_ZDN) + (size_t)r * 1024 + lane * 16;
        float o[16], f[8], z[16];
        unpack8(*(const v4u*)of, o); unpack8(*(const v4u*)(of + 8), o + 8);
        unpack8(*(const v4u*)ob, f);
#pragma unroll
        for (int e = 0; e < 8; ++e) o[e] += f[e];
        unpack8(*(const v4u*)(ob + 8), f);
#pragma unroll
        for (int e = 0; e < 8; ++e) o[8 + e] += f[e];
        unpack8(*(const v4u*)zp, z); unpack8(*(const v4u*)(zp + 8), z + 8);
        float ss = 0.f;
#pragma unroll
        for (int e = 0; e < 16; ++e) ss += o[e] * o[e];
        ss = sum8(ss);
        const float rinv = __builtin_amdgcn_rsqf(ss * (1.f / 128.f) + EPS);
#pragma unroll
        for (int e = 0; e < 16; ++e) o[e] = o[e] * rinv * nw[e] * z[e];
        bf16* yo = WSP(bf16, WS_YDN) + (size_t)r * 1024 + lane * 16;
        *(v4u*)yo = pack8(o); *(v4u*)(yo + 8) = pack8(o + 8);
    }
}
struct EpiGates {
    static constexpr bool PERM = true, AFTER_DRAIN = false;
    const bf16* ODIR; const float* nw; bf16 *YDN, *GDN, *GS5; LAS float* red;
    __device__ __forceinline__ void operator()(const f32x4 (&acc)[2][2][4][2], const pg8::Unit& u, int wr, int wc, int fr_, int fq_) const {
        const int pn = u.pn; int fr = fr_, fq = fq_; asm volatile("" : "+v"(fr), "+v"(fq));
        if (pn < 18) {
            const int c0 = (pn - 14) * 256 + wc * 32 + 8 * fq;
            const bf16* pbase = ODIR + (size_t)(u.pm * 256 + wr * 64 + fr) * 1024 + c0;
#define EG_ISSUE(bt, ra, rb) do { _Pragma("unroll") for (int mi = 0; mi < 2; ++mi) _Pragma("unroll") for (int bj = 0; bj < 2; ++bj) { \
                const bf16* p = pbase + (size_t)(((bt) >> 1) * 128 + (((bt) & 1) * 2 + mi) * 16) * 1024 + bj * 128; ra[mi][bj] = *(const v4u*)p; rb[mi][bj] = *(const v4u*)(p + (size_t)T * 1024); } } while (0)
            {
                v4u ra0[2][2], rb0[2][2], ra1[2][2], rb1[2][2];
                EG_ISSUE(0, ra0, rb0);
#pragma unroll
                for (int bt = 0; bt < 4; ++bt) {
                    if (bt + 1 < 4) { if (bt & 1) EG_ISSUE(bt + 1, ra0, rb0); else EG_ISSUE(bt + 1, ra1, rb1); }
                    asm volatile("" ::: "memory");
#pragma unroll
                    for (int mi = 0; mi < 2; ++mi)
#pragma unroll
                        for (int bj = 0; bj < 2; ++bj) { float a[8], b[8]; unpack8((bt & 1) ? ra1[mi][bj] : ra0[mi][bj], a); unpack8((bt & 1) ? rb1[mi][bj] : rb0[mi][bj], b); float ss = 0.f;
#pragma unroll
                            for (int e = 0; e < 8; ++e) { const float o = a[e] + b[e]; ss += o * o; }
                            ss += __shfl_xor(ss, 16); ss += __shfl_xor(ss, 32);
                            if (fq == 0) red[(wc * 2 + bj) * 256 + (bt >> 1) * 128 + wr * 64 + ((bt & 1) * 2 + mi) * 16 + fr] = ss; }
                    asm volatile("" ::: "memory");
                }
            }
            asm volatile("s_waitcnt lgkmcnt(0)" ::: "memory");
            __builtin_amdgcn_s_barrier();
            {
                v4u ra0[2][2], rb0[2][2], ra1[2][2], rb1[2][2];
                EG_ISSUE(0, ra0, rb0);
#pragma unroll
                for (int bt = 0; bt < 4; ++bt) {
                    if (bt + 1 < 4) { if (bt & 1) EG_ISSUE(bt + 1, ra0, rb0); else EG_ISSUE(bt + 1, ra1, rb1); }
                    asm volatile("" ::: "memory");
#pragma unroll
                    for (int mi = 0; mi < 2; ++mi)
#pragma unroll
                        for (int bj = 0; bj < 2; ++bj) { const int ai = bt >> 1, m = (bt & 1) * 2 + mi, rl = ai * 128 + wr * 64 + m * 16 + fr;
                            const float rinv = __builtin_amdgcn_rsqf(((red[bj * 256 + rl] + red[(2 + bj) * 256 + rl]) + (red[(4 + bj) * 256 + rl] + red[(6 + bj) * 256 + rl])) * (1.f / 128.f) + EPS);
                            float a[8], b[8]; unpack8((bt & 1) ? ra1[mi][bj] : ra0[mi][bj], a); unpack8((bt & 1) ? rb1[mi][bj] : rb0[mi][bj], b);
                            f32x4 v0 = acc[ai][bj][m][0], v1 = acc[ai][bj][m][1]; asm volatile("" : "+v"(v0), "+v"(v1));
                            const float z[8] = {v0[0], v0[1], v0[2], v0[3], v1[0], v1[1], v1[2], v1[3]};
#pragma unroll
                            for (int e = 0; e < 8; ++e) a[e] = (a[e] + b[e]) * rinv * nw[wc * 32 + 8 * fq + e] * siluf_(z[e]);
                            *(v4u*)(YDN + (size_t)(u.pm * 256 + rl) * 1024 + c0 + bj * 128) = pack8(a); }
                    asm volatile("" ::: "memory");
                }
            }
#undef EG_ISSUE
        } else {
#pragma unroll
            for (int ai = 0; ai < 2; ++ai)
#pragma unroll
                for (int m = 0; m < 4; ++m) { const int row = u.pm * 256 + ai * 128 + wr * 64 + m * 16 + fr;
#pragma unroll
                    for (int bj = 0; bj < 2; ++bj) { const f32x4 v0 = acc[ai][bj][m][0], v1 = acc[ai][bj][m][1]; float f[8] = {v0[0], v0[1], v0[2], v0[3], v1[0], v1[1], v1[2], v1[3]};
                        const int colin = bj * 128 + wc * 32 + 8 * fq;
#pragma unroll
                        for (int e = 0; e < 8; ++e) f[e] = sigmoidf_(f[e]);
                        if (pn < 24) *(v4u*)(GDN + (size_t)row * 1024 + (pn - 20) * 256 + colin) = pack8(f);
                        else *(v4u*)(GS5 + (size_t)row * 1024 + (pn - 24) * 256 + colin) = pack8(f); } }
        }
    }
};
struct EpiGlu {
    static constexpr bool PERM = true, AFTER_DRAIN = false;
    const bf16* Y; const bf16* ZS5; const float* gb; bf16* O;
    __device__ __forceinline__ void operator()(const f32x4 (&acc)[2][2][4][2], const pg8::Unit& u, int wr, int wc, int fr, int fq) const {
#pragma unroll
        for (int ai = 0; ai < 2; ++ai)
#pragma unroll
            for (int m = 0; m < 4; ++m) { const int row = u.pm * 256 + ai * 128 + wr * 64 + m * 16 + fr;
#pragma unroll
                for (int bj = 0; bj < 2; ++bj) { const int col = u.pn * 256 + bj * 128 + wc * 32 + 8 * fq; const size_t o = (size_t)row * 512 + col;
                    const f32x4 v0 = acc[ai][bj][m][0], v1 = acc[ai][bj][m][1]; float a[8] = {v0[0], v0[1], v0[2], v0[3], v1[0], v1[1], v1[2], v1[3]}, y[8], z[8];
                    unpack8(*(const v4u*)(Y + o), y); unpack8(*(const v4u*)(ZS5 + o), z);
#pragma unroll
                    for (int e = 0; e < 8; ++e) a[e] = y[e] * sigmoidf_(a[e] + gb[col + e]) * z[e];
                    *(v4u*)(O + o) = pack8(a); } }
    }
};
struct EpiGate {
    static constexpr bool PERM = true, AFTER_DRAIN = false;
    const bf16* Gt; const bf16* P; bf16* O; int add;
    __device__ __forceinline__ void operator()(const f32x4 (&acc)[2][2][4][2], const pg8::Unit& u, int wr, int wc, int fr, int fq) const {
#pragma unroll
        for (int ai = 0; ai < 2; ++ai)
#pragma unroll
            for (int m = 0; m < 4; ++m) { const int row = u.pm * 256 + ai * 128 + wr * 64 + m * 16 + fr;
#pragma unroll
                for (int bj = 0; bj < 2; ++bj) { const int col = u.pn * 256 + bj * 128 + wc * 32 + 8 * fq; const size_t o = (size_t)row * 1024 + col;
                    const f32x4 v0 = acc[ai][bj][m][0], v1 = acc[ai][bj][m][1]; float a[8] = {v0[0], v0[1], v0[2], v0[3], v1[0], v1[1], v1[2], v1[3]}, g[8], p[8];
                    unpack8(*(const v4u*)(Gt + o), g);
                    if (add) { unpack8(*(const v4u*)(P + o), p);
#pragma unroll
                        for (int e = 0; e < 8; ++e) a[e] = p[e] + g[e] * a[e]; }
                    else {
#pragma unroll
                        for (int e = 0; e < 8; ++e) a[e] = g[e] * a[e]; }
                    *(v4u*)(O + o) = pack8(a); } }
    }
};
struct EpiMerge {
    static constexpr bool PERM = true, AFTER_DRAIN = false;
    const bf16* GDN; const bf16* GS5; bf16* O;
    __device__ __forceinline__ void mid(f32x4 (&acc)[2][2][4][2], const pg8::Unit& u, int wr, int wc, int fr, int fq) const {
#pragma unroll
        for (int ai = 0; ai < 2; ++ai)
#pragma unroll
            for (int m = 0; m < 4; ++m) { const int row = u.pm * 256 + ai * 128 + wr * 64 + m * 16 + fr;
#pragma unroll
                for (int bj = 0; bj < 2; ++bj) { const int col = u.pn * 256 + bj * 128 + wc * 32 + 8 * fq; const size_t o = (size_t)row * 1024 + col;
                    const v4u r1 = *(const v4u*)(GDN + o), r2 = *(const v4u*)(GS5 + o);
                    const unsigned w1[4] = {r1.x, r1.y, r1.z, r1.w}, w2[4] = {r2.x, r2.y, r2.z, r2.w};
#pragma unroll
                    for (int w = 0; w < 4; ++w) {
                        const float ra = bf2f(w1[w] & 0xffffu) * __builtin_amdgcn_rcpf(fmaxf(bf2f(w2[w] & 0xffffu), 1e-30f)), rb = bf2f(w1[w] >> 16) * __builtin_amdgcn_rcpf(fmaxf(bf2f(w2[w] >> 16), 1e-30f));
                        acc[ai][bj][m][w >> 1][2 * (w & 1)] *= ra; acc[ai][bj][m][w >> 1][2 * (w & 1) + 1] *= rb; }
                    asm volatile("" ::: "memory"); } }
    }
    __device__ __forceinline__ void operator()(const f32x4 (&acc)[2][2][4][2], const pg8::Unit& u, int wr, int wc, int fr, int fq) const {
#pragma unroll
        for (int ai = 0; ai < 2; ++ai)
#pragma unroll
            for (int m = 0; m < 4; ++m) { const int row = u.pm * 256 + ai * 128 + wr * 64 + m * 16 + fr;
#pragma unroll
                for (int bj = 0; bj < 2; ++bj) { const int col = u.pn * 256 + bj * 128 + wc * 32 + 8 * fq; const size_t o = (size_t)row * 1024 + col;
                    const f32x4 v0 = acc[ai][bj][m][0], v1 = acc[ai][bj][m][1]; float a[8] = {v0[0], v0[1], v0[2], v0[3], v1[0], v1[1], v1[2], v1[3]}, g2[8];
                    unpack8(*(const v4u*)(GS5 + o), g2);
#pragma unroll
                    for (int e = 0; e < 8; ++e) a[e] *= g2[e];
                    *(v4u*)(O + o) = pack8(a); } }
    }
};
struct EpiOut {
    static constexpr bool PERM = false, AFTER_DRAIN = false;
    const float* X; const float* gate; float* O;
    __device__ __forceinline__ void operator()(const f32x4 (&acc)[2][2][4][2], const pg8::Unit& u, int wr, int wc, int fr, int fq) const {
#pragma unroll
        for (int ai = 0; ai < 2; ++ai)
#pragma unroll
            for (int m = 0; m < 4; ++m) { const int row = u.pm * 256 + ai * 128 + wr * 64 + m * 16 + fr; const float* gt = gate + (row >> 13) * 1024;
#pragma unroll
                for (int bj = 0; bj < 2; ++bj)
#pragma unroll
                    for (int n = 0; n < 2; ++n) { const int col = u.pn * 256 + bj * 128 + wc * 32 + 16 * n + 4 * fq; const size_t o = (size_t)row * 1024 + col;
                        *(f32x4*)(O + o) = *(const f32x4*)(X + o) + *(const f32x4*)(gt + col) * acc[ai][bj][m][n]; } }
    }
};
struct EpiOutNorm {
    static constexpr bool PERM = false, AFTER_DRAIN = true;
    const float* X; const float* gate; const float* fnw; float* O; unsigned long long* gran;
    __device__ __forceinline__ void operator()(const f32x4 (&acc)[2][2][4][2], const pg8::Unit& u, int wr, int wc, int fr, int fq) const {}
    __device__ __forceinline__ void fused(f32x4 (&acc)[2][2][4][2], const pg8::Unit& u, int wr, int wc, int fr, int fq, LAS unsigned char* lds, int wid, int lane) const {
        LAS float* red = (LAS float*)lds;
#pragma unroll
        for (int ai = 0; ai < 2; ++ai)
#pragma unroll
            for (int m = 0; m < 4; ++m) { const int rl = ai * 128 + wr * 64 + m * 16 + fr, row = u.pm * 256 + rl; const float* gt = gate + (row >> 13) * 1024; float s = 0.f;
#pragma unroll
                for (int bj = 0; bj < 2; ++bj)
#pragma unroll
                    for (int n = 0; n < 2; ++n) { const int col = u.pn * 256 + bj * 128 + wc * 32 + 16 * n + 4 * fq; const size_t o = (size_t)row * 1024 + col;
                        const f32x4 y = *(const f32x4*)(X + o) + *(const f32x4*)(gt + col) * acc[ai][bj][m][n]; acc[ai][bj][m][n] = y;
                        s += (y.x * y.x + y.y * y.y) + (y.z * y.z + y.w * y.w); }
                s += __shfl_xor(s, 16); s += __shfl_xor(s, 32);
                if (fq == 0) red[wc * 256 + rl] = s; }
        __syncthreads();
        const int t = wid * 64 + lane;
        if (t < 256) {
            const float mine = (red[t] + red[256 + t]) + (red[512 + t] + red[768 + t]);
            unsigned long long* g = gran + u.pm * 256 + t;
            __hip_atomic_store(g + (size_t)u.pn * T, (unsigned long long)__builtin_bit_cast(unsigned, mine) | (1ull << 32), __ATOMIC_RELAXED, __HIP_MEMORY_SCOPE_AGENT);
            float s4 = 0.f;
#pragma unroll
            for (int j = 0; j < 4; ++j) { unsigned long long v;
                if (j == u.pn) { s4 += mine; continue; }
                while (((v = __hip_atomic_load(g + (size_t)j * T, __ATOMIC_RELAXED, __HIP_MEMORY_SCOPE_AGENT)) >> 32) == 0ull) __builtin_amdgcn_s_sleep(1);
                s4 += __builtin_bit_cast(float, (unsigned)v); }
            red[1024 + t] = __builtin_amdgcn_rsqf(s4 * (1.f / D) + EPS); }
        __syncthreads();
#pragma unroll
        for (int ai = 0; ai < 2; ++ai)
#pragma unroll
            for (int m = 0; m < 4; ++m) { const int rl = ai * 128 + wr * 64 + m * 16 + fr, row = u.pm * 256 + rl; const float rinv = red[1024 + rl];
#pragma unroll
                for (int bj = 0; bj < 2; ++bj)
#pragma unroll
                    for (int n = 0; n < 2; ++n) { const int col = u.pn * 256 + bj * 128 + wc * 32 + 16 * n + 4 * fq; const size_t o = (size_t)row * 1024 + col;
                        *(f32x4*)(O + o) = acc[ai][bj][m][n] * rinv * *(const f32x4*)(fnw + col); } }
    }
};
__device__ __forceinline__ void phase11(Frame& F) {
    const int gw = F.vcu * NWAVES + F.wave, NGW = F.G * NWAVES; const f32x4* wv = (const f32x4*)F.in[I_FNW] + F.lane;
    for (int r = gw; r < T; r += NGW) {
        f32x4* xr = (f32x4*)(F.out + (size_t)r * D) + F.lane; f32x4 xv[4]; float s = 0.f;
#pragma unroll
        for (int j = 0; j < 4; ++j) { xv[j] = xr[64 * j]; s += (xv[j].x * xv[j].x + xv[j].y * xv[j].y) + (xv[j].z * xv[j].z + xv[j].w * xv[j].w); }
        const float rinv = __builtin_amdgcn_rsqf(wave_sum(s) * (1.f / D) + EPS);
#pragma unroll
        for (int j = 0; j < 4; ++j) xr[64 * j] = xv[j] * rinv * wv[64 * j];
    }
}
__device__ __forceinline__ void panel_sync(unsigned* cnt) {
    asm volatile("s_waitcnt vmcnt(0)" ::: "memory");
    __syncthreads();
    if (threadIdx.x == 0) {
        __builtin_amdgcn_fence(__ATOMIC_RELEASE, "agent");
        asm volatile("s_waitcnt vmcnt(0)" ::: "memory");
        __hip_atomic_fetch_add(cnt, 1u, __ATOMIC_RELAXED, __HIP_MEMORY_SCOPE_AGENT);
        while (__hip_atomic_load(cnt, __ATOMIC_RELAXED, __HIP_MEMORY_SCOPE_AGENT) < 4u) __builtin_amdgcn_s_sleep(1);
        __builtin_amdgcn_fence(__ATOMIC_ACQUIRE, "agent");
        asm volatile("s_waitcnt vmcnt(0)" ::: "memory");
    }
    __syncthreads();
}
struct Args { const float* in[26]; float* out; unsigned char* ws; int ph_lo, ph_hi, sub, pad; };
__global__ void __launch_bounds__(NWAVES * 64, 2) mk_fwd(Args args) {
    extern __shared__ __attribute__((aligned(16))) unsigned char lds[];
    Frame F;
    F.lds = (LAS unsigned char*)lds;
    F.tid = threadIdx.x; F.lane = F.tid & 63; F.wave = __builtin_amdgcn_readfirstlane(F.tid >> 6);
    F.G = gridDim.x; { const int bx = blockIdx.x; F.vcu = (F.G % 8 == 0) ? (bx % 8) * (F.G / 8) + bx / 8 : bx; }
#pragma unroll
    for (int i = 0; i < 26; ++i) F.in[i] = args.in[i];
    F.out = args.out; F.ws = args.ws;
    volatile LAS unsigned* MISC = (volatile LAS unsigned*)(F.lds + MISC_OFF);
    for (int u = F.tid; u < (LDS_BYTES - LDSCTL_OFF) / 4; u += NTHR) ((LAS unsigned*)(F.lds + LDSCTL_OFF))[u] = 0u;
    __syncthreads();
    XcdBarrier bar; bar.bar = (unsigned*)(F.ws + WS_CTL) + CW_BAR; bar.x = 0; bar.st = nullptr; bar.ngrp = 0u;
    if (!MK_PER_PHASE) bar = xcd_barrier_post((unsigned*)(F.ws + WS_CTL) + CW_BAR, MISC + 8);
    const int lo = args.ph_lo, hi = args.ph_hi;
#define IN(k) (lo <= (k) && (k) < hi)
#if MK_STAMP >= 0
    unsigned long long tstamp[NPHASE + 1]; tstamp[0] = __builtin_amdgcn_s_memrealtime();
#define SEAM(k) do { if (IN(k) && IN((k) + 1)) xcd_barrier(bar); tstamp[(k) + 1] = __builtin_amdgcn_s_memrealtime(); } while (0)
#define SEAMP(k, cw) do { if (IN(k) && IN((k) + 1)) panel_sync((unsigned*)(F.ws + WS_CTL) + (cw) + 64 * mypm); tstamp[(k) + 1] = __builtin_amdgcn_s_memrealtime(); } while (0)
#else
#define SEAM(k) do { if (IN(k) && IN((k) + 1)) xcd_barrier(bar); } while (0)
#define SEAMP(k, cw) do { if (IN(k) && IN((k) + 1)) panel_sync((unsigned*)(F.ws + WS_CTL) + (cw) + 64 * mypm); } while (0)
#endif
    if (IN(0)) { phase0(F); } SEAM(0);
    if (IN(1)) { phase1(F); } SEAM(1);
    if (IN(2)) {
        pg8::Gemm g{DOP(bf16, DO_H), WSP(bf16, WS_WIN), MROWS, NPAD, D}; OrderIn S; S.init(true, F.G, (int)blockIdx.x);
        EpiIn E{WSP(bf16, WS_QKV), WSP(bf16, WS_QKVC_RAW), WSP(bf16, WS_U), WSP(bf16, WS_ZDN), WSP(bf16, WS_ZS5), WSP(bf16, WS_GDN), WSP(bf16, WS_GS5), WSP(float, WS_BD)};
        pg8::gemm_phase<EpiIn, OrderIn, true, true>(F.lds, g, S, E);
    } SEAM(2);
    if (IN(3)) { phase4(F); } SEAM(3);
    if (IN(4) && F.G == 256) {
        if ((F.vcu & 4) == 0) { if (args.sub & 1) phase5b(F, args.sub); }
        else if (args.sub & 30) {
            const int sidx = (F.vcu >> 3) * 4 + (F.vcu & 3);
            XcdBarrier bar2 = xcd_barrier_post((unsigned*)(F.ws + WS_CTL) + CW_BAR2, MISC + 12); bar2.ngrp = 128u;
            if (args.sub & 4) s5_state_scan(F, sidx);
            xcd_barrier(bar2);
            if (args.sub & 8) s5c_group(F, sidx & 31, sidx >> 5, 4);
            __syncthreads();
            if (args.sub & 8) {
                pg8::Gemm g{DOP(bf16, DO_H), WSP(bf16, WS_WIN), T, NPAD, D}; OrderOne S; S.u0.pm = sidx >> 1; S.u0.pn = 18 + (sidx & 1);
                EpiIn E{WSP(bf16, WS_QKV), WSP(bf16, WS_QKVC_RAW), WSP(bf16, WS_U), WSP(bf16, WS_ZDN), WSP(bf16, WS_ZS5), WSP(bf16, WS_GDN), WSP(bf16, WS_GS5), WSP(float, WS_BD)};
                pg8::gemm_phase<EpiIn, OrderOne, false, true>(F.lds, g, S, E); }
            xcd_barrier(bar2);
            if (args.sub & 16) {
                pg8::Gemm g{DOP(bf16, DO_Y), WSP(bf16, WS_GLU), T, 512, 512}; pg8::StaticOrder S; S.init(T, 512, 128, sidx);
                EpiGlu E{DOP(bf16, DO_Y), WSP(bf16, WS_ZS5), F.in[I_GLUB], WSP(bf16, WS_YS5)};
                pg8::gemm_phase<EpiGlu, pg8::StaticOrder, false, true>(F.lds, g, S, E); }
        }
    } SEAM(4);
    if (IN(5)) {
        pg8::Gemm g{DOP(bf16, DO_H), WSP(bf16, WS_WIN), T, NPAD, D}; OrderIn S; S.init(false, F.G, (int)blockIdx.x);
        EpiGates E{WSP(bf16, WS_ODIR), F.in[I_DNNW], WSP(bf16, WS_YDN), WSP(bf16, WS_GDN), WSP(bf16, WS_GS5), (LAS float*)(F.lds + 8 * pg8::HTB)};
        pg8::gemm_phase<EpiGates, OrderIn, true, true>(F.lds, g, S, E);
    }
    const int mypm = 8 * ((int)blockIdx.x & 7) + (((int)blockIdx.x >> 3) & 7);
    SEAM(5);
    if (IN(6)) {
        pg8::Gemm g1{WSP(bf16, WS_YDN), WSP(bf16, WS_WPD), T, 1024, 1024}, g2{WSP(bf16, WS_YS5), WSP(bf16, WS_WPS), T, 1024, 512}; pg8::StaticOrder S; S.init(T, 1024, F.G, (int)blockIdx.x);
        EpiMerge E{WSP(bf16, WS_GDN), WSP(bf16, WS_GS5), WSP(bf16, WS_MERGED)};
        pg8::gemm_dual<EpiMerge, pg8::StaticOrder, 1024, 512>(F.lds, g1, g2, S, E);
    } SEAM(6);
    { int t_ = threadIdx.x; asm volatile("" : "+v"(t_)); F.tid = t_; F.lane = t_ & 63; }
    if (IN(7)) {
        pg8::Gemm g{WSP(bf16, WS_MERGED), WSP(bf16, WS_WOUT), T, 1024, 1024}; pg8::StaticOrder S; S.init(T, 1024, F.G, (int)blockIdx.x);
        EpiOutNorm E{F.in[I_X], TABP(float, TAB_GATE), F.in[I_FNW], F.out, (unsigned long long*)(F.ws + WS_CTL + CTL_GRAN)};
        pg8::gemm_phase<EpiOutNorm, pg8::StaticOrder, false, true>(F.lds, g, S, E);
    }
#if MK_STAMP >= 0
    tstamp[NPHASE] = __builtin_amdgcn_s_memrealtime();
#if MK_STAMP == 200
    {
        asm volatile("s_waitcnt vmcnt(0)" ::: "memory"); __syncthreads();
        if (threadIdx.x == 0) { unsigned* cw = (unsigned*)(F.ws + WS_CTL) + 28672;
            __hip_atomic_fetch_max(cw, ~(unsigned)tstamp[0], __ATOMIC_RELAXED, __HIP_MEMORY_SCOPE_AGENT); __hip_atomic_fetch_max(cw + 64, (unsigned)tstamp[NPHASE], __ATOMIC_RELAXED, __HIP_MEMORY_SCOPE_AGENT);
            __builtin_amdgcn_fence(__ATOMIC_RELEASE, "agent"); asm volatile("s_waitcnt vmcnt(0)" ::: "memory");
            const unsigned old = __hip_atomic_fetch_add(cw + 128, 1u, __ATOMIC_RELAXED, __HIP_MEMORY_SCOPE_AGENT);
            if (old == gridDim.x - 1) { __builtin_amdgcn_fence(__ATOMIC_ACQUIRE, "agent"); asm volatile("s_waitcnt vmcnt(0)" ::: "memory");
                const unsigned s0 = ~__hip_atomic_load(cw, __ATOMIC_RELAXED, __HIP_MEMORY_SCOPE_AGENT), e1 = __hip_atomic_load(cw + 64, __ATOMIC_RELAXED, __HIP_MEMORY_SCOPE_AGENT);
                float* o = F.out; const float v = __hip_atomic_load(o, __ATOMIC_RELAXED, __HIP_MEMORY_SCOPE_AGENT); __hip_atomic_store(o, v + 0.00001f * (float)(e1 - s0), __ATOMIC_RELAXED, __HIP_MEMORY_SCOPE_AGENT); } }
    }
#else
    if (blockIdx.x == 0 && F.tid == 0) { asm volatile("s_waitcnt vmcnt(0)" ::: "memory"); F.out[0] += (MK_STAMP >= 100 ? 0.00001f : 0.01f) * (float)(MK_STAMP >= 100 ? tstamp[MK_STAMP - 100 + 1] - tstamp[0] : tstamp[MK_STAMP + 1] - tstamp[MK_STAMP]); }
#endif
#endif
#undef IN
#undef SEAM
#undef SEAMP
}
extern "C" void kernel_launch(void* const* d_in, const int* in_sizes, int n_in, void* d_out, int out_size, void* d_ws, size_t ws_size, hipStream_t stream) {
    static int grid = 0;
    if (grid == 0) {
        if (n_in != 26 || in_sizes[0] != T * D || out_size != T * D || ws_size < WS_END) { fprintf(stderr, "kernel_launch: unexpected shapes (n_in %d, in0 %d, out %d, ws %zu)\n", n_in, n_in > 0 ? in_sizes[0] : -1, out_size, ws_size); grid = -1; return; }
        int dev = 0, cus = 0;
        if (hipGetDevice(&dev) != hipSuccess || hipDeviceGetAttribute(&cus, hipDeviceAttributeMultiprocessorCount, dev) != hipSuccess) { grid = -1; return; }
        if (hipFuncSetAttribute((const void*)mk_fwd, hipFuncAttributeMaxDynamicSharedMemorySize, LDS_BYTES) != hipSuccess) { fprintf(stderr, "kernel_launch: hipFuncSetAttribute failed\n"); grid = -1; return; }
        (void)hipGetLastError();
        grid = cus;
        if (grid != 256) fprintf(stderr, "kernel_launch: %d CUs; this build assumes 256\n", grid);
    }
    if (grid < 0) return;
    if (hipMemsetAsync((char*)d_ws + WS_CTL, 0, CTL_ZERO_BYTES, stream) != hipSuccess) return;
    Args a{};
    for (int i = 0; i < 26; ++i) a.in[i] = (const float*)d_in[i];
    a.out = (float*)d_out; a.ws = (unsigned char*)d_ws; a.sub = 31;
#if MK_PER_PHASE
    for (int p = 0; p < NPHASE; ++p) { a.ph_lo = p; a.ph_hi = p + 1;
        if (p == 4 && MK_REP == 100) { a.sub = 1; hipLaunchKernelGGL(mk_fwd, dim3(grid), dim3(NWAVES * 64), LDS_BYTES, stream, a); a.sub = 30; }
        for (int rp = 0; rp < ((MK_REP == p && p != 4 && p != 9) ? 2 : 1); ++rp) hipLaunchKernelGGL(mk_fwd, dim3(grid), dim3(NWAVES * 64), LDS_BYTES, stream, a);
        if (p == 4 && MK_REP > 100) { a.sub = MK_REP - 100; (void)hipMemsetAsync((char*)d_ws + WS_CTL + (size_t)CW_BAR2 * 4, 0, 16384, stream); hipLaunchKernelGGL(mk_fwd, dim3(grid), dim3(NWAVES * 64), LDS_BYTES, stream, a); }

        a.sub = 31; }
#else
    a.ph_lo = 0; a.ph_hi = NPHASE; hipLaunchKernelGGL(mk_fwd, dim3(grid), dim3(NWAVES * 64), LDS_BYTES, stream, a);
#endif
}
```

```cpp
#include <hip/hip_runtime.h>
#include <cstdio>
#include <cstdint>
#define MK_PER_PHASE 0
#define MK_REP -1
#define MK_STAMP -1
namespace pg8 {
#define PG8_LAS __attribute__((address_space(3)))
typedef unsigned short bf16_t;
typedef short bf16x8 __attribute__((ext_vector_type(8)));
typedef float f32x4 __attribute__((ext_vector_type(4)));
typedef unsigned u32x4 __attribute__((ext_vector_type(4)));
constexpr int BM = 256, BK = 64, HALF = 128, HTB = HALF * BK * 2  , STAGE_BYTES = 8 * HTB, NXCD = 8, WGM = 8;

__host__ __device__ __forceinline__ int lds_byte(int r, int c) { const int st = (r >> 4) * 2 + (c >> 5), rr = r & 15, cc = c & 31, ob = rr * 64 + cc * 2; return st * 1024 + (ob ^ (((ob >> 9) & 1) << 5)); }
__host__ __device__ __forceinline__ void stage_rc(int b, int& R, int& C) { const int st = b / 1024, sb = b % 1024, swz = sb ^ (((sb >> 9) & 1) << 5); R = (st >> 1) * 16 + swz / 64; C = (st & 1) * 32 + (swz % 64) / 2; }
__host__ __device__ __forceinline__ int perm32(int rho) { const int n = rho >> 4, i = rho & 15; return 8 * (i >> 2) + 4 * n + (i & 3); }

struct Unit { int pm, pn; };
struct Gemm { const bf16_t* A; const bf16_t* Bt; int M, N, K; };

struct StaticOrder {
    int nM, nN, nwg, G, c;
    __host__ __device__ void init(int M, int N, int G_, int c_) { nM = M / BM; nN = N / BM; nwg = nM * nN; G = G_; c = c_; }
    __host__ __device__ bool next(int i, Unit& u) const {
        const long L = (long)i * G + c; if (L >= nwg) return false;
        int wgid = (int)L; { const int q = nwg / NXCD, r = nwg % NXCD, xcd = wgid % NXCD, off = wgid / NXCD; wgid = (xcd < r ? xcd * (q + 1) : r * (q + 1) + (xcd - r) * q) + off; }
        const int nig = WGM * nN, gid = wgid / nig, fm = gid * WGM, gsz = (nM - fm) < WGM ? (nM - fm) : WGM;
        u.pm = fm + ((wgid % nig) % gsz); u.pn = (wgid % nig) / gsz; return true;
    }
    __device__ __forceinline__ void a_ready(const Unit&) const {}
    __device__ __forceinline__ void done(const Unit&) const {}
};

__device__ __forceinline__ unsigned cvt_pk_bf16(float lo, float hi) { unsigned r; asm volatile("v_cvt_pk_bf16_f32 %0, %1, %2" : "=v"(r) : "v"(lo), "v"(hi)); return r; }
template <class Epi, class Sched, bool ALIGN_EPI = false, bool SP2 = false>
__device__ __forceinline__ void gemm_phase(PG8_LAS unsigned char* lds, const Gemm g, const Sched& S, const Epi& E) {
    int tid_ = threadIdx.x; asm volatile("" : "+v"(tid_));
    const int tid = tid_, wid = __builtin_amdgcn_readfirstlane(tid >> 6), lane = tid & 63, wr = wid >> 2, wc = wid & 3, fr = lane & 15, fq = lane >> 4;
    const int K = g.K, nt = K / BK;
    unsigned voffA[2], voffB[2];
#pragma unroll
    for (int i = 0; i < 2; ++i) { int R, C; stage_rc(tid * 16 + i * 8192, R, C); const int Rb = Epi::PERM ? ((R & ~31) + perm32(R & 31)) : R;
        voffA[i] = (unsigned)(R * K + C) * 2u; voffB[i] = (unsigned)(Rb * K + C) * 2u; }
    const size_t kstep = (size_t)(BK * 2);
    const size_t hstep = (size_t)HALF * K * 2;
    const size_t tstep = 2 * hstep;
    const unsigned ldsw = (unsigned)wid * 1024u;
    const int aoff = lds_byte(wr * 64 + fr, fq * 8), boff = lds_byte(wc * 32 + fr, fq * 8);
#define PG8_SA(b, h) (((b) * 2 + (h)) * HTB)
#define PG8_SB(b, h) ((4 + (b) * 2 + (h)) * HTB)
#define PG8_STAGE(bufoff, gbase, voff) do { _Pragma("unroll") for (int _i = 0; _i < 2; ++_i) \
        __builtin_amdgcn_global_load_lds((const unsigned*)((const char*)(gbase) + (voff)[_i]), (PG8_LAS unsigned*)(lds + (bufoff) + ldsw + _i * 8192), 16, 0, 0); } while (0)
#define PG8_LDA(dst, b, h) do { _Pragma("unroll") for (int m = 0; m < 4; ++m) _Pragma("unroll") for (int k = 0; k < 2; ++k) dst[m][k] = *(const PG8_LAS bf16x8*)(lds + PG8_SA(b, h) + aoff + m * 2048 + k * 1024); } while (0)
#define PG8_LDB(dst, b, h) do { _Pragma("unroll") for (int n = 0; n < 2; ++n) _Pragma("unroll") for (int k = 0; k < 2; ++k) dst[n][k] = *(const PG8_LAS bf16x8*)(lds + PG8_SB(b, h) + boff + n * 2048 + k * 1024); } while (0)
#define PG8_MMA(ai, bj, At, Bt) do { __builtin_amdgcn_s_setprio(1); _Pragma("unroll") for (int m = 0; m < 4; ++m) _Pragma("unroll") for (int n = 0; n < 2; ++n) _Pragma("unroll") for (int k = 0; k < 2; ++k) \
        acc[ai][bj][m][n] = __builtin_amdgcn_mfma_f32_16x16x32_bf16(Bt[n][k], At[m][k], acc[ai][bj][m][n], 0, 0, 0); __builtin_amdgcn_s_setprio(0); } while (0)
#define PG8_WAIT_V(n) asm volatile("s_waitcnt vmcnt(" #n ")" ::: "memory")
#define PG8_WAIT_L(n) asm volatile("s_waitcnt lgkmcnt(" #n ")" ::: "memory")
#define PG8_BAR __builtin_amdgcn_s_barrier()
#define PG8_SCHED __builtin_amdgcn_sched_barrier(0)
    Unit cur, nxt; int ui = 0;
    if (!S.next(0, cur)) return;
    f32x4 acc[2][2][4][2];
#pragma unroll
    for (int a = 0; a < 2; ++a)
#pragma unroll
        for (int b = 0; b < 2; ++b)
#pragma unroll
            for (int m = 0; m < 4; ++m)
#pragma unroll
                for (int n = 0; n < 2; ++n) acc[a][b][m][n] = (f32x4){0.f, 0.f, 0.f, 0.f};
    bf16x8 At[4][2], B0[2][2], B1[2][2];
    const char* cA = (const char*)g.A + (size_t)cur.pm * tstep; const char* cB = (const char*)g.Bt + (size_t)cur.pn * tstep;
    S.a_ready(cur);
    if constexpr (SP2) {
        PG8_STAGE(PG8_SB(0, 0), cB, voffB); PG8_STAGE(PG8_SB(0, 1), cB + hstep, voffB); PG8_STAGE(PG8_SA(0, 0), cA, voffA); PG8_STAGE(PG8_SA(0, 1), cA + hstep, voffA);
        if (wr == 1) PG8_BAR;
        PG8_WAIT_V(2); PG8_BAR;
        PG8_STAGE(PG8_SB(1, 0), cB + kstep, voffB); PG8_STAGE(PG8_SA(1, 0), cA + kstep, voffA); PG8_STAGE(PG8_SB(1, 1), cB + hstep + kstep, voffB);
        PG8_WAIT_V(6); PG8_BAR;
    } else {
        PG8_STAGE(PG8_SB(0, 0), cB, voffB); PG8_STAGE(PG8_SA(0, 0), cA, voffA); PG8_STAGE(PG8_SB(0, 1), cB + hstep, voffB); PG8_STAGE(PG8_SA(0, 1), cA + hstep, voffA);
        if (wr == 1) PG8_BAR;
        PG8_WAIT_V(4); PG8_BAR;
        PG8_STAGE(PG8_SB(1, 0), cB + kstep, voffB); PG8_STAGE(PG8_SA(1, 0), cA + kstep, voffA); PG8_STAGE(PG8_SB(1, 1), cB + hstep + kstep, voffB);
        PG8_WAIT_V(6); PG8_BAR;
    }
    for (;;) {
        const bool has_next = S.next(ui + 1, nxt);
        const char* nA = has_next ? (const char*)g.A + (size_t)nxt.pm * tstep : cA; const char* nB = has_next ? (const char*)g.Bt + (size_t)nxt.pn * tstep : cB;
        for (int t = 0; t < nt; t += 2) {
            const bool last = (t == nt - 2);
            const char* a1 = cA + (size_t)(t + 1) * kstep;
            const char* a2 = last ? nA : cA + (size_t)(t + 2) * kstep; const char* b2 = last ? nB : cB + (size_t)(t + 2) * kstep;
            const char* a3 = a2 + kstep; const char* b3 = b2 + kstep;
            if (last && has_next) S.a_ready(nxt);
            if constexpr (SP2) {
            PG8_LDB(B0, 0, 0); PG8_LDB(B1, 0, 1); PG8_SCHED; PG8_LDA(At, 0, 0); PG8_STAGE(PG8_SA(1, 1), a1 + hstep, voffA);
            PG8_WAIT_V(8); PG8_WAIT_L(0); PG8_BAR; PG8_MMA(0, 0, At, B0); PG8_MMA(0, 1, At, B1); PG8_BAR; PG8_SCHED;
            PG8_LDA(At, 0, 1); PG8_STAGE(PG8_SB(0, 0), b2, voffB); PG8_STAGE(PG8_SB(0, 1), b2 + hstep, voffB); PG8_STAGE(PG8_SA(0, 0), a2, voffA);
            PG8_WAIT_V(8); PG8_WAIT_L(0); PG8_BAR; PG8_MMA(1, 0, At, B0); PG8_MMA(1, 1, At, B1); PG8_BAR; PG8_SCHED;
            PG8_LDB(B0, 1, 0); PG8_LDB(B1, 1, 1); PG8_SCHED; PG8_LDA(At, 1, 0); PG8_STAGE(PG8_SA(0, 1), a2 + hstep, voffA);
            PG8_WAIT_V(8); PG8_WAIT_L(0); PG8_BAR; PG8_MMA(0, 0, At, B0); PG8_MMA(0, 1, At, B1); PG8_BAR; PG8_SCHED;
            PG8_LDA(At, 1, 1); PG8_STAGE(PG8_SB(1, 0), b3, voffB); PG8_STAGE(PG8_SB(1, 1), b3 + hstep, voffB); PG8_STAGE(PG8_SA(1, 0), a3, voffA);
            PG8_WAIT_V(8); PG8_WAIT_L(0); PG8_BAR; PG8_MMA(1, 0, At, B0); PG8_MMA(1, 1, At, B1); PG8_BAR; PG8_SCHED;
            } else {
            PG8_LDB(B0, 0, 0); PG8_SCHED; PG8_LDA(At, 0, 0); PG8_STAGE(PG8_SA(1, 1), a1 + hstep, voffA);
            PG8_WAIT_L(8); PG8_BAR; PG8_WAIT_L(0); PG8_MMA(0, 0, At, B0); PG8_BAR; PG8_SCHED;
            PG8_LDB(B1, 0, 1); PG8_STAGE(PG8_SB(0, 0), b2, voffB);
            PG8_BAR; PG8_WAIT_L(0); PG8_MMA(0, 1, At, B1); PG8_BAR;
            PG8_LDA(At, 0, 1); PG8_STAGE(PG8_SA(0, 0), a2, voffA);
            PG8_BAR; PG8_WAIT_L(0); PG8_MMA(1, 0, At, B0); PG8_BAR; PG8_SCHED;
            PG8_STAGE(PG8_SB(0, 1), b2 + hstep, voffB);
            PG8_WAIT_V(6); PG8_BAR; PG8_MMA(1, 1, At, B1); PG8_BAR;
            PG8_LDB(B0, 1, 0); PG8_SCHED; PG8_LDA(At, 1, 0); PG8_STAGE(PG8_SA(0, 1), a2 + hstep, voffA);
            PG8_WAIT_L(8); PG8_BAR; PG8_WAIT_L(0); PG8_MMA(0, 0, At, B0); PG8_BAR; PG8_SCHED;
            PG8_LDB(B1, 1, 1); PG8_STAGE(PG8_SB(1, 0), b3, voffB);
            PG8_BAR; PG8_WAIT_L(0); PG8_MMA(0, 1, At, B1); PG8_BAR;
            PG8_LDA(At, 1, 1); PG8_STAGE(PG8_SA(1, 0), a3, voffA);
            PG8_BAR; PG8_WAIT_L(0); PG8_MMA(1, 0, At, B0); PG8_BAR; PG8_SCHED;
            PG8_STAGE(PG8_SB(1, 1), b3 + hstep, voffB);
            PG8_WAIT_V(6); PG8_BAR; PG8_MMA(1, 1, At, B1); PG8_BAR;
            }
        }
        if constexpr (ALIGN_EPI) { if (wr == 0) PG8_BAR; }
        if constexpr (!Epi::AFTER_DRAIN) { E(acc, cur, wr, wc, fr, fq); S.done(cur); }
        if (!has_next) break;
#pragma unroll
        for (int a = 0; a < 2; ++a)
#pragma unroll
            for (int b = 0; b < 2; ++b)
#pragma unroll
                for (int m = 0; m < 4; ++m)
#pragma unroll
                    for (int n = 0; n < 2; ++n) acc[a][b][m][n] = (f32x4){0.f, 0.f, 0.f, 0.f};
        cur = nxt; cA = nA; cB = nB; ++ui;
        if constexpr (ALIGN_EPI) { if (wr == 1) PG8_BAR; }
    }
    PG8_WAIT_V(0);
    if constexpr (!ALIGN_EPI) { if (wr == 0) PG8_BAR; }
    PG8_BAR;
    if constexpr (Epi::AFTER_DRAIN) { E.fused(acc, cur, wr, wc, fr, fq, lds, wid, lane); S.done(cur); }
#undef PG8_SA
#undef PG8_SB
#undef PG8_STAGE
#undef PG8_LDA
#undef PG8_LDB
#undef PG8_MMA
#undef PG8_WAIT_V
#undef PG8_WAIT_L
#undef PG8_BAR
#undef PG8_SCHED
}

template <class Epi, class Sched, int K1, int K2>
__device__ __forceinline__ void gemm_dual(PG8_LAS unsigned char* lds, const Gemm g1, const Gemm g2, const Sched& S, const Epi& E) {
    const int tid = threadIdx.x, wid = __builtin_amdgcn_readfirstlane(tid >> 6), lane = tid & 63, wr = wid >> 2, wc = wid & 3, fr = lane & 15, fq = lane >> 4;
    static_assert(K1 == 1024 && K2 == 512, "offset trick below"); constexpr int nt1 = K1 / BK, nt = nt1 + K2 / BK;
    unsigned voffA1[2], voffB1[2];
#pragma unroll
    for (int i = 0; i < 2; ++i) { int R, C; stage_rc(tid * 16 + i * 8192, R, C); const int Rb = Epi::PERM ? ((R & ~31) + perm32(R & 31)) : R;
        voffA1[i] = (unsigned)(R * K1 + C) * 2u; voffB1[i] = (unsigned)(Rb * K1 + C) * 2u; }
    constexpr size_t kstep = (size_t)(BK * 2), hstep1 = (size_t)HALF * K1 * 2, hstep2 = (size_t)HALF * K2 * 2;
    const unsigned ldsw = (unsigned)wid * 1024u;
    const int aoff = lds_byte(wr * 64 + fr, fq * 8), boff = lds_byte(wc * 32 + fr, fq * 8);
#define PG8_SA(b, h) (((b) * 2 + (h)) * HTB)
#define PG8_SB(b, h) ((4 + (b) * 2 + (h)) * HTB)
#define PG8_STAGE(bufoff, gbase, voff) do { _Pragma("unroll") for (int _i = 0; _i < 2; ++_i) \
        __builtin_amdgcn_global_load_lds((const unsigned*)((const char*)(gbase) + (voff)[_i]), (PG8_LAS unsigned*)(lds + (bufoff) + ldsw + _i * 8192), 16, 0, 0); } while (0)
#define PG8_STAGE2(bufoff, gbase, voff) do { _Pragma("unroll") for (int _i = 0; _i < 2; ++_i) \
        __builtin_amdgcn_global_load_lds((const unsigned*)((const char*)(gbase) + (((voff)[_i] >> 11) << 10) + ((voff)[_i] & 2047u)), (PG8_LAS unsigned*)(lds + (bufoff) + ldsw + _i * 8192), 16, 0, 0); } while (0)
#define PG8_STAGE_A(bufoff, tau, half) do { if ((tau) < nt1) PG8_STAGE(bufoff, cA1 + (size_t)(tau) * kstep + (half) * hstep1, voffA1); else PG8_STAGE2(bufoff, cA2 + (size_t)((tau) - nt1) * kstep + (half) * hstep2, voffA1); } while (0)
#define PG8_STAGE_B(bufoff, tau, half) do { if ((tau) < nt1) PG8_STAGE(bufoff, cB1 + (size_t)(tau) * kstep + (half) * hstep1, voffB1); else PG8_STAGE2(bufoff, cB2 + (size_t)((tau) - nt1) * kstep + (half) * hstep2, voffB1); } while (0)
#define PG8_LDA(dst, b, h) do { _Pragma("unroll") for (int m = 0; m < 4; ++m) _Pragma("unroll") for (int k = 0; k < 2; ++k) dst[m][k] = *(const PG8_LAS bf16x8*)(lds + PG8_SA(b, h) + aoff + m * 2048 + k * 1024); } while (0)
#define PG8_LDB(dst, b, h) do { _Pragma("unroll") for (int n = 0; n < 2; ++n) _Pragma("unroll") for (int k = 0; k < 2; ++k) dst[n][k] = *(const PG8_LAS bf16x8*)(lds + PG8_SB(b, h) + boff + n * 2048 + k * 1024); } while (0)
#define PG8_MMA(ai, bj, At, Bt) do { __builtin_amdgcn_s_setprio(1); _Pragma("unroll") for (int m = 0; m < 4; ++m) _Pragma("unroll") for (int n = 0; n < 2; ++n) _Pragma("unroll") for (int k = 0; k < 2; ++k) \
        acc[ai][bj][m][n] = __builtin_amdgcn_mfma_f32_16x16x32_bf16(Bt[n][k], At[m][k], acc[ai][bj][m][n], 0, 0, 0); __builtin_amdgcn_s_setprio(0); } while (0)
#define PG8_WAIT_V(n) asm volatile("s_waitcnt vmcnt(" #n ")" ::: "memory")
#define PG8_WAIT_L(n) asm volatile("s_waitcnt lgkmcnt(" #n ")" ::: "memory")
#define PG8_BAR __builtin_amdgcn_s_barrier()
#define PG8_SCHED __builtin_amdgcn_sched_barrier(0)
    Unit cur;
    if (!S.next(0, cur)) return;
    f32x4 acc[2][2][4][2];
#pragma unroll
    for (int a = 0; a < 2; ++a)
#pragma unroll
        for (int b = 0; b < 2; ++b)
#pragma unroll
            for (int m = 0; m < 4; ++m)
#pragma unroll
                for (int n = 0; n < 2; ++n) acc[a][b][m][n] = (f32x4){0.f, 0.f, 0.f, 0.f};
    bf16x8 At[4][2], B0[2][2], B1[2][2];
    const char* cA1 = (const char*)g1.A + (size_t)cur.pm * 2 * hstep1; const char* cB1 = (const char*)g1.Bt + (size_t)cur.pn * 2 * hstep1;
    const char* cA2 = (const char*)g2.A + (size_t)cur.pm * 2 * hstep2; const char* cB2 = (const char*)g2.Bt + (size_t)cur.pn * 2 * hstep2;
    PG8_STAGE_B(PG8_SB(0, 0), 0, 0); PG8_STAGE_B(PG8_SB(0, 1), 0, 1); PG8_STAGE_A(PG8_SA(0, 0), 0, 0); PG8_STAGE_A(PG8_SA(0, 1), 0, 1);
    if (wr == 1) PG8_BAR;
    PG8_WAIT_V(2); PG8_BAR;
    PG8_STAGE_B(PG8_SB(1, 0), 1, 0); PG8_STAGE_A(PG8_SA(1, 0), 1, 0); PG8_STAGE_B(PG8_SB(1, 1), 1, 1);
    PG8_WAIT_V(6); PG8_BAR;
#define PG8_DUAL_TRIP(t) do { \
        const int t2 = (t == nt - 2) ? 0 : t + 2, t3 = t2 + 1; \
        PG8_LDB(B0, 0, 0); PG8_LDB(B1, 0, 1); PG8_SCHED; PG8_LDA(At, 0, 0); PG8_STAGE_A(PG8_SA(1, 1), t + 1, 1); \
        PG8_WAIT_V(8); PG8_WAIT_L(0); PG8_BAR; PG8_MMA(0, 0, At, B0); PG8_MMA(0, 1, At, B1); PG8_BAR; PG8_SCHED; \
        PG8_LDA(At, 0, 1); PG8_STAGE_B(PG8_SB(0, 0), t2, 0); PG8_STAGE_B(PG8_SB(0, 1), t2, 1); PG8_STAGE_A(PG8_SA(0, 0), t2, 0); \
        PG8_WAIT_V(8); PG8_WAIT_L(0); PG8_BAR; PG8_MMA(1, 0, At, B0); PG8_MMA(1, 1, At, B1); PG8_BAR; PG8_SCHED; \
        PG8_LDB(B0, 1, 0); PG8_LDB(B1, 1, 1); PG8_SCHED; PG8_LDA(At, 1, 0); PG8_STAGE_A(PG8_SA(0, 1), t2, 1); \
        PG8_WAIT_V(8); PG8_WAIT_L(0); PG8_BAR; PG8_MMA(0, 0, At, B0); PG8_MMA(0, 1, At, B1); PG8_BAR; PG8_SCHED; \
        PG8_LDA(At, 1, 1); PG8_STAGE_B(PG8_SB(1, 0), t3, 0); PG8_STAGE_B(PG8_SB(1, 1), t3, 1); PG8_STAGE_A(PG8_SA(1, 0), t3, 0); \
        PG8_WAIT_V(8); PG8_WAIT_L(0); PG8_BAR; PG8_MMA(1, 0, At, B0); PG8_MMA(1, 1, At, B1); PG8_BAR; PG8_SCHED; \
    } while (0)
    for (int t = 0; t < nt1; t += 2) PG8_DUAL_TRIP(t);
    E.mid(acc, cur, wr, wc, fr, fq);
    for (int t = nt1; t < nt; t += 2) PG8_DUAL_TRIP(t);
#undef PG8_DUAL_TRIP
    E(acc, cur, wr, wc, fr, fq);
    PG8_WAIT_V(0);
    if (wr == 0) PG8_BAR;
    PG8_BAR;
#undef PG8_SA
#undef PG8_SB
#undef PG8_STAGE
#undef PG8_STAGE2
#undef PG8_STAGE_A
#undef PG8_STAGE_B
#undef PG8_LDA
#undef PG8_LDB
#undef PG8_MMA
#undef PG8_WAIT_V
#undef PG8_WAIT_L
#undef PG8_BAR
#undef PG8_SCHED
}
}
#define GAS __attribute__((address_space(1)))
#define LAS __attribute__((address_space(3)))
typedef unsigned short bf16;
typedef unsigned v4u __attribute__((ext_vector_type(4)));
typedef float f32x4 __attribute__((ext_vector_type(4)));
typedef short bf16x8 __attribute__((ext_vector_type(8)));
typedef GAS unsigned gu32;
typedef GAS unsigned long long gu64;
#define RLX_AGENT __ATOMIC_RELAXED, __HIP_MEMORY_SCOPE_AGENT
#define LDS_WAIT() asm volatile("s_waitcnt lgkmcnt(0)" ::: "memory")
#define VM_WAIT() asm volatile("s_waitcnt vmcnt(0)" ::: "memory")
__device__ __forceinline__ unsigned long long rt() { return __builtin_amdgcn_s_memrealtime(); }
__device__ __forceinline__ unsigned f2bf(float f) { unsigned u = __builtin_bit_cast(unsigned, f); return (u + 0x7fffu + ((u >> 16) & 1u)) >> 16; }
typedef __bf16 bf16x2_t __attribute__((ext_vector_type(2)));
typedef float f32x2p __attribute__((ext_vector_type(2)));
__device__ __forceinline__ unsigned pk2(float lo, float hi) { const f32x2p v = {lo, hi}; const bf16x2_t b = __builtin_convertvector(v, bf16x2_t); return __builtin_bit_cast(unsigned, b); }

#define XB_TMO      128
#define XB_XCNT(j)  (256  + 64 * (j))
#define XB_XSUB(j)  (1280 + 64 * (j))
#define XB_XGEN(j)  (2304 + 64 * (j))
#define XB_TOP      3328
#define XB_TOPGEN   3392
#define XCD_BAR_WORDS 3456
#define XB_SPIN_CAP (1u << 18)

__device__ __forceinline__ unsigned xb_ld(unsigned* p)              { return __hip_atomic_load(p, __ATOMIC_RELAXED, __HIP_MEMORY_SCOPE_AGENT); }
__device__ __forceinline__ unsigned xb_add(unsigned* p, unsigned v) { return __hip_atomic_fetch_add(p, v, __ATOMIC_RELAXED, __HIP_MEMORY_SCOPE_AGENT); }
__device__ __forceinline__ unsigned xb_xcc_id() { return (unsigned)__builtin_amdgcn_s_getreg((3 << 11) | 20) & 0xFu; }
#define XB_SPIN(cond, bar) do { unsigned _sp = 0; while (cond) { __builtin_amdgcn_s_sleep(1); \
    if ((++_sp & 255u) == 0u) { if (xb_ld(&(bar)[XB_TMO])) break; if (_sp > XB_SPIN_CAP) { atomicAdd(&(bar)[XB_TMO], 1u); break; } } } } while (0)

struct XcdBarrier {
    unsigned* bar; unsigned x; unsigned ngrp;
    volatile LAS unsigned* st;
};

__device__ __forceinline__ XcdBarrier xcd_barrier_post(unsigned* bar, volatile LAS unsigned* st) {
    XcdBarrier b; b.bar = bar; b.x = xb_xcc_id(); b.st = st; b.ngrp = 0u;
    if (threadIdx.x == 0) (void)xb_add(&bar[XB_XCNT(b.x)], 1u);
    return b;
}
__device__ __forceinline__ void xcd_barrier_complete(unsigned* bar, unsigned x, unsigned& nloc, unsigned& nx, unsigned ngrp) {
    const unsigned G = ngrp ? ngrp : gridDim.x * gridDim.y * gridDim.z;
    unsigned sum, cnt, mine, sp = 0u;
    for (;;) {
        sum = 0u; cnt = 0u; mine = 0u;
#pragma unroll
        for (unsigned j = 0; j < 16; ++j) { const unsigned c = xb_ld(&bar[XB_XCNT(j)]); sum += c; cnt += (c > 0u) ? 1u : 0u; mine = (j == x) ? c : mine; }
        if (sum == G) break;
        __builtin_amdgcn_s_sleep(1);
        if ((++sp & 255u) == 0u) { if (xb_ld(&bar[XB_TMO])) break; if (sp > XB_SPIN_CAP) { atomicAdd(&bar[XB_TMO], 1u); break; } }
    }
    nloc = mine > 0u ? mine : 1u; nx = cnt > 0u ? cnt : 1u;
}

__device__ __forceinline__ void xcd_barrier(const XcdBarrier& b) {
    asm volatile("s_waitcnt vmcnt(0)" ::: "memory");
    __syncthreads();
    if (threadIdx.x == 0) {
        unsigned* bar = b.bar;
        __builtin_amdgcn_s_waitcnt(0);
        unsigned nloc = b.st[0], nx = b.st[1];
        if (nloc == 0u) { xcd_barrier_complete(bar, b.x, nloc, nx, b.ngrp); b.st[0] = nloc; b.st[1] = nx; }
        const unsigned old = xb_add(&bar[XB_XSUB(b.x)], 1u);
        const unsigned gen = old / nloc;
        if (old + 1u == (gen + 1u) * nloc) {
            __builtin_amdgcn_fence(__ATOMIC_RELEASE, "agent");
            asm volatile("s_waitcnt vmcnt(0)" ::: "memory");
            const unsigned og = xb_add(&bar[XB_TOP], 1u);
            const unsigned tg = og / nx;
            if (og + 1u == (tg + 1u) * nx) xb_add(&bar[XB_TOPGEN], 1u);
            else XB_SPIN(xb_ld(&bar[XB_TOPGEN]) == tg, bar);
            __builtin_amdgcn_fence(__ATOMIC_ACQUIRE, "agent");
            xb_add(&bar[XB_XGEN(b.x)], 1u);
            asm volatile("s_waitcnt vmcnt(0)" ::: "memory");
        } else {
            XB_SPIN(xb_ld(&bar[XB_XGEN(b.x)]) == gen, bar);
            __builtin_amdgcn_fence(__ATOMIC_ACQUIRE, "agent");
            asm volatile("s_waitcnt vmcnt(0)" ::: "memory");
        }
    }
    __syncthreads();
}
constexpr int NWAVES = 8, NTHR = 512;
#ifndef MK_PER_PHASE
#define MK_PER_PHASE 0
#endif
constexpr int NPHASE = 8;
constexpr int BATCH = 2, SEQ = 8192, D = 1024, T = BATCH * SEQ, LCTX = 256, TCX = BATCH * LCTX, MROWS = T + TCX;
constexpr int NH = 8, CHK = 64, NCHL = SEQ / CHK, NCHC = LCTX / CHK, NCH = NCHL + NCHC;
constexpr int INW = 7200, NPAD = 7424;
constexpr float EPS = 1e-6f;
constexpr size_t MiB = 1u << 20;
constexpr size_t WS_CTL = 0, CTL_ZERO_BYTES = 1 * MiB, CTL_GRAN = 256 * 1024;
constexpr size_t WS_TAB = 1 * MiB;
constexpr size_t TAB_MODP = 0, TAB_GATE = 589824, TAB_ABAR = 598016, TAB_A64 = 630784, TAB_BBAR = 663552, TAB_BBT = 1187840, TAB_CBT = 1449984;
constexpr size_t WS_WIN = 3 * MiB, WS_WPD = WS_WIN + (size_t)NPAD * D * 2, WS_WPS = WS_WPD + 2 * MiB, WS_WOUT = WS_WPS + 1 * MiB, WS_GLU = WS_WOUT + 2 * MiB;
constexpr size_t WS_QKV = 23 * MiB, WS_QKVC = 119 * MiB, WS_U = 122 * MiB, WS_BD = WS_U + (size_t)MROWS * 512 * 2, WS_RG = 141 * MiB, WS_CTXTA = 253 * MiB, WS_END = 254 * MiB;
static_assert(WS_GLU + 512 * 512 * 2 <= WS_QKV && WS_BD + (size_t)MROWS * 32 * 4 <= WS_RG, "ws map");
constexpr size_t WS_TA = WS_RG, WS_ODIR = WS_RG + 32 * MiB, WS_YDN = WS_RG, WS_M1 = WS_RG + 32 * MiB, WS_MERGED = WS_RG + 64 * MiB, WS_ZS5 = WS_RG + 96 * MiB;
constexpr size_t WS_QKVC_RAW = WS_RG + 32 * MiB;
constexpr size_t WS_ZDN = WS_QKV, WS_GDN = WS_QKV + 32 * MiB, WS_GS5 = WS_QKV + 64 * MiB, WS_YS5 = WS_U;
constexpr size_t DO_H = 0, DO_SC = 33 * MiB, DO_EH = 38 * MiB, DO_Y = 47 * MiB;
constexpr int SCBLK = 256;
constexpr int CW_BAR = 4096, CW_BAR2 = 8192, CW_PAN = 16384, CW_PAN2 = 20480, CW_PAN3 = 24576;
constexpr int RING_BYTES = 143360, LDSCTL_OFF = RING_BYTES, MISC_OFF = LDSCTL_OFF + 320, LDS_BYTES = 147456;
typedef float f32x2 __attribute__((ext_vector_type(2)));
typedef unsigned v2u __attribute__((ext_vector_type(2)));
#define MFMA16(a, b, c) __builtin_amdgcn_mfma_f32_16x16x32_bf16((a), (b), (c), 0, 0, 0)
__device__ __forceinline__ int off256(int row, int slot) { return row * 256 + ((slot ^ (row & 15)) << 4); }
__device__ __forceinline__ int off128(int row, int slot) { return row * 128 + ((slot ^ ((row >> 1) & 7)) << 4); }
__device__ __forceinline__ int img128_byte(int oi, int oj) { return off128(oi, 4 * (oj >> 5) + ((oj >> 2) & 3)) + 8 * ((oj >> 4) & 1) + 2 * (oj & 3); }
typedef short s16x4 __attribute__((ext_vector_type(4)));
__device__ __forceinline__ s16x4 ds_tr(const LAS unsigned char* p) { return __builtin_bit_cast(s16x4, __builtin_amdgcn_ds_read_tr16_b64_v4i16((LAS s16x4*)p)); }
__device__ __forceinline__ unsigned cvtpk_c(float lo, float hi) { const f32x2 v = {lo, hi}; const bf16x2_t b = __builtin_convertvector(v, bf16x2_t); return __builtin_bit_cast(unsigned, b); }
__device__ __forceinline__ float bf2f(unsigned v) { return __builtin_bit_cast(float, v << 16); }
__device__ __forceinline__ float sigmoidf_(float x) { return __builtin_amdgcn_rcpf(1.f + __expf(-x)); }
__device__ __forceinline__ float siluf_(float x) { return x * __builtin_amdgcn_rcpf(1.f + __expf(-x)); }
__device__ __forceinline__ float softplusf_(float x) { return x > 20.f ? x : log1pf(__expf(x)); }
__device__ __forceinline__ float gelu_tanh(float x) { const float u = 0.7978845608028654f * (x + 0.044715f * x * x * x); const float e = __expf(2.f * u); const float th = 1.f - 2.f * __builtin_amdgcn_rcpf(e + 1.f); return 0.5f * x * (1.f + th); }
__device__ __forceinline__ void unpack8(const v4u r, float* f) { f[0] = bf2f(r.x & 0xffffu); f[1] = bf2f(r.x >> 16); f[2] = bf2f(r.y & 0xffffu); f[3] = bf2f(r.y >> 16); f[4] = bf2f(r.z & 0xffffu); f[5] = bf2f(r.z >> 16); f[6] = bf2f(r.w & 0xffffu); f[7] = bf2f(r.w >> 16); }
__device__ __forceinline__ v4u pack8(const float* f) { v4u o; o.x = pk2(f[0], f[1]); o.y = pk2(f[2], f[3]); o.z = pk2(f[4], f[5]); o.w = pk2(f[6], f[7]); return o; }
__device__ __forceinline__ float wave_sum(float v) {
#pragma unroll
    for (int o = 1; o < 64; o <<= 1) v += __shfl_xor(v, o);
    return v;
}

__device__ __forceinline__ float dpp_add(float x, int ctrl_sel) {
    const int xi = __builtin_bit_cast(int, x); int yi;
    if (ctrl_sel == 0) yi = __builtin_amdgcn_update_dpp(0, xi, 0xB1, 0xF, 0xF, false);
    else if (ctrl_sel == 1) yi = __builtin_amdgcn_update_dpp(0, xi, 0x4E, 0xF, 0xF, false);
    else if (ctrl_sel == 2) yi = __builtin_amdgcn_update_dpp(0, xi, 0x141, 0xF, 0xF, false);
    else yi = __builtin_amdgcn_update_dpp(0, xi, 0x140, 0xF, 0xF, false);
    return x + __builtin_bit_cast(float, yi);
}
__device__ __forceinline__ float sum8(float x) { x = dpp_add(x, 0); x = dpp_add(x, 1); return dpp_add(x, 2); }
__device__ __forceinline__ float sum16(float x) { return dpp_add(sum8(x), 3); }
struct Frame {
    LAS unsigned char* lds;
    int tid, lane, wave, vcu, G;
    const float* in[26]; float* out; unsigned char* ws;
};
#define WSP(T_, off) ((T_*)(F.ws + (off)))
#define DOP(T_, off) ((T_*)((unsigned char*)F.out + (off)))
#define TABP(T_, off) ((T_*)(F.ws + WS_TAB + (off)))
enum { I_X = 0, I_C, I_CTX, I_CCTX, I_WADA, I_BADA, I_NORMW, I_WIN, I_CONVW, I_ALOG, I_DTB, I_DNNW, I_LRE, I_LIM, I_LSTEP, I_BRE, I_BIM, I_CRE, I_CIM, I_S5D, I_GLUW, I_GLUB, I_WPD, I_WPS, I_WOUT, I_FNW };

template <int NB> __device__ __forceinline__ void tr_item(const float* W, int K, int N, bf16* WT, LAS float* scr, int k0, int sn0, int dn0, int lane) {
#pragma unroll
    for (int hh = 0; hh < 32 / NB; ++hh) { float tv[NB];
#pragma unroll
        for (int i = 0; i < NB; ++i) tv[i] = __builtin_nontemporal_load(&W[(size_t)(k0 + 2 * (NB * hh + i) + (lane >> 5)) * N + sn0 + (lane & 31)]);
#pragma unroll
        for (int i = 0; i < NB; ++i) scr[(2 * (NB * hh + i) + (lane >> 5)) * 33 + (lane & 31)] = tv[i]; }
    LDS_WAIT(); asm volatile("" ::: "memory");
    const int c = lane & 7;
#pragma unroll
    for (int j = 0; j < 4; ++j) { const int n = (lane >> 3) + 8 * j; const LAS float* s = scr + (8 * c) * 33 + n;
        v4u o; o.x = pk2(s[0 * 33], s[1 * 33]); o.y = pk2(s[2 * 33], s[3 * 33]); o.z = pk2(s[4 * 33], s[5 * 33]); o.w = pk2(s[6 * 33], s[7 * 33]);
        *(v4u*)(WT + (size_t)(dn0 + n) * K + k0 + 8 * c) = o; }
    LDS_WAIT(); asm volatile("" ::: "memory");
}
struct TrDesc { const float* W; bf16* WT; int K, N, k0, sn0, dn0; };
__device__ __forceinline__ void tr_load(const TrDesc& d, float (&tv)[32], int lane) {
#pragma unroll
    for (int i = 0; i < 32; ++i) tv[i] = __builtin_nontemporal_load(&d.W[(size_t)(d.k0 + 2 * i + (lane >> 5)) * d.N + d.sn0 + (lane & 31)]);
}
__device__ __forceinline__ void tr_emit(const TrDesc& d, const float (&tv)[32], LAS float* scr, int lane) {
#pragma unroll
    for (int i = 0; i < 32; ++i) scr[(2 * i + (lane >> 5)) * 33 + (lane & 31)] = tv[i];
    LDS_WAIT(); asm volatile("" ::: "memory");
    const int c = lane & 7;
#pragma unroll
    for (int j = 0; j < 4; ++j) { const int n = (lane >> 3) + 8 * j; const LAS float* s = scr + (8 * c) * 33 + n;
        v4u o; o.x = pk2(s[0 * 33], s[1 * 33]); o.y = pk2(s[2 * 33], s[3 * 33]); o.z = pk2(s[4 * 33], s[5 * 33]); o.w = pk2(s[6 * 33], s[7 * 33]);
        __builtin_nontemporal_store(o, (v4u*)(d.WT + (size_t)(d.dn0 + n) * d.K + d.k0 + 8 * c)); }
    LDS_WAIT(); asm volatile("" ::: "memory");
}
template <int PART> __device__ __forceinline__ void phase0(Frame& F, int gw, int NGW, int item_lo = 0, int item_hi = 1 << 30, int scr_off = 0, int scr_stride = 16384) {
    LAS float* scr = (LAS float*)(F.lds + scr_off + F.wave * scr_stride);
    const int lane = F.lane;
    constexpr int N_PD = 512, N_PS = 256, N_OUT = 512, N_GLU = 128, N_Z = 28, N_MOD = 768, N_S5 = 64, SB_EARLY = 113, N_WE = 16 * SB_EARLY, N_WL = 16 * (225 - SB_EARLY), N_WIN = 16 * 225;
    constexpr int N_LATE = N_PD + N_PS + N_OUT + N_GLU, N_ALL = PART == 1 ? N_LATE : (PART == 2 ? N_WL : (PART == 6 ? N_S5 : (PART == 3 ? N_WE : N_Z + N_MOD)));
    if constexpr (PART == 1 || PART == 2) {
#define TR_EACH(it_, OP, tv_) do { const int i_ = (it_); \
            if (PART == 2) { const int nsb = 225 - SB_EARLY, kb = i_ / nsb, sb = i_ % nsb + SB_EARLY; const TrDesc d_{F.in[I_WIN], WSP(bf16, WS_WIN), 1024, INW, kb * 64, sb * 32, (sb - 1) * 32}; OP(d_, tv_); } \
            else if (i_ < N_PD) { const TrDesc d_{F.in[I_WPD], WSP(bf16, WS_WPD), 1024, 1024, (i_ / 32) * 64, (i_ % 32) * 32, (i_ % 32) * 32}; OP(d_, tv_); } \
            else if (i_ < N_PD + N_PS) { const int r = i_ - N_PD; const TrDesc d_{F.in[I_WPS], WSP(bf16, WS_WPS), 512, 1024, (r / 32) * 64, (r % 32) * 32, (r % 32) * 32}; OP(d_, tv_); } \
            else if (i_ < N_PD + N_PS + N_OUT) { const int r = i_ - N_PD - N_PS; const TrDesc d_{F.in[I_WOUT], WSP(bf16, WS_WOUT), 1024, 1024, (r / 32) * 64, (r % 32) * 32, (r % 32) * 32}; OP(d_, tv_); } \
            else { const int r = i_ - N_PD - N_PS - N_OUT; const TrDesc d_{F.in[I_GLUW], WSP(bf16, WS_GLU), 512, 512, (r / 16) * 64, (r % 16) * 32, (r % 16) * 32}; OP(d_, tv_); } } while (0)
#define TR_LD(d_, tv_) tr_load(d_, tv_, lane)
#define TR_EM(d_, tv_) tr_emit(d_, tv_, scr, lane)
        const int hi = item_hi < N_ALL ? item_hi : N_ALL;
        for (int it = item_lo + gw; it < hi; it += 2 * NGW) {
            const bool two = it + NGW < hi;
            float ta[32], tb[32]; TR_EACH(it, TR_LD, ta); if (two) TR_EACH(it + NGW, TR_LD, tb);
            asm volatile("" ::: "memory");
            TR_EACH(it, TR_EM, ta); if (two) TR_EACH(it + NGW, TR_EM, tb);
        }
#undef TR_EACH
#undef TR_LD
#undef TR_EM
        return;
    }
    for (int it = gw; it < N_ALL; it += NGW) {
        if (PART == 2 || PART == 3) {
            const int nsb = PART == 2 ? 225 - SB_EARLY : SB_EARLY, kb = it / nsb, sb = it % nsb + (PART == 2 ? SB_EARLY : 0), db = sb < 96 ? sb : (sb == 96 ? 224 : sb - 1);
            tr_item<32>(F.in[I_WIN], 1024, INW, WSP(bf16, WS_WIN), scr, kb * 64, sb * 32, db * 32, lane); continue; }
        int r = PART == 1 ? it : (PART == 6 ? it + N_LATE + N_Z + N_MOD : it + N_LATE);
        if (r < N_PD) { tr_item<32>(F.in[I_WPD], 1024, 1024, WSP(bf16, WS_WPD), scr, (r / 32) * 64, (r % 32) * 32, (r % 32) * 32, lane); continue; } r -= N_PD;
        if (r < N_PS) { tr_item<32>(F.in[I_WPS], 512, 1024, WSP(bf16, WS_WPS), scr, (r / 32) * 64, (r % 32) * 32, (r % 32) * 32, lane); continue; } r -= N_PS;
        if (r < N_OUT) { tr_item<32>(F.in[I_WOUT], 1024, 1024, WSP(bf16, WS_WOUT), scr, (r / 32) * 64, (r % 32) * 32, (r % 32) * 32, lane); continue; } r -= N_OUT;
        if (r < N_GLU) { tr_item<32>(F.in[I_GLUW], 512, 512, WSP(bf16, WS_GLU), scr, (r / 16) * 64, (r % 16) * 32, (r % 16) * 32, lane); continue; } r -= N_GLU;
        if (r < N_Z) { v4u* zb = (v4u*)(WSP(bf16, WS_WIN) + (size_t)INW * 1024 + (size_t)r * 8192); const v4u z = {0u, 0u, 0u, 0u};
#pragma unroll
            for (int j = 0; j < 16; ++j) zb[j * 64 + lane] = z; continue; } r -= N_Z;
        if (r < N_MOD) { const int ks = r / 48, j = (r % 48) * 64 + lane; float s0 = 0.f, s1 = 0.f, s2 = 0.f;
            const float* wa = F.in[I_WADA]; const float* cv = F.in[I_C]; const float* cc = F.in[I_CCTX];
#pragma unroll 16
            for (int k = ks * 64; k < ks * 64 + 64; ++k) { const float w = __builtin_nontemporal_load(&wa[(size_t)k * 3072 + j]); s0 += siluf_(cv[k]) * w; s1 += siluf_(cv[1024 + k]) * w; s2 += siluf_(cc[k]) * w; }
            float* mp = TABP(float, TAB_MODP); mp[(ks * 3 + 0) * 3072 + j] = s0; mp[(ks * 3 + 1) * 3072 + j] = s1; mp[(ks * 3 + 2) * 3072 + j] = s2; continue; } r -= N_MOD;
        { const int idx = r * 64 + lane;
          const int dg = idx >> 6;
          const float lre = F.in[I_LRE][idx], lim = F.in[I_LIM][idx], dt = __expf(F.in[I_LSTEP][dg]);
          const float th = lim * dt, mag = __expf(lre * dt), ct = cosf(th), st = sinf(th), sh = sinf(0.5f * th);
          const float ar = mag * ct, ai = mag * st;
          const float nr = expm1f(lre * dt) * ct - 2.f * sh * sh, ni = ai, den = lre * lre + lim * lim;
          const float fr = (nr * lre + ni * lim) / den, fi = (ni * lre - nr * lim) / den;
          TABP(f32x2, TAB_ABAR)[idx] = (f32x2){ar, ai};
          const double th64 = (double)lim * (double)dt * 64.0; const double tw = th64 - 6.283185307179586 * rint(th64 / 6.283185307179586);
          const float m64 = __expf(64.f * lre * dt);
          TABP(f32x2, TAB_A64)[idx] = (f32x2){m64 * cosf((float)tw), m64 * sinf((float)tw)};
          const float* bre = F.in[I_BRE] + (size_t)idx * 16; const float* bim = F.in[I_BIM] + (size_t)idx * 16; f32x2* bb = TABP(f32x2, TAB_BBAR) + (size_t)idx * 16;
#pragma unroll
          for (int c = 0; c < 16; ++c) bb[c] = (f32x2){fr * bre[c] - fi * bim[c], fr * bim[c] + fi * bre[c]};
          const int p = idx & 63; bf16* bbt = TABP(bf16, TAB_BBT) + (size_t)dg * 2048; bf16* cbt = TABP(bf16, TAB_CBT) + (size_t)dg * 2048;
          float tr_[16], ti_[16];
#pragma unroll
          for (int c = 0; c < 16; ++c) { tr_[c] = fr * bre[c] - fi * bim[c]; ti_[c] = fr * bim[c] + fi * bre[c]; }
          *(v4u*)(bbt + p * 16) = pack8(tr_); *(v4u*)(bbt + p * 16 + 8) = pack8(tr_ + 8);
          *(v4u*)(bbt + (64 + p) * 16) = pack8(ti_); *(v4u*)(bbt + (64 + p) * 16 + 8) = pack8(ti_ + 8);
          const float* cre = F.in[I_CRE] + (size_t)dg * 1024 + p; const float* cim = F.in[I_CIM] + (size_t)dg * 1024 + p;
#pragma unroll
          for (int c = 0; c < 16; ++c) { cbt[c * 128 + p] = (bf16)f2bf(cre[c * 64]); cbt[c * 128 + 64 + p] = (bf16)f2bf(-cim[c * 64]); } }
    }
}
__device__ __forceinline__ void phase1(Frame& F) {
    LAS float* mult = (LAS float*)F.lds; LAS float* shf = mult + 3072;
    const float* mp = TABP(float, TAB_MODP); const float* bada = F.in[I_BADA]; const float* nw = F.in[I_NORMW];
#pragma unroll 3
    for (int e = F.tid; e < 3072; e += NTHR) { const int v = e >> 10, d = e & 1023; float sh = bada[d], sc = bada[1024 + d];
#pragma unroll
        for (int ks = 0; ks < 16; ++ks) { sh += mp[(ks * 3 + v) * 3072 + d]; sc += mp[(ks * 3 + v) * 3072 + 1024 + d]; }
        mult[e] = nw[d] * (1.f + sc); shf[e] = sh; }
    if (blockIdx.x == 0) for (int e = F.tid; e < 2048; e += NTHR) { const int v = e >> 10, d = e & 1023; float gt = bada[2048 + d];
        for (int ks = 0; ks < 16; ++ks) gt += mp[(ks * 3 + v) * 3072 + 2048 + d];
        TABP(float, TAB_GATE)[e] = gt; }
    __syncthreads();
    if (F.wave >= 4) { phase0<3>(F, F.vcu * 4 + F.wave - 4, F.G * 4, 0, 1 << 30, 24576, 8448); return; }
    const int gw = F.vcu * 4 + F.wave, NGW = F.G * 4;
    bf16* Hb = DOP(bf16, DO_H);
    f32x4 xn[4];
    if (gw < MROWS) { const f32x4* xr = (const f32x4*)(gw < T ? F.in[I_X] + (size_t)gw * D : F.in[I_CTX] + (size_t)(gw - T) * D) + F.lane;
#pragma unroll
        for (int j = 0; j < 4; ++j) xn[j] = __builtin_nontemporal_load(&xr[64 * j]); }
    for (int r = gw; r < MROWS; r += NGW) {
        const int v = r < SEQ ? 0 : (r < T ? 1 : 2);
        f32x4 xv[4]; float s = 0.f;
#pragma unroll
        for (int j = 0; j < 4; ++j) xv[j] = xn[j];
        { const int rn = r + NGW; if (rn < MROWS) { const f32x4* xr = (const f32x4*)(rn < T ? F.in[I_X] + (size_t)rn * D : F.in[I_CTX] + (size_t)(rn - T) * D) + F.lane;
#pragma unroll
            for (int j = 0; j < 4; ++j) xn[j] = __builtin_nontemporal_load(&xr[64 * j]); } }
#pragma unroll
        for (int j = 0; j < 4; ++j) s += (xv[j].x * xv[j].x + xv[j].y * xv[j].y) + (xv[j].z * xv[j].z + xv[j].w * xv[j].w);
        const float rinv = __builtin_amdgcn_rsqf(wave_sum(s) * (1.f / D) + EPS);
        unsigned long long* o8 = (unsigned long long*)(Hb + (size_t)r * D) + F.lane;
#pragma unroll
        for (int j = 0; j < 4; ++j) { const int e0 = v * 1024 + 4 * F.lane + 256 * j;
            const f32x4 m = *(const LAS f32x4*)(mult + e0), sh = *(const LAS f32x4*)(shf + e0);
            const f32x4 y = xv[j] * rinv * m + sh;
            o8[64 * j] = (unsigned long long)pk2(y.x, y.y) | ((unsigned long long)pk2(y.z, y.w) << 32); }
    }
}
struct OrderIn {
    pg8::StaticOrder so; bool first;
    __device__ void init(bool first_, int G, int c) { first = first_; if (first_) so.init(MROWS, 15 * 256, G, c); else so.init(T, 12 * 256, G, c); }
    __device__ bool next(int i, pg8::Unit& u) const {
        if (!so.next(i, u)) return false;
        u.pn = first ? (u.pn < 14 ? u.pn : 28) : (u.pn < 4 ? 14 + u.pn : 16 + u.pn); return true;
    }
    __device__ __forceinline__ void a_ready(const pg8::Unit&) const {}
    __device__ __forceinline__ void done(const pg8::Unit&) const {}
};
struct OrderOne {
    pg8::Unit u0;
    __device__ bool next(int i, pg8::Unit& u) const { if (i != 0) return false; u = u0; return true; }
    __device__ __forceinline__ void a_ready(const pg8::Unit&) const {}
    __device__ __forceinline__ void done(const pg8::Unit&) const {}
};
struct EpiIn {
    static constexpr bool PERM = true, AFTER_DRAIN = false;
    bf16 *QKV, *QKVC, *U, *ZDN, *ZS5, *GDN, *GS5; float* BD;
    __device__ __forceinline__ void operator()(const f32x4 (&acc)[2][2][4][2], const pg8::Unit& u, int wr, int wc, int fr, int fq) const {
        const int pn = u.pn; const bool ctx = u.pm >= 64;
#pragma unroll
        for (int ai = 0; ai < 2; ++ai)
#pragma unroll
            for (int m = 0; m < 4; ++m) {
                const int row = u.pm * 256 + ai * 128 + wr * 64 + m * 16 + fr;
#pragma unroll
                for (int bj = 0; bj < 2; ++bj) {
                    const f32x4 v0 = acc[ai][bj][m][0], v1 = acc[ai][bj][m][1];
                    float f[8] = {v0[0], v0[1], v0[2], v0[3], v1[0], v1[1], v1[2], v1[3]};
                    const int colin = bj * 128 + wc * 32 + 8 * fq;
                    if (pn < 12) {
                        const int which = pn >> 2, head = 2 * (pn & 3) + bj, d0 = wc * 32 + 8 * fq;
                        bf16* dst;
                        if (!ctx) { const int b = row >> 13, t = row & 8191; dst = QKV + ((size_t)(((which * 2 + b) * 8 + head) * SEQ + t)) * 128 + d0; }
                        else { const int rr = row - T, b = rr >> 8, t = rr & 255; dst = QKVC + ((size_t)(((which * 2 + b) * 8 + head) * LCTX + t)) * 128 + d0; }
                        *(v4u*)dst = pack8(f);
                    } else if (pn < 14) {
                        *(v4u*)(U + (size_t)row * 512 + (pn - 12) * 256 + colin) = pack8(f);
                    } else if (pn < 28) {
                        if (!ctx) {
                            if (pn < 20) {
#pragma unroll
                                for (int e = 0; e < 8; ++e) f[e] = siluf_(f[e]);
                                if (pn < 18) *(v4u*)(ZDN + (size_t)row * 1024 + (pn - 14) * 256 + colin) = pack8(f);
                                else *(v4u*)(ZS5 + (size_t)row * 512 + (pn - 18) * 256 + colin) = pack8(f);
                            } else {
#pragma unroll
                                for (int e = 0; e < 8; ++e) f[e] = sigmoidf_(f[e]);
                                if (pn < 24) *(v4u*)(GDN + (size_t)row * 1024 + (pn - 20) * 256 + colin) = pack8(f);
                                else *(v4u*)(GS5 + (size_t)row * 1024 + (pn - 24) * 256 + colin) = pack8(f);
                            }
                        }
                    } else {
                        if (bj == 0 && wc == 0) { float* dst = BD + (size_t)row * 32 + 8 * fq; *(f32x4*)dst = v0; *(f32x4*)(dst + 4) = v1; }
                    }
                }
            }
    }
};
typedef short s16x4k __attribute__((ext_vector_type(4)));
#define MFMA16K16(a, b, c) __builtin_amdgcn_mfma_f32_16x16x16bf16_1k((a), (b), (c), 0, 0, 0)
constexpr int S5_BUF_BYTES = 128 * 20 * 4, S5_HT_BYTES = 128 * 48;
template <bool OUT> __device__ __forceinline__ void s5_block(LAS float* buf, LAS unsigned char* hT, const LAS unsigned* ubw, const s16x4k (&bbf)[8], const bf16x8 (&cbf)[4], const f32x2 a, float& hr, float& hi,
                                                             int d, int ib, int lane, LAS float* yb) {
    const int fr = lane & 15, fq = lane >> 4;
    { const int i = 16 * ib + fr, t = d ? 63 - i : i; const v2u au = *(const LAS v2u*)(ubw + t * 8 + 2 * fq); const s16x4k af = __builtin_bit_cast(s16x4k, au);
#pragma unroll
      for (int nt = 0; nt < 8; ++nt) { const f32x4 Dm = MFMA16K16(af, bbf[nt], ((f32x4){0.f, 0.f, 0.f, 0.f}));
          *(LAS f32x4*)(buf + (16 * nt + fr) * 20 + 4 * fq) = Dm; } }
    asm volatile("" ::: "memory");
    f32x4 br[4], bi[4];
#pragma unroll
    for (int q = 0; q < 4; ++q) { br[q] = *(const LAS f32x4*)(buf + lane * 20 + 4 * q); bi[q] = *(const LAS f32x4*)(buf + (64 + lane) * 20 + 4 * q); }
    float hre[16], him[16];
#pragma unroll
    for (int il = 0; il < 16; ++il) { const float nr = a.x * hr - a.y * hi + br[il >> 2][il & 3], ni = a.x * hi + a.y * hr + bi[il >> 2][il & 3]; hr = nr; hi = ni; hre[il] = hr; him[il] = hi; }
    if (OUT) {
        v4u w0, w1;
        w0.x = cvtpk_c(hre[0], hre[1]); w0.y = cvtpk_c(hre[2], hre[3]); w0.z = cvtpk_c(hre[4], hre[5]); w0.w = cvtpk_c(hre[6], hre[7]);
        w1.x = cvtpk_c(hre[8], hre[9]); w1.y = cvtpk_c(hre[10], hre[11]); w1.z = cvtpk_c(hre[12], hre[13]); w1.w = cvtpk_c(hre[14], hre[15]);
        *(LAS v4u*)(hT + lane * 48) = w0; *(LAS v4u*)(hT + lane * 48 + 16) = w1;
        w0.x = cvtpk_c(him[0], him[1]); w0.y = cvtpk_c(him[2], him[3]); w0.z = cvtpk_c(him[4], him[5]); w0.w = cvtpk_c(him[6], him[7]);
        w1.x = cvtpk_c(him[8], him[9]); w1.y = cvtpk_c(him[10], him[11]); w1.z = cvtpk_c(him[12], him[13]); w1.w = cvtpk_c(him[14], him[15]);
        *(LAS v4u*)(hT + (64 + lane) * 48) = w0; *(LAS v4u*)(hT + (64 + lane) * 48 + 16) = w1;
        asm volatile("" ::: "memory");
        f32x4 acc = {0.f, 0.f, 0.f, 0.f};
#pragma unroll
        for (int ks = 0; ks < 4; ++ks) {
            const s16x4 lo = ds_tr(hT + (32 * ks + 8 * fq + (fr >> 2)) * 48 + 8 * (fr & 3)), hi4 = ds_tr(hT + (32 * ks + 8 * fq + 4 + (fr >> 2)) * 48 + 8 * (fr & 3));
            const bf16x8 bfrag = __builtin_shufflevector(lo, hi4, 0, 1, 2, 3, 4, 5, 6, 7);
            acc = MFMA16(cbf[ks], bfrag, acc); }
        { const int i = 16 * ib + fr, t = d ? 63 - i : i; LAS f32x4* yp = (LAS f32x4*)(yb + t * 16 + 4 * fq); *yp = *yp + acc; }
        asm volatile("" ::: "memory");
    }
}
__device__ __forceinline__ void s5_load_bbf(const Frame& F, int dg, int lane, s16x4k (&bbf)[8]) {
    const bf16* bbt = TABP(bf16, TAB_BBT) + (size_t)dg * 2048;
#pragma unroll
    for (int nt = 0; nt < 8; ++nt) bbf[nt] = *(const s16x4k*)(bbt + (16 * nt + (lane & 15)) * 16 + 4 * (lane >> 4));
}
__device__ __forceinline__ void s5a_group(Frame& F, int g, int q0, int nq, int mbase, int nw, int wv, int mlim) {
    if (wv < 0) return;
    LAS float* buf = (LAS float*)(F.lds + F.wave * 12288); LAS unsigned* ubw = (LAS unsigned*)(F.lds + F.wave * 12288 + S5_BUF_BYTES);
    const bf16x8 cdummy[4] = {};
    s16x4k bbf0[8], bbf1[8]; s5_load_bbf(F, g, F.lane, bbf0); s5_load_bbf(F, 32 + g, F.lane, bbf1);
    const f32x2 a0 = TABP(f32x2, TAB_ABAR)[g * 64 + F.lane], a1 = TABP(f32x2, TAB_ABAR)[(32 + g) * 64 + F.lane];
    auto unit_of = [&](int m) { return m < mlim ? 8 * q0 + (m & 7) + 8 * nq * (m >> 3) : 2 * NCH; };
    auto urow = [&](int un) { const int b = un / NCH, ch = un % NCH, r0 = ch < 4 ? T + b * LCTX + ch * CHK : b * SEQ + (ch - 4) * CHK; return WSP(bf16, WS_U) + (size_t)(r0 + F.lane) * 512 + g * 16; };
    v4u n0 = {0u, 0u, 0u, 0u}, n1 = n0;
    { const int un0 = unit_of(mbase + wv); if (un0 < 2 * NCH) { const bf16* src = urow(un0); n0 = *(const v4u*)src; n1 = *(const v4u*)(src + 8); } }
    for (int m = mbase + wv; unit_of(m) < 2 * NCH; m += nw) {
        const int un = unit_of(m), unn = unit_of(m + nw);
        const int b = un / NCH, ch = un % NCH;
        *(LAS v4u*)(ubw + F.lane * 8) = n0; *(LAS v4u*)(ubw + F.lane * 8 + 4) = n1;
        if (unn < 2 * NCH) { const bf16* src = urow(unn); n0 = *(const v4u*)src; n1 = *(const v4u*)(src + 8); }
        asm volatile("" ::: "memory");
        { float hr = 0.f, hi = 0.f;
          for (int ib = 0; ib < 4; ++ib) s5_block<false>(buf, nullptr, ubw, bbf0, cdummy, a0, hr, hi, 0, ib, F.lane, nullptr);
          DOP(f32x2, DO_EH)[(size_t)(((0 * 2 + b) * NCH + ch) * 32 + g) * 64 + F.lane] = (f32x2){hr, hi}; }
        { float hr = 0.f, hi = 0.f;
          for (int ib = 0; ib < 4; ++ib) s5_block<false>(buf, nullptr, ubw, bbf1, cdummy, a1, hr, hi, 1, ib, F.lane, nullptr);
          DOP(f32x2, DO_EH)[(size_t)(((1 * 2 + b) * NCH + ch) * 32 + g) * 64 + F.lane] = (f32x2){hr, hi}; }
        LDS_WAIT(); asm volatile("" ::: "memory");
    }
}
__device__ __forceinline__ void s5_state_scan(Frame& F, int sidx) {
    if (sidx < 16) {
        const int idx = sidx * NTHR + F.tid, d = idx >> 12, b = (idx >> 11) & 1, g = (idx >> 6) & 31, p = idx & 63;
        const f32x2 a64 = TABP(f32x2, TAB_A64)[(d * 32 + g) * 64 + p];
        f32x2* base = DOP(f32x2, DO_EH) + (size_t)((d * 2 + b) * NCH) * 2048 + g * 64 + p;
        float hr = 0.f, hi = 0.f;
        for (int kb = 0; kb < NCH; kb += 33) { f32x2 e[33];
#pragma unroll
            for (int j = 0; j < 33; ++j) { const int k = kb + j, ch = d == 0 ? k : (k < 4 ? 3 - k : 135 - k); e[j] = base[(size_t)ch * 2048]; }
#pragma unroll
            for (int j = 0; j < 33; ++j) { const int k = kb + j, ch = d == 0 ? k : (k < 4 ? 3 - k : 135 - k); base[(size_t)ch * 2048] = (f32x2){hr, hi};
                const float nr = a64.x * hr - a64.y * hi + e[j].x, ni = a64.x * hi + a64.y * hr + e[j].y; hr = nr; hi = ni; } }
    }
}
constexpr int SB_KP = 0, SB_QP = 16384, SB_TP = 32768, SB_AP = 40960, SB_V = 49152, SB_SC = 53248, SB_SIZE = 54272;
constexpr int XS_OFF = 2 * SB_SIZE, XB_OFF = XS_OFF + 16384, OST_OFF = XB_OFF + 4096, FLG_OFF = OST_OFF + 8192;
static_assert(FLG_OFF + 16 <= RING_BYTES, "scan LDS");
__device__ __forceinline__ bf16x8 packB(const f32x4 a, const f32x4 b) {
    v4u o; o.x = cvtpk_c(a[0], a[1]); o.y = cvtpk_c(a[2], a[3]); o.z = cvtpk_c(b[0], b[1]); o.w = cvtpk_c(b[2], b[3]);
    return __builtin_bit_cast(bf16x8, o);
}
struct ScanStep { bool ctx; int cc; const unsigned char *qimg, *kimg, *vrow, *ta, *sc; };
__device__ __forceinline__ ScanStep scan_step(const Frame& F, int step, int d, int bh) {
    ScanStep s; s.ctx = step < 4; s.cc = s.ctx ? (d ? 3 - step : step) : (d ? 131 - step : step - 4); const int ch132 = s.ctx ? s.cc : 4 + s.cc;
    const bf16* base = s.ctx ? WSP(bf16, WS_QKVC) : WSP(bf16, WS_QKV); const int Lx = s.ctx ? LCTX : SEQ;
    s.qimg = (const unsigned char*)(base + ((size_t)(bh) * Lx + s.cc * CHK) * 128); s.kimg = (const unsigned char*)(base + ((size_t)(16 + bh) * Lx + s.cc * CHK) * 128);
    s.vrow = (const unsigned char*)(base + ((size_t)(32 + bh) * Lx + s.cc * CHK) * 128);
    s.ta = (const unsigned char*)(s.ctx ? WSP(bf16, WS_CTXTA) + (size_t)(bh * 4 + s.cc) * 8192 : WSP(bf16, WS_TA) + (size_t)(bh * NCHL + s.cc) * 8192);
    s.sc = (const unsigned char*)(DOP(float, DO_SC) + (size_t)(((d * 2 + (bh >> 3)) * 8 + (bh & 7)) * NCH + ch132) * SCBLK);
    return s;
}
#define SCAN_BAR() do { asm volatile("s_waitcnt lgkmcnt(0)" ::: "memory"); __builtin_amdgcn_s_barrier(); asm volatile("" ::: "memory"); } while (0)
#define GLDS16(gp, lp) __builtin_amdgcn_global_load_lds((const unsigned*)(gp), (LAS unsigned*)(lp), 16, 0, 0)
template <int LW> __device__ __forceinline__ void dma_issue(const ScanStep& s, LAS unsigned char* B, int pair, int lane) {
    if (LW == 0) {
#pragma unroll
        for (int u = 0; u < 16; ++u) GLDS16(s.kimg + u * 1024 + lane * 16, B + SB_KP + u * 1024);
    } else if (LW == 1) {
        if (!s.ctx) {
#pragma unroll
            for (int u = 0; u < 16; ++u) GLDS16(s.qimg + u * 1024 + lane * 16, B + SB_QP + u * 1024);
        }
    } else if (LW == 2) {
#pragma unroll
        for (int u = 0; u < 8; ++u) GLDS16(s.ta + u * 1024 + lane * 16, B + SB_TP + u * 1024);
        if (!s.ctx) {
#pragma unroll
            for (int u = 0; u < 8; ++u) GLDS16(s.ta + 8192 + u * 1024 + lane * 16, B + SB_AP + u * 1024);
        }
    } else {
#pragma unroll
        for (int u = 0; u < 4; ++u) GLDS16(s.vrow + (16 * u + (lane >> 2)) * 256 + pair * 64 + (lane & 3) * 16, B + SB_V + u * 1024);
        GLDS16(s.sc + lane * 16, B + SB_SC);
    }
}
__device__ __forceinline__ void ost_store(Frame& F, int d, int bh, int pair, int step, int lane) {
    const int cc = d ? 131 - step : step - 4, b = bh >> 3, h = bh & 7;
    bf16* ob = WSP(bf16, WS_ODIR) + ((size_t)d * T + b * SEQ + cc * CHK) * 1024 + h * 128 + pair * 32;
#pragma unroll
    for (int u = 0; u < 4; ++u) { const v4u v = *(const LAS v4u*)(F.lds + OST_OFF + (step & 1) * 4096 + u * 1024 + lane * 16); *(v4u*)(ob + (size_t)(16 * u + (lane >> 2)) * 1024 + (lane & 3) * 8) = v; }
}
template <int LW> __device__ __forceinline__ void scan_dma(Frame& F, int d, int bh, int pair, int probe) {
    const int lane = F.lane;
    if ((probe & 512) && LW != 0) { for (int i = 0; i <= NCH; ++i) SCAN_BAR(); return; }
    if ((probe & 1024) && (LW == 1 || LW == 3)) { for (int i = 0; i <= NCH; ++i) SCAN_BAR(); return; }
    { const ScanStep s0 = scan_step(F, 0, d, bh); dma_issue<LW>(s0, F.lds, pair, lane); }
    asm volatile("s_waitcnt vmcnt(0)" ::: "memory");
    SCAN_BAR();
    for (int step = 0; step < NCH; ++step) {
        if (LW == 3 && step >= 5 && !(probe & 32)) ost_store(F, d, bh, pair, step - 1, lane);
        if (step + 1 < NCH) { const ScanStep s1 = scan_step(F, step + 1, d, bh); dma_issue<LW>(s1, F.lds + ((step + 1) & 1) * SB_SIZE, pair, lane); }
        asm volatile("s_waitcnt vmcnt(0)" ::: "memory");
        SCAN_BAR();
    }
    if (LW == 3 && !(probe & 32)) ost_store(F, d, bh, pair, NCH - 1, lane);
}
struct FragMask { unsigned keep[2][4], diag[2][4]; };
template <int D, bool STRICT> __device__ __forceinline__ FragMask frag_mask(int fr, int fq) {
    FragMask M;
#pragma unroll
    for (int h = 0; h < 2; ++h)
#pragma unroll
        for (int w = 0; w < 4; ++w) { unsigned k = 0u, dg = 0u;
#pragma unroll
            for (int e = 0; e < 2; ++e) { const int jj = 2 * w + e, irel = 16 * h + fr, jrel = 16 * (jj >> 2) + 4 * fq + (jj & 3);
                const bool kp = STRICT ? (D == 0 ? irel > jrel : irel < jrel) : (D == 0 ? irel >= jrel : irel <= jrel);
                k |= kp ? (0xffffu << (16 * e)) : 0u; dg |= (STRICT && irel == jrel) ? (0x3f80u << (16 * e)) : 0u; }
            M.keep[h][w] = k; M.diag[h][w] = dg; }
    return M;
}
__device__ __forceinline__ bf16x8 apply_mask(const bf16x8 f, const unsigned (&keep)[4], const unsigned (&diag)[4]) {
    v4u v = __builtin_bit_cast(v4u, f); v.x = (v.x & keep[0]) | diag[0]; v.y = (v.y & keep[1]) | diag[1]; v.z = (v.z & keep[2]) | diag[2]; v.w = (v.w & keep[3]) | diag[3];
    return __builtin_bit_cast(bf16x8, v);
}
template <int D> __device__ __forceinline__ constexpr int frag_kind(int mt, int ks) { return ks == (mt >> 1) ? 2 : ((ks > (mt >> 1)) == (D == 1) ? 1 : 0); }
template <int D> __device__ __forceinline__ void scan_chain(Frame& F, int slice) {
    const int lane = F.lane, fr = lane & 15, fq = lane >> 4;
    f32x4 Sacc[8]; bf16x8 Sb[4];
#pragma unroll
    for (int m = 0; m < 8; ++m) Sacc[m] = (f32x4){0.f, 0.f, 0.f, 0.f};
#pragma unroll
    for (int k = 0; k < 4; ++k) Sb[k] = (bf16x8){0, 0, 0, 0, 0, 0, 0, 0};
    LAS unsigned char* xs = F.lds + XS_OFF + slice * 8192; LAS unsigned char* xb = F.lds + XB_OFF + slice * 2048;
    volatile LAS unsigned* flg = (volatile LAS unsigned*)(F.lds + FLG_OFF + slice * 8);
    if (lane == 0) *flg = 0u;
    const FragMask TM = frag_mask<D, true>(fr, fq);
    SCAN_BAR();
    for (int step = 0; step < NCH; ++step) {
        const LAS unsigned char* B = F.lds + (step & 1) * SB_SIZE;
        bf16x8 fk[16], ft[8];
#pragma unroll
        for (int ks = 0; ks < 4; ++ks)
#pragma unroll
            for (int mt = 0; mt < 4; ++mt) fk[ks * 4 + mt] = *(const LAS bf16x8*)(B + SB_KP + off256(16 * mt + fr, 4 * ks + fq));
        f32x4 bg4[4], ee4[4], be4[4]; s16x4 vv[4];
#pragma unroll
        for (int mt = 0; mt < 4; ++mt) { const int i0 = 16 * mt + 4 * fq;
            bg4[mt] = *(const LAS f32x4*)(B + SB_SC + i0 * 4); ee4[mt] = *(const LAS f32x4*)(B + SB_SC + 256 + i0 * 4); be4[mt] = *(const LAS f32x4*)(B + SB_SC + 768 + i0 * 4);
            vv[mt] = ds_tr(B + SB_V + (16 * mt + 4 * fq + (fr >> 2)) * 64 + slice * 32 + 8 * (fr & 3)); }
#pragma unroll
        for (int mt = 0; mt < 4; ++mt)
#pragma unroll
            for (int ks = 0; ks < 2; ++ks) if (frag_kind<D>(mt, ks) != 0) ft[2 * mt + ks] = *(const LAS bf16x8*)(B + SB_TP + off128(16 * mt + fr, 4 * ks + fq));
        const float ae = *(const LAS float*)(B + SB_SC + 512 + (D ? 0 : 63) * 4);
        const f32x4 z4 = {0.f, 0.f, 0.f, 0.f};
        f32x4 R[4] = {z4, z4, z4, z4};
#pragma unroll
        for (int ks = 0; ks < 4; ++ks)
#pragma unroll
            for (int mt = 0; mt < 4; ++mt) R[mt] = MFMA16(fk[ks * 4 + mt], Sb[ks], R[mt]);
        __builtin_amdgcn_sched_barrier(0);
        s16x4 tl[16], th[16];
#pragma unroll
        for (int m = 0; m < 8; ++m)
#pragma unroll
            for (int ks = 0; ks < 2; ++ks) {
                tl[m * 2 + ks] = ds_tr(B + SB_KP + off256(32 * ks + 4 * fq + (fr >> 2), 4 * (m >> 1) + (fr & 3)) + 8 * (m & 1));
                th[m * 2 + ks] = ds_tr(B + SB_KP + off256(32 * ks + 16 + 4 * fq + (fr >> 2), 4 * (m >> 1) + (fr & 3)) + 8 * (m & 1)); }
        f32x4 rhs[4];
#pragma unroll
        for (int mt = 0; mt < 4; ++mt) { const f32x4 vf = {bf2f((unsigned short)vv[mt][0]), bf2f((unsigned short)vv[mt][1]), bf2f((unsigned short)vv[mt][2]), bf2f((unsigned short)vv[mt][3])};
            rhs[mt] = be4[mt] * vf - bg4[mt] * R[mt]; }
        const bf16x8 RB0 = packB(rhs[0], rhs[1]), RB1 = packB(rhs[2], rhs[3]);
        f32x4 VN[4] = {z4, z4, z4, z4};
#pragma unroll
        for (int mt = 0; mt < 4; ++mt)
#pragma unroll
            for (int ks = 0; ks < 2; ++ks) {
                const int kind = frag_kind<D>(mt, ks);
                if (kind == 1) VN[mt] = MFMA16(ft[2 * mt + ks], ks == 0 ? RB0 : RB1, VN[mt]);
                else if (kind == 2) VN[mt] = MFMA16(apply_mask(ft[2 * mt + ks], TM.keep[mt & 1], TM.diag[mt & 1]), ks == 0 ? RB0 : RB1, VN[mt]); }
        const bf16x8 VS0 = packB(ee4[0] * VN[0], ee4[1] * VN[1]), VS1 = packB(ee4[2] * VN[2], ee4[3] * VN[3]);
        const bf16x8 VB0 = packB(VN[0], VN[1]), VB1 = packB(VN[2], VN[3]);
        *(LAS bf16x8*)(xb + lane * 16) = VB0; *(LAS bf16x8*)(xb + 1024 + lane * 16) = VB1;
        asm volatile("" ::: "memory");
        if (lane == 0) *flg = (unsigned)(step + 1);
        asm volatile("" ::: "memory");
#pragma unroll
        for (int m = 0; m < 8; ++m) { Sacc[m] = Sacc[m] * ae;
#pragma unroll
            for (int ks = 0; ks < 2; ++ks) { const bf16x8 a = __builtin_shufflevector(tl[m * 2 + ks], th[m * 2 + ks], 0, 1, 2, 3, 4, 5, 6, 7);
                Sacc[m] = MFMA16(a, ks == 0 ? VS0 : VS1, Sacc[m]); } }
#pragma unroll
        for (int k = 0; k < 4; ++k) { Sb[k] = packB(Sacc[2 * k], Sacc[2 * k + 1]); *(LAS bf16x8*)(xs + ((step + 1) & 1) * 4096 + k * 1024 + lane * 16) = Sb[k]; }
        SCAN_BAR();
    }
}
template <int D> __device__ __forceinline__ void scan_out(Frame& F, int bh, int pair, int slice, bool nostore) {
    const int lane = F.lane, fr = lane & 15, fq = lane >> 4, b = bh >> 3, h = bh & 7;
    const LAS unsigned char* xs = F.lds + XS_OFF + slice * 8192; const LAS unsigned char* xb = F.lds + XB_OFF + slice * 2048;
    volatile LAS unsigned* flg = (volatile LAS unsigned*)(F.lds + FLG_OFF + slice * 8);
    const FragMask AM = frag_mask<D, false>(fr, fq);
    SCAN_BAR();
    for (int step = 0; step < 4; ++step) SCAN_BAR();
    for (int step = 4; step < NCH; ++step) {
        const LAS unsigned char* B = F.lds + (step & 1) * SB_SIZE;
        bf16x8 fqv[16], fa[8], sb[4]; f32x4 eG4[4];
#pragma unroll
        for (int k = 0; k < 4; ++k) sb[k] = *(const LAS bf16x8*)(xs + (step & 1) * 4096 + k * 1024 + lane * 16);
#pragma unroll
        for (int ks = 0; ks < 4; ++ks)
#pragma unroll
            for (int mt = 0; mt < 4; ++mt) fqv[ks * 4 + mt] = *(const LAS bf16x8*)(B + SB_QP + off256(16 * mt + fr, 4 * ks + fq));
#pragma unroll
        for (int mt = 0; mt < 4; ++mt) {
#pragma unroll
            for (int ks = 0; ks < 2; ++ks) if (frag_kind<D>(mt, ks) != 0) fa[2 * mt + ks] = *(const LAS bf16x8*)(B + SB_AP + off128(16 * mt + fr, 4 * ks + fq));
            eG4[mt] = *(const LAS f32x4*)(B + SB_SC + 512 + (16 * mt + 4 * fq) * 4); }
        const f32x4 z4 = {0.f, 0.f, 0.f, 0.f};
        f32x4 QS[4] = {z4, z4, z4, z4};
#pragma unroll
        for (int ks = 0; ks < 4; ++ks)
#pragma unroll
            for (int mt = 0; mt < 4; ++mt) QS[mt] = MFMA16(fqv[ks * 4 + mt], sb[ks], QS[mt]);
#pragma unroll
        for (int mt = 0; mt < 4; ++mt) QS[mt] = QS[mt] * eG4[mt];
        while (*flg < (unsigned)(step + 1)) __builtin_amdgcn_s_sleep(1);
        asm volatile("" ::: "memory");
        const bf16x8 VB0 = *(const LAS bf16x8*)(xb + lane * 16), VB1 = *(const LAS bf16x8*)(xb + 1024 + lane * 16);
#pragma unroll
        for (int mt = 0; mt < 4; ++mt) { f32x4 O = QS[mt];
#pragma unroll
            for (int ks = 0; ks < 2; ++ks) { const int kind = frag_kind<D>(mt, ks);
                if (kind == 1) O = MFMA16(fa[2 * mt + ks], ks == 0 ? VB0 : VB1, O);
                else if (kind == 2) { const unsigned zero4[4] = {0u, 0u, 0u, 0u}; O = MFMA16(apply_mask(fa[2 * mt + ks], AM.keep[mt & 1], zero4), ks == 0 ? VB0 : VB1, O); } }
#pragma unroll
            for (int r = 0; r < 4; ++r) { const int i = 16 * mt + 4 * fq + r; *(LAS unsigned short*)(F.lds + OST_OFF + (step & 1) * 4096 + i * 64 + (slice * 16 + fr) * 2) = (unsigned short)f2bf(O[r]); } }
        SCAN_BAR();
    }
}
__device__ __forceinline__ void phase5b(Frame& F, int probe) {
    if ((probe & 64) && F.wave < 4) { for (int i = 0; i <= NCH; ++i) SCAN_BAR(); return; }
    if ((probe & 32) && F.wave >= 4) { for (int i = 0; i <= NCH; ++i) SCAN_BAR(); return; }
    const int seqid = F.vcu >> 3, pair = F.vcu & 3, d = seqid >> 4, bh = seqid & 15;
    const bool ns = (probe & 32) != 0;
    switch (F.wave) {
        case 0: case 1: if (d) scan_chain<1>(F, F.wave); else scan_chain<0>(F, F.wave); break;
        case 2: case 3: if (d) scan_out<1>(F, bh, pair, F.wave - 2, ns); else scan_out<0>(F, bh, pair, F.wave - 2, ns); break;
        case 4: scan_dma<0>(F, d, bh, pair, probe); break;
        case 5: scan_dma<1>(F, d, bh, pair, probe); break;
        case 6: scan_dma<2>(F, d, bh, pair, probe); break;
        default: scan_dma<3>(F, d, bh, pair, probe); break;
    }
}
constexpr int PP_PITCH = 68, PP_BYTES = 64 * PP_PITCH * 4, PP_GOFF = 4 * PP_BYTES;
struct PrepUnit { const bf16 *kbase, *qbase; int rowbase, ch132, b, h; bf16* ta; };
__device__ __forceinline__ PrepUnit prep_unit(const Frame& F, int uid) {
    PrepUnit u; const bool ctx = uid < 64; const int v = ctx ? uid : uid - 64;
    const int bh = ctx ? (v >> 2) : (v >> 7), cc = ctx ? (v & 3) : (v & 127); u.b = bh >> 3; u.h = bh & 7;
    u.kbase = ctx ? WSP(bf16, WS_QKVC) + ((size_t)(16 + bh) * LCTX + cc * CHK) * 128 : WSP(bf16, WS_QKV) + ((size_t)(16 + bh) * SEQ + cc * CHK) * 128;
    u.qbase = ctx ? WSP(bf16, WS_QKVC) + ((size_t)(bh) * LCTX + cc * CHK) * 128 : WSP(bf16, WS_QKV) + ((size_t)(bh) * SEQ + cc * CHK) * 128;
    u.rowbase = ctx ? T + u.b * LCTX + cc * CHK : u.b * SEQ + cc * CHK; u.ch132 = ctx ? cc : 4 + cc;
    u.ta = ctx ? WSP(bf16, WS_CTXTA) + (size_t)v * 8192 : WSP(bf16, WS_TA) + (size_t)v * 8192;
    return u;
}
template <int M> __device__ __forceinline__ void fmac_chunk(float (&s)[4], float t, const float* x) {
    if constexpr (M == 1) asm("s_nop 1\n\tv_fmac_f32_dpp %0, %4, %5 row_newbcast:0 row_mask:0xf bank_mask:0xf" : "+v"(s[0]), "+v"(s[1]), "+v"(s[2]), "+v"(s[3]) : "v"(t), "v"(x[0]));
    if constexpr (M == 2) asm("s_nop 1\n\tv_fmac_f32_dpp %0, %4, %5 row_newbcast:0 row_mask:0xf bank_mask:0xf\n\tv_fmac_f32_dpp %1, %4, %6 row_newbcast:1 row_mask:0xf bank_mask:0xf" : "+v"(s[0]), "+v"(s[1]), "+v"(s[2]), "+v"(s[3]) : "v"(t), "v"(x[0]), "v"(x[1]));
    if constexpr (M == 3) asm("s_nop 1\n\tv_fmac_f32_dpp %0, %4, %5 row_newbcast:0 row_mask:0xf bank_mask:0xf\n\tv_fmac_f32_dpp %1, %4, %6 row_newbcast:1 row_mask:0xf bank_mask:0xf\n\tv_fmac_f32_dpp %2, %4, %7 row_newbcast:2 row_mask:0xf bank_mask:0xf" : "+v"(s[0]), "+v"(s[1]), "+v"(s[2]), "+v"(s[3]) : "v"(t), "v"(x[0]), "v"(x[1]), "v"(x[2]));
    if constexpr (M == 4) asm("s_nop 1\n\tv_fmac_f32_dpp %0, %4, %5 row_newbcast:0 row_mask:0xf bank_mask:0xf\n\tv_fmac_f32_dpp %1, %4, %6 row_newbcast:1 row_mask:0xf bank_mask:0xf\n\tv_fmac_f32_dpp %2, %4, %7 row_newbcast:2 row_mask:0xf bank_mask:0xf\n\tv_fmac_f32_dpp %3, %4, %8 row_newbcast:3 row_mask:0xf bank_mask:0xf" : "+v"(s[0]), "+v"(s[1]), "+v"(s[2]), "+v"(s[3]) : "v"(t), "v"(x[0]), "v"(x[1]), "v"(x[2]), "v"(x[3]));
    if constexpr (M == 5) asm("s_nop 1\n\tv_fmac_f32_dpp %0, %4, %5 row_newbcast:0 row_mask:0xf bank_mask:0xf\n\tv_fmac_f32_dpp %1, %4, %6 row_newbcast:1 row_mask:0xf bank_mask:0xf\n\tv_fmac_f32_dpp %2, %4, %7 row_newbcast:2 row_mask:0xf bank_mask:0xf\n\tv_fmac_f32_dpp %3, %4, %8 row_newbcast:3 row_mask:0xf bank_mask:0xf\n\tv_fmac_f32_dpp %0, %4, %9 row_newbcast:4 row_mask:0xf bank_mask:0xf" : "+v"(s[0]), "+v"(s[1]), "+v"(s[2]), "+v"(s[3]) : "v"(t), "v"(x[0]), "v"(x[1]), "v"(x[2]), "v"(x[3]), "v"(x[4]));
    if constexpr (M == 6) asm("s_nop 1\n\tv_fmac_f32_dpp %0, %4, %5 row_newbcast:0 row_mask:0xf bank_mask:0xf\n\tv_fmac_f32_dpp %1, %4, %6 row_newbcast:1 row_mask:0xf bank_mask:0xf\n\tv_fmac_f32_dpp %2, %4, %7 row_newbcast:2 row_mask:0xf bank_mask:0xf\n\tv_fmac_f32_dpp %3, %4, %8 row_newbcast:3 row_mask:0xf bank_mask:0xf\n\tv_fmac_f32_dpp %0, %4, %9 row_newbcast:4 row_mask:0xf bank_mask:0xf\n\tv_fmac_f32_dpp %1, %4, %10 row_newbcast:5 row_mask:0xf bank_mask:0xf" : "+v"(s[0]), "+v"(s[1]), "+v"(s[2]), "+v"(s[3]) : "v"(t), "v"(x[0]), "v"(x[1]), "v"(x[2]), "v"(x[3]), "v"(x[4]), "v"(x[5]));
    if constexpr (M == 7) asm("s_nop 1\n\tv_fmac_f32_dpp %0, %4, %5 row_newbcast:0 row_mask:0xf bank_mask:0xf\n\tv_fmac_f32_dpp %1, %4, %6 row_newbcast:1 row_mask:0xf bank_mask:0xf\n\tv_fmac_f32_dpp %2, %4, %7 row_newbcast:2 row_mask:0xf bank_mask:0xf\n\tv_fmac_f32_dpp %3, %4, %8 row_newbcast:3 row_mask:0xf bank_mask:0xf\n\tv_fmac_f32_dpp %0, %4, %9 row_newbcast:4 row_mask:0xf bank_mask:0xf\n\tv_fmac_f32_dpp %1, %4, %10 row_newbcast:5 row_mask:0xf bank_mask:0xf\n\tv_fmac_f32_dpp %2, %4, %11 row_newbcast:6 row_mask:0xf bank_mask:0xf" : "+v"(s[0]), "+v"(s[1]), "+v"(s[2]), "+v"(s[3]) : "v"(t), "v"(x[0]), "v"(x[1]), "v"(x[2]), "v"(x[3]), "v"(x[4]), "v"(x[5]), "v"(x[6]));
    if constexpr (M == 8) asm("s_nop 1\n\tv_fmac_f32_dpp %0, %4, %5 row_newbcast:0 row_mask:0xf bank_mask:0xf\n\tv_fmac_f32_dpp %1, %4, %6 row_newbcast:1 row_mask:0xf bank_mask:0xf\n\tv_fmac_f32_dpp %2, %4, %7 row_newbcast:2 row_mask:0xf bank_mask:0xf\n\tv_fmac_f32_dpp %3, %4, %8 row_newbcast:3 row_mask:0xf bank_mask:0xf\n\tv_fmac_f32_dpp %0, %4, %9 row_newbcast:4 row_mask:0xf bank_mask:0xf\n\tv_fmac_f32_dpp %1, %4, %10 row_newbcast:5 row_mask:0xf bank_mask:0xf\n\tv_fmac_f32_dpp %2, %4, %11 row_newbcast:6 row_mask:0xf bank_mask:0xf\n\tv_fmac_f32_dpp %3, %4, %12 row_newbcast:7 row_mask:0xf bank_mask:0xf" : "+v"(s[0]), "+v"(s[1]), "+v"(s[2]), "+v"(s[3]) : "v"(t), "v"(x[0]), "v"(x[1]), "v"(x[2]), "v"(x[3]), "v"(x[4]), "v"(x[5]), "v"(x[6]), "v"(x[7]));
    if constexpr (M == 9) asm("s_nop 1\n\tv_fmac_f32_dpp %0, %4, %5 row_newbcast:0 row_mask:0xf bank_mask:0xf\n\tv_fmac_f32_dpp %1, %4, %6 row_newbcast:1 row_mask:0xf bank_mask:0xf\n\tv_fmac_f32_dpp %2, %4, %7 row_newbcast:2 row_mask:0xf bank_mask:0xf\n\tv_fmac_f32_dpp %3, %4, %8 row_newbcast:3 row_mask:0xf bank_mask:0xf\n\tv_fmac_f32_dpp %0, %4, %9 row_newbcast:4 row_mask:0xf bank_mask:0xf\n\tv_fmac_f32_dpp %1, %4, %10 row_newbcast:5 row_mask:0xf bank_mask:0xf\n\tv_fmac_f32_dpp %2, %4, %11 row_newbcast:6 row_mask:0xf bank_mask:0xf\n\tv_fmac_f32_dpp %3, %4, %12 row_newbcast:7 row_mask:0xf bank_mask:0xf\n\tv_fmac_f32_dpp %0, %4, %13 row_newbcast:8 row_mask:0xf bank_mask:0xf" : "+v"(s[0]), "+v"(s[1]), "+v"(s[2]), "+v"(s[3]) : "v"(t), "v"(x[0]), "v"(x[1]), "v"(x[2]), "v"(x[3]), "v"(x[4]), "v"(x[5]), "v"(x[6]), "v"(x[7]), "v"(x[8]));
    if constexpr (M == 10) asm("s_nop 1\n\tv_fmac_f32_dpp %0, %4, %5 row_newbcast:0 row_mask:0xf bank_mask:0xf\n\tv_fmac_f32_dpp %1, %4, %6 row_newbcast:1 row_mask:0xf bank_mask:0xf\n\tv_fmac_f32_dpp %2, %4, %7 row_newbcast:2 row_mask:0xf bank_mask:0xf\n\tv_fmac_f32_dpp %3, %4, %8 row_newbcast:3 row_mask:0xf bank_mask:0xf\n\tv_fmac_f32_dpp %0, %4, %9 row_newbcast:4 row_mask:0xf bank_mask:0xf\n\tv_fmac_f32_dpp %1, %4, %10 row_newbcast:5 row_mask:0xf bank_mask:0xf\n\tv_fmac_f32_dpp %2, %4, %11 row_newbcast:6 row_mask:0xf bank_mask:0xf\n\tv_fmac_f32_dpp %3, %4, %12 row_newbcast:7 row_mask:0xf bank_mask:0xf\n\tv_fmac_f32_dpp %0, %4, %13 row_newbcast:8 row_mask:0xf bank_mask:0xf\n\tv_fmac_f32_dpp %1, %4, %14 row_newbcast:9 row_mask:0xf bank_mask:0xf" : "+v"(s[0]), "+v"(s[1]), "+v"(s[2]), "+v"(s[3]) : "v"(t), "v"(x[0]), "v"(x[1]), "v"(x[2]), "v"(x[3]), "v"(x[4]), "v"(x[5]), "v"(x[6]), "v"(x[7]), "v"(x[8]), "v"(x[9]));
    if constexpr (M == 11) asm("s_nop 1\n\tv_fmac_f32_dpp %0, %4, %5 row_newbcast:0 row_mask:0xf bank_mask:0xf\n\tv_fmac_f32_dpp %1, %4, %6 row_newbcast:1 row_mask:0xf bank_mask:0xf\n\tv_fmac_f32_dpp %2, %4, %7 row_newbcast:2 row_mask:0xf bank_mask:0xf\n\tv_fmac_f32_dpp %3, %4, %8 row_newbcast:3 row_mask:0xf bank_mask:0xf\n\tv_fmac_f32_dpp %0, %4, %9 row_newbcast:4 row_mask:0xf bank_mask:0xf\n\tv_fmac_f32_dpp %1, %4, %10 row_newbcast:5 row_mask:0xf bank_mask:0xf\n\tv_fmac_f32_dpp %2, %4, %11 row_newbcast:6 row_mask:0xf bank_mask:0xf\n\tv_fmac_f32_dpp %3, %4, %12 row_newbcast:7 row_mask:0xf bank_mask:0xf\n\tv_fmac_f32_dpp %0, %4, %13 row_newbcast:8 row_mask:0xf bank_mask:0xf\n\tv_fmac_f32_dpp %1, %4, %14 row_newbcast:9 row_mask:0xf bank_mask:0xf\n\tv_fmac_f32_dpp %2, %4, %15 row_newbcast:10 row_mask:0xf bank_mask:0xf" : "+v"(s[0]), "+v"(s[1]), "+v"(s[2]), "+v"(s[3]) : "v"(t), "v"(x[0]), "v"(x[1]), "v"(x[2]), "v"(x[3]), "v"(x[4]), "v"(x[5]), "v"(x[6]), "v"(x[7]), "v"(x[8]), "v"(x[9]), "v"(x[10]));
    if constexpr (M == 12) asm("s_nop 1\n\tv_fmac_f32_dpp %0, %4, %5 row_newbcast:0 row_mask:0xf bank_mask:0xf\n\tv_fmac_f32_dpp %1, %4, %6 row_newbcast:1 row_mask:0xf bank_mask:0xf\n\tv_fmac_f32_dpp %2, %4, %7 row_newbcast:2 row_mask:0xf bank_mask:0xf\n\tv_fmac_f32_dpp %3, %4, %8 row_newbcast:3 row_mask:0xf bank_mask:0xf\n\tv_fmac_f32_dpp %0, %4, %9 row_newbcast:4 row_mask:0xf bank_mask:0xf\n\tv_fmac_f32_dpp %1, %4, %10 row_newbcast:5 row_mask:0xf bank_mask:0xf\n\tv_fmac_f32_dpp %2, %4, %11 row_newbcast:6 row_mask:0xf bank_mask:0xf\n\tv_fmac_f32_dpp %3, %4, %12 row_newbcast:7 row_mask:0xf bank_mask:0xf\n\tv_fmac_f32_dpp %0, %4, %13 row_newbcast:8 row_mask:0xf bank_mask:0xf\n\tv_fmac_f32_dpp %1, %4, %14 row_newbcast:9 row_mask:0xf bank_mask:0xf\n\tv_fmac_f32_dpp %2, %4, %15 row_newbcast:10 row_mask:0xf bank_mask:0xf\n\tv_fmac_f32_dpp %3, %4, %16 row_newbcast:11 row_mask:0xf bank_mask:0xf" : "+v"(s[0]), "+v"(s[1]), "+v"(s[2]), "+v"(s[3]) : "v"(t), "v"(x[0]), "v"(x[1]), "v"(x[2]), "v"(x[3]), "v"(x[4]), "v"(x[5]), "v"(x[6]), "v"(x[7]), "v"(x[8]), "v"(x[9]), "v"(x[10]), "v"(x[11]));
    if constexpr (M == 13) asm("s_nop 1\n\tv_fmac_f32_dpp %0, %4, %5 row_newbcast:0 row_mask:0xf bank_mask:0xf\n\tv_fmac_f32_dpp %1, %4, %6 row_newbcast:1 row_mask:0xf bank_mask:0xf\n\tv_fmac_f32_dpp %2, %4, %7 row_newbcast:2 row_mask:0xf bank_mask:0xf\n\tv_fmac_f32_dpp %3, %4, %8 row_newbcast:3 row_mask:0xf bank_mask:0xf\n\tv_fmac_f32_dpp %0, %4, %9 row_newbcast:4 row_mask:0xf bank_mask:0xf\n\tv_fmac_f32_dpp %1, %4, %10 row_newbcast:5 row_mask:0xf bank_mask:0xf\n\tv_fmac_f32_dpp %2, %4, %11 row_newbcast:6 row_mask:0xf bank_mask:0xf\n\tv_fmac_f32_dpp %3, %4, %12 row_newbcast:7 row_mask:0xf bank_mask:0xf\n\tv_fmac_f32_dpp %0, %4, %13 row_newbcast:8 row_mask:0xf bank_mask:0xf\n\tv_fmac_f32_dpp %1, %4, %14 row_newbcast:9 row_mask:0xf bank_mask:0xf\n\tv_fmac_f32_dpp %2, %4, %15 row_newbcast:10 row_mask:0xf bank_mask:0xf\n\tv_fmac_f32_dpp %3, %4, %16 row_newbcast:11 row_mask:0xf bank_mask:0xf\n\tv_fmac_f32_dpp %0, %4, %17 row_newbcast:12 row_mask:0xf bank_mask:0xf" : "+v"(s[0]), "+v"(s[1]), "+v"(s[2]), "+v"(s[3]) : "v"(t), "v"(x[0]), "v"(x[1]), "v"(x[2]), "v"(x[3]), "v"(x[4]), "v"(x[5]), "v"(x[6]), "v"(x[7]), "v"(x[8]), "v"(x[9]), "v"(x[10]), "v"(x[11]), "v"(x[12]));
    if constexpr (M == 14) asm("s_nop 1\n\tv_fmac_f32_dpp %0, %4, %5 row_newbcast:0 row_mask:0xf bank_mask:0xf\n\tv_fmac_f32_dpp %1, %4, %6 row_newbcast:1 row_mask:0xf bank_mask:0xf\n\tv_fmac_f32_dpp %2, %4, %7 row_newbcast:2 row_mask:0xf bank_mask:0xf\n\tv_fmac_f32_dpp %3, %4, %8 row_newbcast:3 row_mask:0xf bank_mask:0xf\n\tv_fmac_f32_dpp %0, %4, %9 row_newbcast:4 row_mask:0xf bank_mask:0xf\n\tv_fmac_f32_dpp %1, %4, %10 row_newbcast:5 row_mask:0xf bank_mask:0xf\n\tv_fmac_f32_dpp %2, %4, %11 row_newbcast:6 row_mask:0xf bank_mask:0xf\n\tv_fmac_f32_dpp %3, %4, %12 row_newbcast:7 row_mask:0xf bank_mask:0xf\n\tv_fmac_f32_dpp %0, %4, %13 row_newbcast:8 row_mask:0xf bank_mask:0xf\n\tv_fmac_f32_dpp %1, %4, %14 row_newbcast:9 row_mask:0xf bank_mask:0xf\n\tv_fmac_f32_dpp %2, %4, %15 row_newbcast:10 row_mask:0xf bank_mask:0xf\n\tv_fmac_f32_dpp %3, %4, %16 row_newbcast:11 row_mask:0xf bank_mask:0xf\n\tv_fmac_f32_dpp %0, %4, %17 row_newbcast:12 row_mask:0xf bank_mask:0xf\n\tv_fmac_f32_dpp %1, %4, %18 row_newbcast:13 row_mask:0xf bank_mask:0xf" : "+v"(s[0]), "+v"(s[1]), "+v"(s[2]), "+v"(s[3]) : "v"(t), "v"(x[0]), "v"(x[1]), "v"(x[2]), "v"(x[3]), "v"(x[4]), "v"(x[5]), "v"(x[6]), "v"(x[7]), "v"(x[8]), "v"(x[9]), "v"(x[10]), "v"(x[11]), "v"(x[12]), "v"(x[13]));
    if constexpr (M == 15) asm("s_nop 1\n\tv_fmac_f32_dpp %0, %4, %5 row_newbcast:0 row_mask:0xf bank_mask:0xf\n\tv_fmac_f32_dpp %1, %4, %6 row_newbcast:1 row_mask:0xf bank_mask:0xf\n\tv_fmac_f32_dpp %2, %4, %7 row_newbcast:2 row_mask:0xf bank_mask:0xf\n\tv_fmac_f32_dpp %3, %4, %8 row_newbcast:3 row_mask:0xf bank_mask:0xf\n\tv_fmac_f32_dpp %0, %4, %9 row_newbcast:4 row_mask:0xf bank_mask:0xf\n\tv_fmac_f32_dpp %1, %4, %10 row_newbcast:5 row_mask:0xf bank_mask:0xf\n\tv_fmac_f32_dpp %2, %4, %11 row_newbcast:6 row_mask:0xf bank_mask:0xf\n\tv_fmac_f32_dpp %3, %4, %12 row_newbcast:7 row_mask:0xf bank_mask:0xf\n\tv_fmac_f32_dpp %0, %4, %13 row_newbcast:8 row_mask:0xf bank_mask:0xf\n\tv_fmac_f32_dpp %1, %4, %14 row_newbcast:9 row_mask:0xf bank_mask:0xf\n\tv_fmac_f32_dpp %2, %4, %15 row_newbcast:10 row_mask:0xf bank_mask:0xf\n\tv_fmac_f32_dpp %3, %4, %16 row_newbcast:11 row_mask:0xf bank_mask:0xf\n\tv_fmac_f32_dpp %0, %4, %17 row_newbcast:12 row_mask:0xf bank_mask:0xf\n\tv_fmac_f32_dpp %1, %4, %18 row_newbcast:13 row_mask:0xf bank_mask:0xf\n\tv_fmac_f32_dpp %2, %4, %19 row_newbcast:14 row_mask:0xf bank_mask:0xf" : "+v"(s[0]), "+v"(s[1]), "+v"(s[2]), "+v"(s[3]) : "v"(t), "v"(x[0]), "v"(x[1]), "v"(x[2]), "v"(x[3]), "v"(x[4]), "v"(x[5]), "v"(x[6]), "v"(x[7]), "v"(x[8]), "v"(x[9]), "v"(x[10]), "v"(x[11]), "v"(x[12]), "v"(x[13]), "v"(x[14]));
    if constexpr (M == 16) asm("s_nop 1\n\tv_fmac_f32_dpp %0, %4, %5 row_newbcast:0 row_mask:0xf bank_mask:0xf\n\tv_fmac_f32_dpp %1, %4, %6 row_newbcast:1 row_mask:0xf bank_mask:0xf\n\tv_fmac_f32_dpp %2, %4, %7 row_newbcast:2 row_mask:0xf bank_mask:0xf\n\tv_fmac_f32_dpp %3, %4, %8 row_newbcast:3 row_mask:0xf bank_mask:0xf\n\tv_fmac_f32_dpp %0, %4, %9 row_newbcast:4 row_mask:0xf bank_mask:0xf\n\tv_fmac_f32_dpp %1, %4, %10 row_newbcast:5 row_mask:0xf bank_mask:0xf\n\tv_fmac_f32_dpp %2, %4, %11 row_newbcast:6 row_mask:0xf bank_mask:0xf\n\tv_fmac_f32_dpp %3, %4, %12 row_newbcast:7 row_mask:0xf bank_mask:0xf\n\tv_fmac_f32_dpp %0, %4, %13 row_newbcast:8 row_mask:0xf bank_mask:0xf\n\tv_fmac_f32_dpp %1, %4, %14 row_newbcast:9 row_mask:0xf bank_mask:0xf\n\tv_fmac_f32_dpp %2, %4, %15 row_newbcast:10 row_mask:0xf bank_mask:0xf\n\tv_fmac_f32_dpp %3, %4, %16 row_newbcast:11 row_mask:0xf bank_mask:0xf\n\tv_fmac_f32_dpp %0, %4, %17 row_newbcast:12 row_mask:0xf bank_mask:0xf\n\tv_fmac_f32_dpp %1, %4, %18 row_newbcast:13 row_mask:0xf bank_mask:0xf\n\tv_fmac_f32_dpp %2, %4, %19 row_newbcast:14 row_mask:0xf bank_mask:0xf\n\tv_fmac_f32_dpp %3, %4, %20 row_newbcast:15 row_mask:0xf bank_mask:0xf" : "+v"(s[0]), "+v"(s[1]), "+v"(s[2]), "+v"(s[3]) : "v"(t), "v"(x[0]), "v"(x[1]), "v"(x[2]), "v"(x[3]), "v"(x[4]), "v"(x[5]), "v"(x[6]), "v"(x[7]), "v"(x[8]), "v"(x[9]), "v"(x[10]), "v"(x[11]), "v"(x[12]), "v"(x[13]), "v"(x[14]), "v"(x[15]));
}
template <int DIR> __device__ __forceinline__ int eidx(int i, int j) { return DIR == 0 ? i * PP_PITCH + j : (63 - i) * PP_PITCH + (63 - j); }
template <int R> __device__ __forceinline__ void diag_row(float (&dg)[16], const float (&t)[16], int c) {
    float s[4] = {0.f, 0.f, 0.f, 0.f};
    if constexpr (R > 0) fmac_chunk<(R > 0 ? R : 1)>(s, t[R], dg);
    dg[R] = ((c == R) ? 1.f : 0.f) - ((s[0] + s[1]) + (s[2] + s[3]));
}
template <int... Rs> __device__ __forceinline__ void diag_rows(float (&dg)[16], const float (&t)[16], int c, std::integer_sequence<int, Rs...>) { (diag_row<Rs>(dg, t, c), ...); }
template <int DIR> __device__ __forceinline__ void prep_solve(LAS float* P, LAS float* S, int lane_) {
    int lane = lane_; asm volatile("" : "+v"(lane));
    const int q = lane >> 4, n = lane & 15;
    {
        LAS float* Bd = P + eidx<DIR>(16 * q, 16 * q + n); constexpr int RS = DIR == 0 ? PP_PITCH : -PP_PITCH;
        float t[16], dg[16];
#pragma unroll
        for (int r = 0; r < 16; ++r) t[r] = Bd[r * RS];
        diag_rows(dg, t, n, std::make_integer_sequence<int, 16>{});
#pragma unroll
        for (int r = 1; r < 16; ++r) if (n < r) Bd[r * RS] = dg[r];
    }
#pragma unroll
    for (int I = 1; I < 4; ++I) {
        f32x4 xs[3];
#pragma unroll
        for (int J = I - 1; J >= 0; --J) {
            f32x4 acc = {0.f, 0.f, 0.f, 0.f};
#pragma unroll
            for (int K = J; K < I; ++K)
#pragma unroll
                for (int ks = 0; ks < 4; ++ks) { const int kk = 4 * ks + q;
                    const float a = P[eidx<DIR>(16 * I + n, 16 * K + kk)];
                    float b = P[eidx<DIR>(16 * K + kk, 16 * J + n)];
                    if (K == J) b = n < kk ? b : (n == kk ? 1.f : 0.f);
                    acc = __builtin_amdgcn_mfma_f32_16x16x4f32(a, b, acc, 0, 0, 0); }
#pragma unroll
            for (int r = 0; r < 4; ++r) S[(4 * q + r) * 17 + n] = acc[r];
            f32x4 acc2 = {0.f, 0.f, 0.f, 0.f};
#pragma unroll
            for (int ks = 0; ks < 4; ++ks) { const int kk = 4 * ks + q;
                float a = P[eidx<DIR>(16 * I + n, 16 * I + kk)]; a = kk < n ? a : (kk == n ? 1.f : 0.f);
                acc2 = __builtin_amdgcn_mfma_f32_16x16x4f32(a, S[kk * 17 + n], acc2, 0, 0, 0); }
            xs[J] = -acc2;
        }
#pragma unroll
        for (int J = 0; J < I; ++J)
#pragma unroll
            for (int r = 0; r < 4; ++r) P[eidx<DIR>(16 * I + 4 * q + r, 16 * J + n)] = xs[J][r];
    }
}
__device__ __forceinline__ void prep_store(const LAS float* P, int half, int lane, bf16* ta) {
#pragma unroll
    for (int it = 0; it < 8; ++it) { const int row = half * 32 + it * 4 + (lane >> 4), g = lane & 15;
        f32x4 v = *(const LAS f32x4*)(P + row * PP_PITCH + 4 * g);
        if ((row >> 2) == g) v[row & 3] = 1.f;
        *(v2u*)((unsigned char*)ta + off128(row, 4 * (g >> 3) + (g & 3)) + 8 * ((g >> 2) & 1)) = (v2u){pk2(v[0], v[1]), pk2(v[2], v[3])}; }
}
__device__ __forceinline__ void conv_tile(Frame& F, int uid) {
    const float* cw = F.in[I_CONVW];
    const int lane = F.lane, tg = lane >> 4, c8 = lane & 15;
    {
        int which, bh, ck, Lx; const bf16* src; bf16* dst;
        if (uid < 192) { which = uid / 64; bh = (uid % 64) >> 2; ck = uid & 3; Lx = LCTX; src = WSP(bf16, WS_QKVC_RAW) + (size_t)((which * 16 + bh) * LCTX) * 128; dst = WSP(bf16, WS_QKVC) + (size_t)((which * 16 + bh) * LCTX) * 128; }
        else { const int v = uid - 192; which = v / (16 * NCHL); const int rem = v % (16 * NCHL); bh = rem / NCHL; ck = 0; Lx = CHK; bf16* p = WSP(bf16, WS_QKV) + ((size_t)(which * 16 + bh) * SEQ + (rem % NCHL) * CHK) * 128; src = p; dst = p; }
        const int h = bh & 7, ch0 = which * 1024 + h * 128 + c8 * 8, t0 = ck * 64 + tg * 16;
        float w[5][8];
#pragma unroll
        for (int j = 0; j < 5; ++j) { const f32x4 a = *(const f32x4*)(cw + j * 3072 + ch0), b2 = *(const f32x4*)(cw + j * 3072 + ch0 + 4);
            w[j][0] = a[0]; w[j][1] = a[1]; w[j][2] = a[2]; w[j][3] = a[3]; w[j][4] = b2[0]; w[j][5] = b2[1]; w[j][6] = b2[2]; w[j][7] = b2[3]; }
        v4u xr[20];
#pragma unroll
        for (int r = 0; r < 20; ++r) { const int t = t0 + r - 2; xr[r] = (t >= 0 && t < Lx) ? *(const v4u*)(src + (size_t)t * 128 + c8 * 8) : (v4u){0u, 0u, 0u, 0u}; }
        asm volatile("s_waitcnt vmcnt(0)" ::: "memory");
        float win[5][8];
#pragma unroll
        for (int r = 0; r < 4; ++r) unpack8(xr[r], win[r + 1]);
#pragma unroll
        for (int t = 0; t < 16; ++t) {
#pragma unroll
            for (int r = 0; r < 4; ++r)
#pragma unroll
                for (int e = 0; e < 8; ++e) win[r][e] = win[r + 1][e];
            unpack8(xr[t + 4], win[4]);
            float y[8]; float ss = 0.f;
#pragma unroll
            for (int e = 0; e < 8; ++e) { float a = w[0][e] * win[0][e]; a += w[1][e] * win[1][e]; a += w[2][e] * win[2][e]; a += w[3][e] * win[3][e]; a += w[4][e] * win[4][e]; y[e] = siluf_(a); ss += y[e] * y[e]; }
            if (which < 2) { ss = sum16(ss);
                const float sc = (__builtin_amdgcn_rsqf(ss + EPS)) * (which == 0 ? 0.08838834764831845f : 1.f);
#pragma unroll
                for (int e = 0; e < 8; ++e) y[e] *= sc; }
            const v4u pk = pack8(y);
            if (which < 2) {
                const int rt = (t0 + t) & 63; unsigned char* tb = (unsigned char*)(dst + (size_t)((t0 + t) - rt) * 128);
                const int ks = c8 >> 2, bb = (c8 >> 1) & 1, fqb = 2 * (c8 & 1);
                *(v2u*)(tb + off256(rt, 4 * ks + fqb) + 8 * bb) = (v2u){pk.x, pk.y}; *(v2u*)(tb + off256(rt, 4 * ks + fqb + 1) + 8 * bb) = (v2u){pk.z, pk.w};
            } else *(v4u*)(dst + (size_t)(t0 + t) * 128 + c8 * 8) = pk;
        }
    }
}
__device__ __forceinline__ void dn_prep4(Frame& F, int item) {
    int lane_ = F.lane; asm volatile("" : "+v"(lane_));
    const int w = F.wave, lane = lane_, fr = lane & 15, fq = lane >> 4, uu = w >> 1, which = w & 1;
    const PrepUnit U = prep_unit(F, item * 4 + uu);
    LAS float* P = (LAS float*)(F.lds + uu * PP_BYTES);
    LAS float* Gf = (LAS float*)(F.lds + PP_GOFF + uu * 1024); LAS float* Gb = Gf + 64; LAS float* Bf = Gf + 128; LAS float* Bb = Gf + 192;
    {
        const float* bd = WSP(float, WS_BD) + (size_t)(U.rowbase + lane) * 32;
        const float bfv = sigmoidf_(bd[U.h]), bbv = sigmoidf_(bd[8 + U.h]);
        const float gfv = -__expf(F.in[I_ALOG][U.h]) * softplusf_(bd[16 + U.h] + F.in[I_DTB][U.h]);
        const float gbv = -__expf(F.in[I_ALOG][8 + U.h]) * softplusf_(bd[24 + U.h] + F.in[I_DTB][8 + U.h]);
        float pf = gfv, pb = gbv;
#pragma unroll
        for (int o = 1; o < 64; o <<= 1) { const float nf = __shfl_up(pf, o), nb = __shfl_up(pb, o); if (lane >= o) { pf += nf; pb += nb; } }
        const float totf = __shfl(pf, 63), totb = __shfl(pb, 63);
        const float sfx = totb - pb + gbv;
        if (which == 0) { Gf[lane] = pf; Gb[lane] = sfx; Bf[lane] = bfv; Bb[lane] = bbv;
            float* sc0 = DOP(float, DO_SC) + (size_t)(((0 * 2 + U.b) * 8 + U.h) * NCH + U.ch132) * SCBLK + lane;
            float* sc1 = DOP(float, DO_SC) + (size_t)(((1 * 2 + U.b) * 8 + U.h) * NCH + U.ch132) * SCBLK + lane;
            { const float eg = __expf(pf); sc0[0] = bfv * eg; sc0[64] = __expf(totf - pf); sc0[128] = eg; sc0[192] = bfv; }
            { const float eg = __expf(sfx); sc1[0] = bbv * eg; sc1[64] = __expf(totb - sfx); sc1[128] = eg; sc1[192] = bbv; } }
    }
    __syncthreads();
    {
        const bf16* asrc = which ? U.qbase : U.kbase;
        LAS unsigned char* AT = (LAS unsigned char*)(F.lds + PP_GOFF + 4096 + 8 * 1088 + uu * 8192);
        bf16x8 bfr[4][4], afa[4][4];
#pragma unroll
        for (int nt = 0; nt < 4; ++nt)
#pragma unroll
            for (int ks = 0; ks < 4; ++ks) { bfr[nt][ks] = *(const bf16x8*)((const unsigned char*)U.kbase + off256(16 * nt + fr, 4 * ks + fq)); afa[nt][ks] = *(const bf16x8*)((const unsigned char*)asrc + off256(16 * nt + fr, 4 * ks + fq)); }
#pragma unroll
        for (int mt = 0; mt < 4; ++mt) {
            const f32x4 gfi = *(const LAS f32x4*)(Gf + 16 * mt + 4 * fq), gbi = *(const LAS f32x4*)(Gb + 16 * mt + 4 * fq);
            const f32x4 bfi = *(const LAS f32x4*)(Bf + 16 * mt + 4 * fq), bbi = *(const LAS f32x4*)(Bb + 16 * mt + 4 * fq);
#pragma unroll
            for (int nt = 0; nt < 4; ++nt) {
                f32x4 Dm = {0.f, 0.f, 0.f, 0.f};
#pragma unroll
                for (int ks = 0; ks < 4; ++ks) Dm = MFMA16(afa[mt][ks], bfr[nt][ks], Dm);
                const int oj = 16 * nt + fr; const float gfj = Gf[oj], gbj = Gb[oj];
#pragma unroll
                for (int r = 0; r < 4; ++r) { const int oi = 16 * mt + 4 * fq + r;
                    const float dec = mt > nt ? __expf(gfi[r] - gfj) : (mt < nt ? __expf(gbi[r] - gbj) : (oi > oj ? __expf(gfi[r] - gfj) : (oi < oj ? __expf(gbi[r] - gbj) : 1.f)));
                    const float bsel = mt > nt ? bfi[r] : (mt < nt ? bbi[r] : (oi > oj ? bfi[r] : bbi[r]));
                    if (which == 0) P[oi * PP_PITCH + oj] = bsel * Dm[r] * dec;
                    else *(LAS bf16*)(AT + img128_byte(oi, oj)) = (bf16)pk2(Dm[r] * dec, 0.f); }
            }
        }
        if (which) {
            asm volatile("s_waitcnt lgkmcnt(0)" ::: "memory");
#pragma unroll
            for (int p8 = 0; p8 < 8; ++p8) *(v4u*)((unsigned char*)U.ta + 8192 + (p8 * 64 + lane) * 16) = *(const LAS v4u*)(AT + (p8 * 64 + lane) * 16);
        }
    }
    __syncthreads();
    { LAS float* S = (LAS float*)(F.lds + PP_GOFF + 4096 + w * 1088); if (which == 0) prep_solve<0>(P, S, lane); else prep_solve<1>(P, S, lane); }
    __syncthreads();
    prep_store(P, which, lane, U.ta);
    __syncthreads();
}
__device__ __forceinline__ void phase4(Frame& F) {
    constexpr int N_DN = (64 + 16 * NCHL) / 4;
    const bool s5wg = F.vcu >= 16 && F.vcu < 240;
    if (s5wg) {
        if (F.wave < 4) {
            for (int it = F.vcu; it < N_DN; it += F.G)
#pragma unroll 1
                for (int j = F.wave; j < 12; j += 4) { const int un = it * 4 + (j & 3), which = j >> 2;
                    conv_tile(F, un < 64 ? which * 64 + un : 192 + which * (16 * NCHL) + (un - 64)); }
        } else s5a_group(F, (F.vcu - 16) & 31, (F.vcu - 16) >> 5, 7, 0, 4, F.wave - 4, 24);
    } else {
        for (int it = F.vcu; it < N_DN; it += F.G)
#pragma unroll 1
            for (int j = F.wave; j < 12; j += NWAVES) { const int un = it * 4 + (j & 3), which = j >> 2;
                conv_tile(F, un < 64 ? which * 64 + un : 192 + which * (16 * NCHL) + (un - 64)); }
    }
    asm volatile("s_waitcnt vmcnt(0)" ::: "memory");
    __syncthreads();
    for (int it = F.vcu; it < N_DN; it += F.G) dn_prep4(F, it);
    if (s5wg) { __syncthreads(); s5a_group(F, (F.vcu - 16) & 31, (F.vcu - 16) >> 5, 7, 24, 8, F.wave, 1 << 20);
        __syncthreads(); phase0<1>(F, (F.vcu - 16) * NWAVES + F.wave, 224 * NWAVES); phase0<2>(F, (F.vcu - 16) * NWAVES + F.wave, 224 * NWAVES, 0, 896); }
    else if (F.vcu >= 240) { __syncthreads(); phase0<2>(F, (F.vcu - 240) * NWAVES + F.wave, 16 * NWAVES, 896, 1792); }
}
__device__ __forceinline__ void s5c_group(Frame& F, int g, int q0, int nq) {
    const int lane = F.lane;
    constexpr int WST = S5_BUF_BYTES + 2048 + 4096;
    static_assert(8 * WST <= RING_BYTES && S5_HT_BYTES <= S5_BUF_BYTES, "S5 LDS");
    LAS float* buf = (LAS float*)(F.lds + F.wave * WST); LAS unsigned char* hT = F.lds + F.wave * WST; LAS unsigned* ubw = (LAS unsigned*)(F.lds + F.wave * WST + S5_BUF_BYTES); LAS float* yb = (LAS float*)(F.lds + F.wave * WST + S5_BUF_BYTES + 2048);
    s16x4k bbf0[8], bbf1[8]; s5_load_bbf(F, g, lane, bbf0); s5_load_bbf(F, 32 + g, lane, bbf1);
    bf16x8 cbf0[4], cbf1[4];
    { const bf16* c0 = TABP(bf16, TAB_CBT) + (size_t)g * 2048; const bf16* c1 = TABP(bf16, TAB_CBT) + (size_t)(32 + g) * 2048;
#pragma unroll
      for (int ks = 0; ks < 4; ++ks) { cbf0[ks] = *(const bf16x8*)(c0 + (lane & 15) * 128 + 32 * ks + 8 * (lane >> 4)); cbf1[ks] = *(const bf16x8*)(c1 + (lane & 15) * 128 + 32 * ks + 8 * (lane >> 4)); } }
    const f32x2 a0 = TABP(f32x2, TAB_ABAR)[g * 64 + lane], a1 = TABP(f32x2, TAB_ABAR)[(32 + g) * 64 + lane];
    float Dp[16];
#pragma unroll
    for (int c = 0; c < 16; ++c) Dp[c] = F.in[I_S5D][g * 16 + c];
    v4u na = {0u, 0u, 0u, 0u}, nc = na; f32x2 nh0 = {0.f, 0.f}, nh1 = nh0;
#define S5C_FETCH(un_) do { const int b_ = (un_) / NCHL, lc_ = (un_) % NCHL; const bf16* src_ = WSP(bf16, WS_U) + (size_t)(b_ * SEQ + lc_ * CHK + lane) * 512 + g * 16; na = *(const v4u*)src_; nc = *(const v4u*)(src_ + 8); \
        nh0 = DOP(f32x2, DO_EH)[(size_t)(((0 * 2 + b_) * NCH + 4 + lc_) * 32 + g) * 64 + lane]; nh1 = DOP(f32x2, DO_EH)[(size_t)(((1 * 2 + b_) * NCH + 4 + lc_) * 32 + g) * 64 + lane]; } while (0)
    if (q0 * 8 + F.wave < 2 * NCHL) S5C_FETCH(q0 * 8 + F.wave);
    for (int un = q0 * 8 + F.wave; un < 2 * NCHL; un += nq * 8) {
        const int b = un / NCHL, lc = un % NCHL, r0 = b * SEQ + lc * CHK;
        const f32x2 h00 = nh0, h01 = nh1;
        { const v4u a = na, c2 = nc;
          if (un + nq * 8 < 2 * NCHL) S5C_FETCH(un + nq * 8);
          *(LAS v4u*)(ubw + lane * 8) = a; *(LAS v4u*)(ubw + lane * 8 + 4) = c2;
          float f[8];
          unpack8(a, f); *(LAS f32x4*)(yb + lane * 16) = (f32x4){f[0] * Dp[0], f[1] * Dp[1], f[2] * Dp[2], f[3] * Dp[3]}; *(LAS f32x4*)(yb + lane * 16 + 4) = (f32x4){f[4] * Dp[4], f[5] * Dp[5], f[6] * Dp[6], f[7] * Dp[7]};
          unpack8(c2, f); *(LAS f32x4*)(yb + lane * 16 + 8) = (f32x4){f[0] * Dp[8], f[1] * Dp[9], f[2] * Dp[10], f[3] * Dp[11]}; *(LAS f32x4*)(yb + lane * 16 + 12) = (f32x4){f[4] * Dp[12], f[5] * Dp[13], f[6] * Dp[14], f[7] * Dp[15]}; }
        asm volatile("" ::: "memory");
        { float hr = h00.x, hi = h00.y; for (int ib = 0; ib < 4; ++ib) s5_block<true>(buf, hT, ubw, bbf0, cbf0, a0, hr, hi, 0, ib, lane, yb); }
        { float hr = h01.x, hi = h01.y; for (int ib = 0; ib < 4; ++ib) s5_block<true>(buf, hT, ubw, bbf1, cbf1, a1, hr, hi, 1, ib, lane, yb); }
#pragma unroll
        for (int rep = 0; rep < 4; ++rep) { const int t = rep * 16 + (lane >> 2), cq = lane & 3; const f32x4 yv = *(const LAS f32x4*)(yb + t * 16 + cq * 4);
            const unsigned lo = pk2(gelu_tanh(yv[0]), gelu_tanh(yv[1])), hi2 = pk2(gelu_tanh(yv[2]), gelu_tanh(yv[3]));
            *(unsigned long long*)(DOP(bf16, DO_Y) + (size_t)(r0 + t) * 512 + g * 16 + cq * 4) = (unsigned long long)lo | ((unsigned long long)hi2 << 32); }
        LDS_WAIT(); asm volatile("" ::: "memory");
    }
}
__device__ __forceinline__ void phase7(Frame& F) {
    const int lane = F.lane;
    const int gw = F.vcu * NWAVES + F.wave, NGW = F.G * NWAVES;
    const float* nw = F.in[I_DNNW] + (lane & 7) * 16;
    for (int r = gw; r < T; r += NGW) {
        const bf16* of = WSP(bf16, WS_ODIR) + (size_t)r * 1024 + lane * 16; const bf16* ob = of + (size_t)T * 1024; const bf16* zp = WSP(bf16, WS_ZDN) + (size_t)r * 1024 + lane * 16;
        float o[16], f[8], z[16];
        unpack8(*(const v4u*)of, o); unpack8(*(const v4u*)(of + 8), o + 8);
        unpack8(*(const v4u*)ob, f);
#pragma unroll
        for (int e = 0; e < 8; ++e) o[e] += f[e];
        unpack8(*(const v4u*)(ob + 8), f);
#pragma unroll
        for (int e = 0; e < 8; ++e) o[8 + e] += f[e];
        unpack8(*(const v4u*)zp, z); unpack8(*(const v4u*)(zp + 8), z + 8);
        float ss = 0.f;
#pragma unroll
        for (int e = 0; e < 16; ++e) ss += o[e] * o[e];
        ss = sum8(ss);
        const float rinv = __builtin_amdgcn_rsqf(ss * (1.f / 128.f) + EPS);
#pragma unroll
        for (int e = 0; e < 16; ++e) o[e] = o[e] * rinv * nw[e] * z[e];
        bf16* yo = WSP(bf16, WS_YDN) + (size_t)r * 1024 + lane * 16;
        *(v4u*)yo = pack8(o); *(v4u*)(yo + 8) = pack8(o + 8);
    }
}
struct EpiGates {
    static constexpr bool PERM = true, AFTER_DRAIN = false;
    const bf16* ODIR; const float* nw; bf16 *YDN, *GDN, *GS5; LAS float* red;
    __device__ __forceinline__ void operator()(const f32x4 (&acc)[2][2][4][2], const pg8::Unit& u, int wr, int wc, int fr_, int fq_) const {
        const int pn = u.pn; int fr = fr_, fq = fq_; asm volatile("" : "+v"(fr), "+v"(fq));
        if (pn < 18) {
            const int c0 = (pn - 14) * 256 + wc * 32 + 8 * fq;
            const bf16* pbase = ODIR + (size_t)(u.pm * 256 + wr * 64 + fr) * 1024 + c0;
#define EG_ISSUE(bt, ra, rb) do { _Pragma("unroll") for (int mi = 0; mi < 2; ++mi) _Pragma("unroll") for (int bj = 0; bj < 2; ++bj) { \
                const bf16* p = pbase + (size_t)(((bt) >> 1) * 128 + (((bt) & 1) * 2 + mi) * 16) * 1024 + bj * 128; ra[mi][bj] = *(const v4u*)p; rb[mi][bj] = *(const v4u*)(p + (size_t)T * 1024); } } while (0)
            {
                v4u ra0[2][2], rb0[2][2], ra1[2][2], rb1[2][2];
                EG_ISSUE(0, ra0, rb0);
#pragma unroll
                for (int bt = 0; bt < 4; ++bt) {
                    if (bt + 1 < 4) { if (bt & 1) EG_ISSUE(bt + 1, ra0, rb0); else EG_ISSUE(bt + 1, ra1, rb1); }
                    asm volatile("" ::: "memory");
#pragma unroll
                    for (int mi = 0; mi < 2; ++mi)
#pragma unroll
                        for (int bj = 0; bj < 2; ++bj) { float a[8], b[8]; unpack8((bt & 1) ? ra1[mi][bj] : ra0[mi][bj], a); unpack8((bt & 1) ? rb1[mi][bj] : rb0[mi][bj], b); float ss = 0.f;
#pragma unroll
                            for (int e = 0; e < 8; ++e) { const float o = a[e] + b[e]; ss += o * o; }
                            ss += __shfl_xor(ss, 16); ss += __shfl_xor(ss, 32);
                            if (fq == 0) red[(wc * 2 + bj) * 256 + (bt >> 1) * 128 + wr * 64 + ((bt & 1) * 2 + mi) * 16 + fr] = ss; }
                    asm volatile("" ::: "memory");
                }
            }
            {
#define EG2_ISSUE(it, ra, rb) do { _Pragma("unroll") for (int bj = 0; bj < 2; ++bj) { const bf16* p = pbase + (size_t)(((it) >> 2) * 128 + ((it) & 3) * 16) * 1024 + bj * 128; ra[bj] = *(const v4u*)p; rb[bj] = *(const v4u*)(p + (size_t)T * 1024); } } while (0)
                v4u a0[2], b0[2], a1[2], b1[2];
                EG2_ISSUE(0, a0, b0);
                const f32x4 nwa = *(const f32x4*)(nw + wc * 32 + 8 * fq), nwb = *(const f32x4*)(nw + wc * 32 + 8 * fq + 4);
                asm volatile("s_waitcnt lgkmcnt(0)" ::: "memory");
                __builtin_amdgcn_s_barrier();
                const float nwv[8] = {nwa[0], nwa[1], nwa[2], nwa[3], nwb[0], nwb[1], nwb[2], nwb[3]};
#pragma unroll
                for (int it = 0; it < 8; ++it) { const int ai = it >> 2, m = it & 3, rl = ai * 128 + wr * 64 + m * 16 + fr;
                    if (it + 1 < 8) { if (it & 1) EG2_ISSUE(it + 1, a0, b0); else EG2_ISSUE(it + 1, a1, b1); }
                    asm volatile("" ::: "memory");
#pragma unroll
                    for (int bj = 0; bj < 2; ++bj) {
                        const float rinv = __builtin_amdgcn_rsqf(((red[bj * 256 + rl] + red[(2 + bj) * 256 + rl]) + (red[(4 + bj) * 256 + rl] + red[(6 + bj) * 256 + rl])) * (1.f / 128.f) + EPS);
                        float a[8], b[8]; unpack8((it & 1) ? a1[bj] : a0[bj], a); unpack8((it & 1) ? b1[bj] : b0[bj], b);
                        f32x4 v0 = acc[ai][bj][m][0], v1 = acc[ai][bj][m][1]; asm volatile("" : "+v"(v0), "+v"(v1));
                        const float z[8] = {v0[0], v0[1], v0[2], v0[3], v1[0], v1[1], v1[2], v1[3]};
#pragma unroll
                        for (int e = 0; e < 8; ++e) a[e] = (a[e] + b[e]) * rinv * nwv[e] * siluf_(z[e]);
                        *(v4u*)(YDN + (size_t)(u.pm * 256 + rl) * 1024 + c0 + bj * 128) = pack8(a); }
                    asm volatile("" ::: "memory");
                }
#undef EG2_ISSUE
            }
#undef EG_ISSUE
        } else {
#pragma unroll
            for (int ai = 0; ai < 2; ++ai)
#pragma unroll
                for (int m = 0; m < 4; ++m) { const int row = u.pm * 256 + ai * 128 + wr * 64 + m * 16 + fr;
#pragma unroll
                    for (int bj = 0; bj < 2; ++bj) { const f32x4 v0 = acc[ai][bj][m][0], v1 = acc[ai][bj][m][1]; float f[8] = {v0[0], v0[1], v0[2], v0[3], v1[0], v1[1], v1[2], v1[3]};
                        const int colin = bj * 128 + wc * 32 + 8 * fq;
#pragma unroll
                        for (int e = 0; e < 8; ++e) f[e] = sigmoidf_(f[e]);
                        if (pn < 24) *(v4u*)(GDN + (size_t)row * 1024 + (pn - 20) * 256 + colin) = pack8(f);
                        else *(v4u*)(GS5 + (size_t)row * 1024 + (pn - 24) * 256 + colin) = pack8(f); } }
        }
    }
};
struct EpiGlu {
    static constexpr bool PERM = true, AFTER_DRAIN = false;
    const bf16* Y; const bf16* ZS5; const float* gb; bf16* O;
    __device__ __forceinline__ void operator()(const f32x4 (&acc)[2][2][4][2], const pg8::Unit& u, int wr, int wc, int fr, int fq) const {
#pragma unroll
        for (int ai = 0; ai < 2; ++ai)
#pragma unroll
            for (int m = 0; m < 4; ++m) { const int row = u.pm * 256 + ai * 128 + wr * 64 + m * 16 + fr;
#pragma unroll
                for (int bj = 0; bj < 2; ++bj) { const int col = u.pn * 256 + bj * 128 + wc * 32 + 8 * fq; const size_t o = (size_t)row * 512 + col;
                    const f32x4 v0 = acc[ai][bj][m][0], v1 = acc[ai][bj][m][1]; float a[8] = {v0[0], v0[1], v0[2], v0[3], v1[0], v1[1], v1[2], v1[3]}, y[8], z[8];
                    unpack8(*(const v4u*)(Y + o), y); unpack8(*(const v4u*)(ZS5 + o), z);
#pragma unroll
                    for (int e = 0; e < 8; ++e) a[e] = y[e] * sigmoidf_(a[e] + gb[col + e]) * z[e];
                    *(v4u*)(O + o) = pack8(a); } }
    }
};
struct EpiGate {
    static constexpr bool PERM = true, AFTER_DRAIN = false;
    const bf16* Gt; const bf16* P; bf16* O; int add;
    __device__ __forceinline__ void operator()(const f32x4 (&acc)[2][2][4][2], const pg8::Unit& u, int wr, int wc, int fr, int fq) const {
#pragma unroll
        for (int ai = 0; ai < 2; ++ai)
#pragma unroll
            for (int m = 0; m < 4; ++m) { const int row = u.pm * 256 + ai * 128 + wr * 64 + m * 16 + fr;
#pragma unroll
                for (int bj = 0; bj < 2; ++bj) { const int col = u.pn * 256 + bj * 128 + wc * 32 + 8 * fq; const size_t o = (size_t)row * 1024 + col;
                    const f32x4 v0 = acc[ai][bj][m][0], v1 = acc[ai][bj][m][1]; float a[8] = {v0[0], v0[1], v0[2], v0[3], v1[0], v1[1], v1[2], v1[3]}, g[8], p[8];
                    unpack8(*(const v4u*)(Gt + o), g);
                    if (add) { unpack8(*(const v4u*)(P + o), p);
#pragma unroll
                        for (int e = 0; e < 8; ++e) a[e] = p[e] + g[e] * a[e]; }
                    else {
#pragma unroll
                        for (int e = 0; e < 8; ++e) a[e] = g[e] * a[e]; }
                    *(v4u*)(O + o) = pack8(a); } }
    }
};
struct EpiMerge {
    static constexpr bool PERM = true, AFTER_DRAIN = false;
    const bf16* GDN; const bf16* GS5; bf16* O;
    __device__ __forceinline__ void mid(f32x4 (&acc)[2][2][4][2], const pg8::Unit& u, int wr, int wc, int fr, int fq) const {
#pragma unroll
        for (int ai = 0; ai < 2; ++ai)
#pragma unroll
            for (int m = 0; m < 4; ++m) { const int row = u.pm * 256 + ai * 128 + wr * 64 + m * 16 + fr;
#pragma unroll
                for (int bj = 0; bj < 2; ++bj) { const int col = u.pn * 256 + bj * 128 + wc * 32 + 8 * fq; const size_t o = (size_t)row * 1024 + col;
                    const v4u r1 = *(const v4u*)(GDN + o), r2 = *(const v4u*)(GS5 + o);
                    const unsigned w1[4] = {r1.x, r1.y, r1.z, r1.w}, w2[4] = {r2.x, r2.y, r2.z, r2.w};
#pragma unroll
                    for (int w = 0; w < 4; ++w) {
                        const float ra = bf2f(w1[w] & 0xffffu) * __builtin_amdgcn_rcpf(fmaxf(bf2f(w2[w] & 0xffffu), 1e-30f)), rb = bf2f(w1[w] >> 16) * __builtin_amdgcn_rcpf(fmaxf(bf2f(w2[w] >> 16), 1e-30f));
                        acc[ai][bj][m][w >> 1][2 * (w & 1)] *= ra; acc[ai][bj][m][w >> 1][2 * (w & 1) + 1] *= rb; }
                    asm volatile("" ::: "memory"); } }
    }
    __device__ __forceinline__ void operator()(const f32x4 (&acc)[2][2][4][2], const pg8::Unit& u, int wr, int wc, int fr, int fq) const {
        const size_t o0 = (size_t)(u.pm * 256 + wr * 64 + fr) * 1024 + u.pn * 256 + wc * 32 + 8 * fq;
#define EMF_ISSUE(it, bg) do { _Pragma("unroll") for (int bj = 0; bj < 2; ++bj) bg[bj] = *(const v4u*)(GS5 + o0 + (size_t)(((it) >> 2) * 128 + ((it) & 3) * 16) * 1024 + bj * 128); } while (0)
        v4u g0[2], g1[2], g2b[2];
        EMF_ISSUE(0, g0); EMF_ISSUE(1, g1);
#pragma unroll
        for (int it = 0; it < 8; ++it) { const int ai = it >> 2, m = it & 3;
            if (it + 2 < 8) { if (it % 3 == 0) EMF_ISSUE(it + 2, g2b); else if (it % 3 == 1) EMF_ISSUE(it + 2, g0); else EMF_ISSUE(it + 2, g1); }
            asm volatile("" ::: "memory");
#pragma unroll
            for (int bj = 0; bj < 2; ++bj) { const size_t o = o0 + (size_t)(ai * 128 + m * 16) * 1024 + bj * 128;
                const f32x4 v0 = acc[ai][bj][m][0], v1 = acc[ai][bj][m][1]; float a[8] = {v0[0], v0[1], v0[2], v0[3], v1[0], v1[1], v1[2], v1[3]}, g2[8];
                unpack8(it % 3 == 0 ? g0[bj] : (it % 3 == 1 ? g1[bj] : g2b[bj]), g2);
#pragma unroll
                for (int e = 0; e < 8; ++e) a[e] *= g2[e];
                *(v4u*)(O + o) = pack8(a); }
            asm volatile("" ::: "memory"); }
#undef EMF_ISSUE
    }
};
struct EpiOut {
    static constexpr bool PERM = false, AFTER_DRAIN = false;
    const float* X; const float* gate; float* O;
    __device__ __forceinline__ void operator()(const f32x4 (&acc)[2][2][4][2], const pg8::Unit& u, int wr, int wc, int fr, int fq) const {
#pragma unroll
        for (int ai = 0; ai < 2; ++ai)
#pragma unroll
            for (int m = 0; m < 4; ++m) { const int row = u.pm * 256 + ai * 128 + wr * 64 + m * 16 + fr; const float* gt = gate + (row >> 13) * 1024;
#pragma unroll
                for (int bj = 0; bj < 2; ++bj)
#pragma unroll
                    for (int n = 0; n < 2; ++n) { const int col = u.pn * 256 + bj * 128 + wc * 32 + 16 * n + 4 * fq; const size_t o = (size_t)row * 1024 + col;
                        *(f32x4*)(O + o) = *(const f32x4*)(X + o) + *(const f32x4*)(gt + col) * acc[ai][bj][m][n]; } }
    }
};
struct EpiOutNorm {
    static constexpr bool PERM = false, AFTER_DRAIN = true;
    const float* X; const float* gate; const float* fnw; float* O; unsigned long long* gran;
    __device__ __forceinline__ void operator()(const f32x4 (&acc)[2][2][4][2], const pg8::Unit& u, int wr, int wc, int fr, int fq) const {}
    __device__ __forceinline__ void fused(f32x4 (&acc)[2][2][4][2], const pg8::Unit& u, int wr, int wc, int fr, int fq, LAS unsigned char* lds, int wid, int lane) const {
        LAS float* red = (LAS float*)lds;
#pragma unroll
        for (int ai = 0; ai < 2; ++ai)
#pragma unroll
            for (int m = 0; m < 4; ++m) { const int rl = ai * 128 + wr * 64 + m * 16 + fr, row = u.pm * 256 + rl; const float* gt = gate + (row >> 13) * 1024; float s = 0.f;
#pragma unroll
                for (int bj = 0; bj < 2; ++bj)
#pragma unroll
                    for (int n = 0; n < 2; ++n) { const int col = u.pn * 256 + bj * 128 + wc * 32 + 16 * n + 4 * fq; const size_t o = (size_t)row * 1024 + col;
                        const f32x4 y = __builtin_nontemporal_load((const f32x4*)(X + o)) + *(const f32x4*)(gt + col) * acc[ai][bj][m][n]; acc[ai][bj][m][n] = y;
                        s += (y.x * y.x + y.y * y.y) + (y.z * y.z + y.w * y.w); }
                s += __shfl_xor(s, 16); s += __shfl_xor(s, 32);
                if (fq == 0) red[wc * 256 + rl] = s; }
        __syncthreads();
        const int t = wid * 64 + lane;
        if (t < 256) {
            const float mine = (red[t] + red[256 + t]) + (red[512 + t] + red[768 + t]);
            unsigned long long* g = gran + u.pm * 256 + t;
            __hip_atomic_store(g + (size_t)u.pn * T, (unsigned long long)__builtin_bit_cast(unsigned, mine) | (1ull << 32), __ATOMIC_RELAXED, __HIP_MEMORY_SCOPE_AGENT);
            float s4 = 0.f;
#pragma unroll
            for (int j = 0; j < 4; ++j) { unsigned long long v;
                if (j == u.pn) { s4 += mine; continue; }
                while (((v = __hip_atomic_load(g + (size_t)j * T, __ATOMIC_RELAXED, __HIP_MEMORY_SCOPE_AGENT)) >> 32) == 0ull) __builtin_amdgcn_s_sleep(1);
                s4 += __builtin_bit_cast(float, (unsigned)v); }
            red[1024 + t] = __builtin_amdgcn_rsqf(s4 * (1.f / D) + EPS); }
        __syncthreads();
#pragma unroll
        for (int ai = 0; ai < 2; ++ai)
#pragma unroll
            for (int m = 0; m < 4; ++m) { const int rl = ai * 128 + wr * 64 + m * 16 + fr, row = u.pm * 256 + rl; const float rinv = red[1024 + rl];
#pragma unroll
                for (int bj = 0; bj < 2; ++bj)
#pragma unroll
                    for (int n = 0; n < 2; ++n) { const int col = u.pn * 256 + bj * 128 + wc * 32 + 16 * n + 4 * fq; const size_t o = (size_t)row * 1024 + col;
                        *(f32x4*)(O + o) = acc[ai][bj][m][n] * rinv * *(const f32x4*)(fnw + col); } }
    }
};
__device__ __forceinline__ void phase11(Frame& F) {
    const int gw = F.vcu * NWAVES + F.wave, NGW = F.G * NWAVES; const f32x4* wv = (const f32x4*)F.in[I_FNW] + F.lane;
    for (int r = gw; r < T; r += NGW) {
        f32x4* xr = (f32x4*)(F.out + (size_t)r * D) + F.lane; f32x4 xv[4]; float s = 0.f;
#pragma unroll
        for (int j = 0; j < 4; ++j) { xv[j] = xr[64 * j]; s += (xv[j].x * xv[j].x + xv[j].y * xv[j].y) + (xv[j].z * xv[j].z + xv[j].w * xv[j].w); }
        const float rinv = __builtin_amdgcn_rsqf(wave_sum(s) * (1.f / D) + EPS);
#pragma unroll
        for (int j = 0; j < 4; ++j) xr[64 * j] = xv[j] * rinv * wv[64 * j];
    }
}
__device__ __forceinline__ void panel_sync(unsigned* cnt) {
    asm volatile("s_waitcnt vmcnt(0)" ::: "memory");
    __syncthreads();
    if (threadIdx.x == 0) {
        __builtin_amdgcn_fence(__ATOMIC_RELEASE, "agent");
        asm volatile("s_waitcnt vmcnt(0)" ::: "memory");
        __hip_atomic_fetch_add(cnt, 1u, __ATOMIC_RELAXED, __HIP_MEMORY_SCOPE_AGENT);
        while (__hip_atomic_load(cnt, __ATOMIC_RELAXED, __HIP_MEMORY_SCOPE_AGENT) < 4u) __builtin_amdgcn_s_sleep(1);
        __builtin_amdgcn_fence(__ATOMIC_ACQUIRE, "agent");
        asm volatile("s_waitcnt vmcnt(0)" ::: "memory");
    }
    __syncthreads();
}
struct Args { const float* in[26]; float* out; unsigned char* ws; int ph_lo, ph_hi, sub, pad; };
__global__ void __launch_bounds__(NWAVES * 64, 2) mk_fwd(Args args) {
    extern __shared__ __attribute__((aligned(16))) unsigned char lds[];
    Frame F;
    F.lds = (LAS unsigned char*)lds;
    F.tid = threadIdx.x; F.lane = F.tid & 63; F.wave = __builtin_amdgcn_readfirstlane(F.tid >> 6);
    F.G = gridDim.x; { const int bx = blockIdx.x; F.vcu = (F.G % 8 == 0) ? (bx % 8) * (F.G / 8) + bx / 8 : bx; }
#pragma unroll
    for (int i = 0; i < 26; ++i) F.in[i] = args.in[i];
    F.out = args.out; F.ws = args.ws;
    volatile LAS unsigned* MISC = (volatile LAS unsigned*)(F.lds + MISC_OFF);
    for (int u = F.tid; u < (LDS_BYTES - LDSCTL_OFF) / 4; u += NTHR) ((LAS unsigned*)(F.lds + LDSCTL_OFF))[u] = 0u;
    __syncthreads();
    XcdBarrier bar; bar.bar = (unsigned*)(F.ws + WS_CTL) + CW_BAR; bar.x = 0; bar.st = nullptr; bar.ngrp = 0u;
    if (!MK_PER_PHASE) bar = xcd_barrier_post((unsigned*)(F.ws + WS_CTL) + CW_BAR, MISC + 8);
    const int lo = args.ph_lo, hi = args.ph_hi;
#define IN(k) (lo <= (k) && (k) < hi)
#if MK_STAMP >= 0
    unsigned long long tstamp[NPHASE + 1]; tstamp[0] = __builtin_amdgcn_s_memrealtime();
#define SEAM(k) do { if (IN(k) && IN((k) + 1)) xcd_barrier(bar); tstamp[(k) + 1] = __builtin_amdgcn_s_memrealtime(); } while (0)
#define SEAMP(k, cw) do { if (IN(k) && IN((k) + 1)) panel_sync((unsigned*)(F.ws + WS_CTL) + (cw) + 64 * mypm); tstamp[(k) + 1] = __builtin_amdgcn_s_memrealtime(); } while (0)
#else
#define SEAM(k) do { if (IN(k) && IN((k) + 1)) xcd_barrier(bar); } while (0)
#define SEAMP(k, cw) do { if (IN(k) && IN((k) + 1)) panel_sync((unsigned*)(F.ws + WS_CTL) + (cw) + 64 * mypm); } while (0)
#endif
    if (IN(0)) { phase0<0>(F, F.vcu * NWAVES + F.wave, F.G * NWAVES); } SEAM(0);
    if (IN(1)) { phase1(F); } SEAM(1);
    if (IN(2)) {
        pg8::Gemm g{DOP(bf16, DO_H), WSP(bf16, WS_WIN), MROWS, NPAD, D}; OrderIn S; S.init(true, F.G, (int)blockIdx.x);
        EpiIn E{WSP(bf16, WS_QKV), WSP(bf16, WS_QKVC_RAW), WSP(bf16, WS_U), WSP(bf16, WS_ZDN), WSP(bf16, WS_ZS5), WSP(bf16, WS_GDN), WSP(bf16, WS_GS5), WSP(float, WS_BD)};
        pg8::gemm_phase<EpiIn, OrderIn, true, true>(F.lds, g, S, E);
        if (F.G == 256 && blockIdx.x >= 222) phase0<6>(F, ((int)blockIdx.x - 222) * NWAVES + F.wave, 34 * NWAVES);
    } SEAM(2);
    if (IN(3)) { phase4(F); } SEAM(3);
    if (IN(4) && F.G == 256) {
        if ((F.vcu & 4) == 0) { if (args.sub & 1) phase5b(F, args.sub); }
        else if (args.sub & 30) {
            const int sidx = (F.vcu >> 3) * 4 + (F.vcu & 3);
            XcdBarrier bar2 = xcd_barrier_post((unsigned*)(F.ws + WS_CTL) + CW_BAR2, MISC + 12); bar2.ngrp = 128u;
            if (args.sub & 4) s5_state_scan(F, sidx);
            xcd_barrier(bar2);
            if (args.sub & 8) s5c_group(F, sidx & 31, sidx >> 5, 4);
            __syncthreads();
            if (args.sub & 8) {
                pg8::Gemm g{DOP(bf16, DO_H), WSP(bf16, WS_WIN), T, NPAD, D}; OrderOne S; S.u0.pm = sidx >> 1; S.u0.pn = 18 + (sidx & 1);
                EpiIn E{WSP(bf16, WS_QKV), WSP(bf16, WS_QKVC_RAW), WSP(bf16, WS_U), WSP(bf16, WS_ZDN), WSP(bf16, WS_ZS5), WSP(bf16, WS_GDN), WSP(bf16, WS_GS5), WSP(float, WS_BD)};
                pg8::gemm_phase<EpiIn, OrderOne, false, true>(F.lds, g, S, E); }
            xcd_barrier(bar2);
            if (args.sub & 16) {
                pg8::Gemm g{DOP(bf16, DO_Y), WSP(bf16, WS_GLU), T, 512, 512}; pg8::StaticOrder S; S.init(T, 512, 128, sidx);
                EpiGlu E{DOP(bf16, DO_Y), WSP(bf16, WS_ZS5), F.in[I_GLUB], WSP(bf16, WS_YS5)};
                pg8::gemm_phase<EpiGlu, pg8::StaticOrder, false, true>(F.lds, g, S, E); }
        }
    } SEAM(4);
    if (IN(5)) {
        pg8::Gemm g{DOP(bf16, DO_H), WSP(bf16, WS_WIN), T, NPAD, D}; OrderIn S; S.init(false, F.G, (int)blockIdx.x);
        EpiGates E{WSP(bf16, WS_ODIR), F.in[I_DNNW], WSP(bf16, WS_YDN), WSP(bf16, WS_GDN), WSP(bf16, WS_GS5), (LAS float*)(F.lds + 8 * pg8::HTB)};
        pg8::gemm_phase<EpiGates, OrderIn, true, true>(F.lds, g, S, E);
    }
    const int mypm = 8 * ((int)blockIdx.x & 7) + (((int)blockIdx.x >> 3) & 7);
    SEAMP(5, CW_PAN2);
    if (IN(6)) {
        pg8::Gemm g1{WSP(bf16, WS_YDN), WSP(bf16, WS_WPD), T, 1024, 1024}, g2{WSP(bf16, WS_YS5), WSP(bf16, WS_WPS), T, 1024, 512}; pg8::StaticOrder S; S.init(T, 1024, F.G, (int)blockIdx.x);
        EpiMerge E{WSP(bf16, WS_GDN), WSP(bf16, WS_GS5), WSP(bf16, WS_MERGED)};
        pg8::gemm_dual<EpiMerge, pg8::StaticOrder, 1024, 512>(F.lds, g1, g2, S, E);
    } SEAM(6);
    { int t_ = threadIdx.x; asm volatile("" : "+v"(t_)); F.tid = t_; F.lane = t_ & 63; }
    if (IN(7)) {
        pg8::Gemm g{WSP(bf16, WS_MERGED), WSP(bf16, WS_WOUT), T, 1024, 1024}; pg8::StaticOrder S; S.init(T, 1024, F.G, (int)blockIdx.x);
        EpiOutNorm E{F.in[I_X], TABP(float, TAB_GATE), F.in[I_FNW], F.out, (unsigned long long*)(F.ws + WS_CTL + CTL_GRAN)};
        pg8::gemm_phase<EpiOutNorm, pg8::StaticOrder, false, true>(F.lds, g, S, E);
    }
#if MK_STAMP >= 0
    tstamp[NPHASE] = __builtin_amdgcn_s_memrealtime();
#if MK_STAMP == 200
    {
        asm volatile("s_waitcnt vmcnt(0)" ::: "memory"); __syncthreads();
        if (threadIdx.x == 0) { unsigned* cw = (unsigned*)(F.ws + WS_CTL) + 28672;
            __hip_atomic_fetch_max(cw, ~(unsigned)tstamp[0], __ATOMIC_RELAXED, __HIP_MEMORY_SCOPE_AGENT); __hip_atomic_fetch_max(cw + 64, (unsigned)tstamp[NPHASE], __ATOMIC_RELAXED, __HIP_MEMORY_SCOPE_AGENT);
            __builtin_amdgcn_fence(__ATOMIC_RELEASE, "agent"); asm volatile("s_waitcnt vmcnt(0)" ::: "memory");
            const unsigned old = __hip_atomic_fetch_add(cw + 128, 1u, __ATOMIC_RELAXED, __HIP_MEMORY_SCOPE_AGENT);
            if (old == gridDim.x - 1) { __builtin_amdgcn_fence(__ATOMIC_ACQUIRE, "agent"); asm volatile("s_waitcnt vmcnt(0)" ::: "memory");
                const unsigned s0 = ~__hip_atomic_load(cw, __ATOMIC_RELAXED, __HIP_MEMORY_SCOPE_AGENT), e1 = __hip_atomic_load(cw + 64, __ATOMIC_RELAXED, __HIP_MEMORY_SCOPE_AGENT);
                float* o = F.out; const float v = __hip_atomic_load(o, __ATOMIC_RELAXED, __HIP_MEMORY_SCOPE_AGENT); __hip_atomic_store(o, v + 0.00001f * (float)(e1 - s0), __ATOMIC_RELAXED, __HIP_MEMORY_SCOPE_AGENT); } }
    }
#else
    if (blockIdx.x == 0 && F.tid == 0) { asm volatile("s_waitcnt vmcnt(0)" ::: "memory"); F.out[0] += (MK_STAMP >= 100 ? 0.00001f : 0.01f) * (float)(MK_STAMP >= 100 ? tstamp[MK_STAMP - 100 + 1] - tstamp[0] : tstamp[MK_STAMP + 1] - tstamp[MK_STAMP]); }
#endif
#endif
#undef IN
#undef SEAM
#undef SEAMP
}
extern "C" void kernel_launch(void* const* d_in, const int* in_sizes, int n_in, void* d_out, int out_size, void* d_ws, size_t ws_size, hipStream_t stream) {
    static int grid = 0;
    if (grid == 0) {
        if (n_in != 26 || in_sizes[0] != T * D || out_size != T * D || ws_size < WS_END) { fprintf(stderr, "kernel_launch: unexpected shapes (n_in %d, in0 %d, out %d, ws %zu)\n", n_in, n_in > 0 ? in_sizes[0] : -1, out_size, ws_size); grid = -1; return; }
        int dev = 0, cus = 0;
        if (hipGetDevice(&dev) != hipSuccess || hipDeviceGetAttribute(&cus, hipDeviceAttributeMultiprocessorCount, dev) != hipSuccess) { grid = -1; return; }
        if (hipFuncSetAttribute((const void*)mk_fwd, hipFuncAttributeMaxDynamicSharedMemorySize, LDS_BYTES) != hipSuccess) { fprintf(stderr, "kernel_launch: hipFuncSetAttribute failed\n"); grid = -1; return; }
        (void)hipGetLastError();
        grid = cus;
        if (grid != 256) fprintf(stderr, "kernel_launch: %d CUs; this build assumes 256\n", grid);
    }
    if (grid < 0) return;
    if (hipMemsetAsync((char*)d_ws + WS_CTL, 0, CTL_ZERO_BYTES, stream) != hipSuccess) return;
    Args a{};
    for (int i = 0; i < 26; ++i) a.in[i] = (const float*)d_in[i];
    a.out = (float*)d_out; a.ws = (unsigned char*)d_ws; a.sub = 31;
#if MK_PER_PHASE
    for (int p = 0; p < NPHASE; ++p) { a.ph_lo = p; a.ph_hi = p + 1;
        if (p == 4 && MK_REP == 100) { a.sub = 1; hipLaunchKernelGGL(mk_fwd, dim3(grid), dim3(NWAVES * 64), LDS_BYTES, stream, a); a.sub = 30; }
        for (int rp = 0; rp < ((MK_REP == p && p != 4 && p != 9) ? 2 : 1); ++rp) hipLaunchKernelGGL(mk_fwd, dim3(grid), dim3(NWAVES * 64), LDS_BYTES, stream, a);
        if (p == 4 && MK_REP > 100) { a.sub = MK_REP - 100; (void)hipMemsetAsync((char*)d_ws + WS_CTL + (size_t)CW_BAR2 * 4, 0, 16384, stream); hipLaunchKernelGGL(mk_fwd, dim3(grid), dim3(NWAVES * 64), LDS_BYTES, stream, a); }

        a.sub = 31; }
#else
    a.ph_lo = 0; a.ph_hi = NPHASE; hipLaunchKernelGGL(mk_fwd, dim3(grid), dim3(NWAVES * 64), LDS_BYTES, stream, a);
#endif
}
```
